# Optimizing an MI355X kernel written in HIP

```python
import math
import jax
import jax.numpy as jnp
from jax import lax
import numpy as np

D_MODEL = 2048
BATCH = 2
SEQ = 4096
DEPTH = 2

CHUNK = 64
Q_BLOCK = 128
HEAD_DIM = 128
FOX_HEADS = 6
SB_HEADS = 6
DIFF_HEADS = 4
DIFF_QK_DIM = HEAD_DIM // 2
DIFF_V_DIM = HEAD_DIM
FOX_WIDTH = FOX_HEADS * HEAD_DIM
SB_WIDTH = SB_HEADS * HEAD_DIM
DIFF_QK_WIDTH = DIFF_HEADS * 2 * DIFF_QK_DIM
DIFF_WIDTH = DIFF_HEADS * DIFF_V_DIM
N_BRANCHES = 3
IN_SPLITS = (FOX_WIDTH, FOX_WIDTH, FOX_WIDTH, SB_WIDTH, SB_WIDTH, SB_WIDTH, DIFF_QK_WIDTH, DIFF_QK_WIDTH, DIFF_WIDTH, FOX_HEADS, D_MODEL, D_MODEL, D_MODEL)
IN_WIDTH = 3 * FOX_WIDTH + 3 * SB_WIDTH + 2 * DIFF_QK_WIDTH + DIFF_WIDTH + FOX_HEADS + N_BRANCHES * D_MODEL
ROPE_THETA = 10000.0
RMS_EPS = 1e-6
N_MOD = 6
PEER_HEADS = 8
PEER_N_KEYS = 128
PEER_EXPERTS = PEER_N_KEYS * PEER_N_KEYS
PEER_TOPK = 16
PEER_KEY_DIM = 256
PEER_HALF = PEER_KEY_DIM // 2
PEER_TOKEN_BLOCK = 128

kernel_name = 'hybrid_fox_sb_diff_peer_block'


def rms_norm(x, g):
    xf = x.astype(jnp.float32)
    y = xf * lax.rsqrt(jnp.mean(xf * xf, axis=-1, keepdims=True) + RMS_EPS)
    return (y * g.astype(jnp.float32)).astype(x.dtype)


def rope(x, positions):
    d = x.shape[-1]
    inv_freq = ROPE_THETA ** (-jnp.arange(0, d, 2, dtype=jnp.float32) / d)
    ang = positions.astype(jnp.float32)[..., None] * inv_freq
    cos = jnp.cos(ang)[:, :, None, :]
    sin = jnp.sin(ang)[:, :, None, :]
    x1, x2 = x[..., : d // 2], x[..., d // 2:]
    return jnp.concatenate([x1 * cos - x2 * sin, x1 * sin + x2 * cos], axis=-1)


def _split_q_blocks(a):
    b, s = a.shape[:2]
    a = a.reshape((b, s // Q_BLOCK, Q_BLOCK) + a.shape[2:])
    return jnp.moveaxis(a, 1, 0)


def _merge_q_blocks(o):
    o = jnp.moveaxis(o, 0, 1)
    return o.reshape((o.shape[0], o.shape[1] * o.shape[2]) + o.shape[3:])


def forgetting_attention(q, k, v, log_f):
    seq = q.shape[1]
    scale = q.shape[-1] ** -0.5
    cum = jnp.cumsum(log_f, axis=1)
    cum_k = jnp.transpose(cum, (0, 2, 1))
    s_idx = jnp.arange(seq)

    def block(args):
        bi, q_blk, cum_q = args
        t_idx = bi * Q_BLOCK + jnp.arange(Q_BLOCK)
        logits = jnp.einsum('bqhd,bshd->bhqs', q_blk, k) * scale
        logits = logits + jnp.transpose(cum_q, (0, 2, 1))[..., None] - cum_k[:, :, None, :]
        mask = s_idx[None, :] <= t_idx[:, None]
        p = jax.nn.softmax(jnp.where(mask, logits, -jnp.inf), axis=-1)
        return jnp.einsum('bhqs,bshd->bqhd', p, v)

    nb = seq // Q_BLOCK
    out = lax.map(block, (jnp.arange(nb), _split_q_blocks(q), _split_q_blocks(cum)))
    return _merge_q_blocks(out)


def stick_breaking_attention(q, k, v):
    seq = q.shape[1]
    scale = q.shape[-1] ** -0.5
    s_idx = jnp.arange(seq)

    def block(args):
        bi, q_blk = args
        t_idx = bi * Q_BLOCK + jnp.arange(Q_BLOCK)
        z = jnp.einsum('bqhd,bshd->bhqs', q_blk, k) * scale
        mask = s_idx[None, :] < t_idx[:, None]
        log_beta = jax.nn.log_sigmoid(z)
        log_keep = jnp.where(mask, jax.nn.log_sigmoid(-z), 0.0)
        later = lax.cumsum(log_keep, axis=3, reverse=True) - log_keep
        w = jnp.where(mask, jnp.exp(log_beta + later), 0.0)
        return jnp.einsum('bhqs,bshd->bqhd', w, v)

    nb = seq // Q_BLOCK
    out = lax.map(block, (jnp.arange(nb), _split_q_blocks(q)))
    return _merge_q_blocks(out)


def differential_attention(q, k, v, lam):
    seq = q.shape[1]
    scale = q.shape[-1] ** -0.5
    k1, k2 = k[..., 0, :], k[..., 1, :]
    chunk_k = jnp.arange(seq) // CHUNK

    def block(args):
        bi, q1_blk, q2_blk = args
        chunk_q = (bi * Q_BLOCK + jnp.arange(Q_BLOCK)) // CHUNK
        mask = chunk_k[None, :] <= chunk_q[:, None]
        l1 = jnp.einsum('bqhd,bshd->bhqs', q1_blk, k1) * scale
        l2 = jnp.einsum('bqhd,bshd->bhqs', q2_blk, k2) * scale
        p1 = jax.nn.softmax(jnp.where(mask, l1, -jnp.inf), axis=-1)
        p2 = jax.nn.softmax(jnp.where(mask, l2, -jnp.inf), axis=-1)
        return jnp.einsum('bhqs,bshd->bqhd', p1 - lam[None, :, None, None] * p2, v)

    nb = seq // Q_BLOCK
    out = lax.map(block, (jnp.arange(nb), _split_q_blocks(q[..., 0, :]), _split_q_blocks(q[..., 1, :])))
    return _merge_q_blocks(out)


def token_mixer(h, positions, w_in, b_forget, lam_q1, lam_k1, lam_q2, lam_k2, lam_init,
                subln_g, w_br_fox, w_br_sb, w_br_diff, w_o):
    b, s, _ = h.shape
    f32 = jnp.float32
    dt = h.dtype
    proj = h @ w_in
    (fq, fk, fv, sq, sk, sv, dq, dk, dv, f_logit, g_fox, g_sb, g_diff) = jnp.split(
        proj, np.cumsum(IN_SPLITS)[:-1].tolist(), axis=-1)

    def heads(a, n, dh):
        return a.reshape(b, s, n, dh).astype(f32)

    log_f = jax.nn.log_sigmoid(f_logit.astype(f32) + b_forget.astype(f32))
    o_fox = forgetting_attention(heads(fq, FOX_HEADS, HEAD_DIM), heads(fk, FOX_HEADS, HEAD_DIM),
                                 heads(fv, FOX_HEADS, HEAD_DIM), log_f)
    o_sb = stick_breaking_attention(heads(sq, SB_HEADS, HEAD_DIM), heads(sk, SB_HEADS, HEAD_DIM),
                                    heads(sv, SB_HEADS, HEAD_DIM))
    q_d = rope(heads(dq, 2 * DIFF_HEADS, DIFF_QK_DIM), positions).reshape(b, s, DIFF_HEADS, 2, DIFF_QK_DIM)
    k_d = rope(heads(dk, 2 * DIFF_HEADS, DIFF_QK_DIM), positions).reshape(b, s, DIFF_HEADS, 2, DIFF_QK_DIM)
    v_d = heads(dv, DIFF_HEADS, DIFF_V_DIM)
    lam = (jnp.exp(jnp.sum(lam_q1.astype(f32) * lam_k1.astype(f32), axis=-1))
           - jnp.exp(jnp.sum(lam_q2.astype(f32) * lam_k2.astype(f32), axis=-1)) + lam_init)
    o_diff = differential_attention(q_d, k_d, v_d, lam)
    o_diff = rms_norm(o_diff, subln_g) * (1.0 - lam_init)

    y = (jax.nn.sigmoid(g_fox) * (o_fox.reshape(b, s, FOX_WIDTH).astype(dt) @ w_br_fox)
         + jax.nn.sigmoid(g_sb) * (o_sb.reshape(b, s, SB_WIDTH).astype(dt) @ w_br_sb)
         + jax.nn.sigmoid(g_diff) * (o_diff.reshape(b, s, DIFF_WIDTH).astype(dt) @ w_br_diff))
    return y @ w_o


def peer_ffn(h, w_pq, sub_keys, u_table, v_table):
    b, s, d = h.shape
    t = b * s
    hf = h.reshape(t, d)
    q = (hf @ w_pq).reshape(t, PEER_HEADS, 2, PEER_HALF).astype(jnp.float32)
    scores = jnp.einsum('thpd,hpkd->thpk', q, sub_keys.astype(jnp.float32))
    s_top, i_top = lax.top_k(scores, PEER_TOPK)
    cand = (s_top[:, :, 0, :, None] + s_top[:, :, 1, None, :]).reshape(t, PEER_HEADS, PEER_TOPK * PEER_TOPK)
    cand_idx = (i_top[:, :, 0, :, None] * PEER_N_KEYS + i_top[:, :, 1, None, :]).reshape(t, PEER_HEADS, PEER_TOPK * PEER_TOPK)
    best, pos = lax.top_k(cand, PEER_TOPK)
    expert = jnp.take_along_axis(cand_idx, pos, axis=-1).reshape(t, PEER_HEADS * PEER_TOPK)
    gate = jax.nn.softmax(best, axis=-1).reshape(t, PEER_HEADS * PEER_TOPK).astype(h.dtype)

    def block(args):
        xb, eb, gb = args
        hid = jnp.einsum('td,ted->te', xb, u_table[eb])
        act = gb * jax.nn.gelu(hid, approximate=False)
        return jnp.einsum('te,ted->td', act, v_table[eb])

    nblk = t // PEER_TOKEN_BLOCK
    out = lax.map(block, (hf.reshape(nblk, PEER_TOKEN_BLOCK, d),
                          expert.reshape(nblk, PEER_TOKEN_BLOCK, -1),
                          gate.reshape(nblk, PEER_TOKEN_BLOCK, -1)))
    return out.reshape(b, s, d)


def setup_inputs(seed: int = 0) -> dict:
    key = jax.random.key(seed)
    ks = jax.random.split(key, 24)
    f32 = jnp.float32
    d = D_MODEL

    def nrm(k, shape, scale):
        return jax.random.normal(k, shape, f32) * scale

    offset = jax.random.randint(ks[2], (BATCH, 1), 0, 32768, dtype=jnp.int32)
    positions = offset + jnp.arange(SEQ, dtype=jnp.int32)[None, :]
    return {
        'x': nrm(ks[0], (BATCH, SEQ, d), 1.0),
        'c': nrm(ks[1], (BATCH, d), 1.0),
        'positions': positions,
        'ada_w': nrm(ks[3], (DEPTH, d, N_MOD * d), 0.5 * d ** -0.5),
        'ada_b': nrm(ks[4], (DEPTH, N_MOD * d), 0.01),
        'norm1_g': 1.0 + nrm(ks[5], (DEPTH, d), 0.02),
        'norm2_g': 1.0 + nrm(ks[6], (DEPTH, d), 0.02),
        'w_in': nrm(ks[7], (DEPTH, d, IN_WIDTH), d ** -0.5),
        'b_forget': 2.0 + nrm(ks[8], (DEPTH, FOX_HEADS), 0.5),
        'lam_q1': nrm(ks[9], (DEPTH, DIFF_HEADS, DIFF_QK_DIM), 0.1),
        'lam_k1': nrm(ks[10], (DEPTH, DIFF_HEADS, DIFF_QK_DIM), 0.1),
        'lam_q2': nrm(ks[11], (DEPTH, DIFF_HEADS, DIFF_QK_DIM), 0.1),
        'lam_k2': nrm(ks[12], (DEPTH, DIFF_HEADS, DIFF_QK_DIM), 0.1),
        'diff_subln_g': 1.0 + nrm(ks[13], (DEPTH, DIFF_V_DIM), 0.02),
        'w_br_fox': nrm(ks[14], (DEPTH, FOX_WIDTH, d), FOX_WIDTH ** -0.5),
        'w_br_sb': nrm(ks[15], (DEPTH, SB_WIDTH, d), SB_WIDTH ** -0.5),
        'w_br_diff': nrm(ks[16], (DEPTH, DIFF_WIDTH, d), DIFF_WIDTH ** -0.5),
        'w_o': nrm(ks[17], (DEPTH, d, d), d ** -0.5),
        'peer_wq': nrm(ks[18], (DEPTH, d, PEER_HEADS * PEER_KEY_DIM), d ** -0.5),
        'peer_sub_keys': nrm(ks[19], (DEPTH, PEER_HEADS, 2, PEER_N_KEYS, PEER_HALF), PEER_HALF ** -0.5),
        'peer_u': nrm(ks[20], (DEPTH, PEER_EXPERTS, d), d ** -0.5),
        'peer_v': nrm(ks[21], (DEPTH, PEER_EXPERTS, d), 1.0),
        'final_norm_g': 1.0 + nrm(ks[22], (d,), 0.02),
    }


def reference(x, c, positions, ada_w, ada_b, norm1_g, norm2_g, w_in, b_forget,
              lam_q1, lam_k1, lam_q2, lam_k2, diff_subln_g, w_br_fox, w_br_sb, w_br_diff,
              w_o, peer_wq, peer_sub_keys, peer_u, peer_v, final_norm_g):
    cond = jax.nn.silu(c)
    for l in range(DEPTH):
        lam_init = 0.8 - 0.6 * math.exp(-0.3 * l)
        mod = cond @ ada_w[l] + ada_b[l]
        sh1, sc1, gt1, sh2, sc2, gt2 = jnp.split(mod, N_MOD, axis=-1)
        h = rms_norm(x, norm1_g[l]) * (1.0 + sc1[:, None, :]) + sh1[:, None, :]
        x = x + gt1[:, None, :] * token_mixer(h, positions, w_in[l], b_forget[l], lam_q1[l], lam_k1[l],
                                               lam_q2[l], lam_k2[l], lam_init, diff_subln_g[l],
                                               w_br_fox[l], w_br_sb[l], w_br_diff[l], w_o[l])
        h = rms_norm(x, norm2_g[l]) * (1.0 + sc2[:, None, :]) + sh2[:, None, :]
        x = x + gt2[:, None, :] * peer_ffn(h, peer_wq[l], peer_sub_keys[l], peer_u[l], peer_v[l])
    return rms_norm(x, final_norm_g)
```

```cpp
#include <hip/hip_runtime.h>
#include <cstdio>
#include <cstdint>

#define LAS __attribute__((address_space(3)))
#define GAS __attribute__((address_space(1)))

constexpr int NB = 2, SEQ = 4096, DM = 2048, NT = NB * SEQ, DEPTH = 2;
constexpr int INW = 12294;
constexpr int C_FQ = 0, C_FK = 768, C_FV = 1536, C_SQ = 2304, C_SK = 3072, C_SV = 3840, C_DQ = 4608, C_DK = 5120, C_DV = 5632, C_FL = 6144, C_GF = 6150, C_GS = 8198, C_GD = 10246;
constexpr int NMOD = 6 * DM;
constexpr int PE_H = 8, PE_K = 128, PE_TOP = 16, PE_E = PE_H * PE_TOP;
constexpr float RMS_EPS = 1e-6f;

constexpr size_t MiB = 1u << 20;
constexpr size_t WS_CTL = 0, CTL_ZERO_BYTES = 1 * MiB;
constexpr size_t WS_X = 1 * MiB;
constexpr size_t WS_HB = WS_X + (size_t)NT * DM * 4;
constexpr size_t WS_ATT = WS_HB + (size_t)NT * DM * 2;
constexpr size_t WS_GATES = WS_ATT + (size_t)NT * 6144 * 2;
constexpr size_t WS_Y = WS_GATES + (size_t)NT * 6144 * 2;
constexpr size_t WS_G = WS_Y;
constexpr size_t WS_PQ = WS_G + (size_t)NT * 16384;
constexpr size_t WS_WINT = WS_PQ + (size_t)NT * DM * 4;
constexpr size_t WS_WBRT = WS_WINT + (size_t)2 * 12288 * DM * 2;
constexpr size_t WS_WOT = WS_WBRT + (size_t)2 * 3 * DM * 768 * 2;
constexpr size_t WS_WQT = WS_WOT + (size_t)2 * DM * DM * 2;
constexpr size_t WS_OB = WS_WQT + (size_t)2 * DM * DM * 2;
constexpr size_t WS_YB = WS_OB + (size_t)NT * DM * 2;
constexpr size_t WS_UB = WS_YB + (size_t)NT * DM * 2;
constexpr size_t WS_VT = WS_UB + (size_t)2 * 16384 * DM * 2;
constexpr size_t WS_ROPE = WS_VT + (size_t)2 * 16384 * DM * 2;
constexpr size_t WS_FL = WS_ROPE + (size_t)NT * 64 * 4;
constexpr size_t WS_CUM = WS_FL + (size_t)NT * 8 * 4;
constexpr size_t WS_MODP = WS_CUM + (size_t)12 * SEQ * 4;
constexpr size_t WS_MOD = WS_MODP + (size_t)2 * 16 * 2 * NMOD * 4;
constexpr size_t WS_EIDX = WS_MOD + (size_t)2 * 2 * NMOD * 4;
constexpr size_t WS_GATE = WS_EIDX + (size_t)NT * PE_E * 4;
constexpr size_t WS_HB8 = WS_GATE + (size_t)NT * PE_E * 4;
constexpr size_t WS_SH = WS_HB8 + (size_t)NT * DM;
constexpr size_t WS_SU = WS_SH + (size_t)NT * 4;
constexpr size_t WS_DV = WS_SU + (size_t)2 * 16384 * 4;
constexpr size_t WS_GM = WS_DV + (size_t)2 * 16384 * 4;
constexpr size_t WS_ACTF = WS_GM + (size_t)NT * PE_E * 4;
constexpr size_t WS_SA = WS_ACTF + (size_t)NT * PE_E * 4;
constexpr size_t WS_SW = WS_SA + (size_t)NT * 4;
constexpr size_t WS_SH1 = WS_SW + (size_t)2 * 12288 * 4;
constexpr size_t WS_SWQ = WS_SH1 + (size_t)NT * 4;
constexpr size_t WS_ODF = WS_SWQ + (size_t)2 * DM * 4;
constexpr size_t WS_END = WS_ODF + (size_t)2 * NT * 512 * 4;
static_assert(WS_END <= (size_t)1024 * MiB, "workspace map exceeds the guaranteed 1 GiB");

constexpr int CW_BAR = 4096;
constexpr int NWAVES = 8, NTHR = NWAVES * 64;
constexpr int LDS_BYTES = 147456;
constexpr int MISC_OFF = 144 * 1024 - 1024;

#define XB_TMO      128
#define XB_XCNT(j)  (256  + 64 * (j))
#define XB_XSUB(j)  (1280 + 64 * (j))
#define XB_XGEN(j)  (2304 + 64 * (j))
#define XB_TOP      3328
#define XB_TOPGEN   3392
#define XCD_BAR_WORDS 3456
#define XB_SPIN_CAP (1u << 18)

__device__ __forceinline__ unsigned xb_ld(unsigned* p)              { return __hip_atomic_load(p, __ATOMIC_RELAXED, __HIP_MEMORY_SCOPE_AGENT); }
__device__ __forceinline__ unsigned xb_add(unsigned* p, unsigned v) { return __hip_atomic_fetch_add(p, v, __ATOMIC_RELAXED, __HIP_MEMORY_SCOPE_AGENT); }
__device__ __forceinline__ unsigned xb_xcc_id() { return (unsigned)__builtin_amdgcn_s_getreg((3 << 11) | 20) & 0xFu; }
#define XB_SPIN(cond, bar) do { unsigned _sp = 0; while (cond) { __builtin_amdgcn_s_sleep(1); \
    if ((++_sp & 255u) == 0u) { if (xb_ld(&(bar)[XB_TMO])) break; if (_sp > XB_SPIN_CAP) { atomicAdd(&(bar)[XB_TMO], 1u); break; } } } } while (0)

struct XcdBarrier { unsigned* bar; unsigned x; volatile LAS unsigned* st; };

__device__ __forceinline__ XcdBarrier xcd_barrier_post(unsigned* bar, volatile LAS unsigned* st) {
    XcdBarrier b; b.bar = bar; b.x = xb_xcc_id(); b.st = st;
    if (threadIdx.x == 0) (void)xb_add(&bar[XB_XCNT(b.x)], 1u);
    return b;
}
__device__ __forceinline__ void xcd_barrier_complete(unsigned* bar, unsigned x, unsigned& nloc, unsigned& nx) {
    const unsigned G = gridDim.x * gridDim.y * gridDim.z;
    unsigned sum, cnt, mine, sp = 0u;
    for (;;) {
        sum = 0u; cnt = 0u; mine = 0u;
#pragma unroll
        for (unsigned j = 0; j < 16; ++j) { const unsigned c = xb_ld(&bar[XB_XCNT(j)]); sum += c; cnt += (c > 0u) ? 1u : 0u; mine = (j == x) ? c : mine; }
        if (sum == G) break;
        __builtin_amdgcn_s_sleep(1);
        if ((++sp & 255u) == 0u) { if (xb_ld(&bar[XB_TMO])) break; if (sp > XB_SPIN_CAP) { atomicAdd(&bar[XB_TMO], 1u); break; } }
    }
    nloc = mine > 0u ? mine : 1u; nx = cnt > 0u ? cnt : 1u;
}
__device__ __forceinline__ void xcd_barrier(const XcdBarrier& b, const bool thread0) {
    asm volatile("s_waitcnt vmcnt(0)" ::: "memory");
    __syncthreads();
    if (thread0) {
        unsigned* bar = b.bar;
        __builtin_amdgcn_s_waitcnt(0);
        unsigned nloc = b.st[0], nx = b.st[1];
        if (nloc == 0u) { xcd_barrier_complete(bar, b.x, nloc, nx); b.st[0] = nloc; b.st[1] = nx; }
        const unsigned old = xb_add(&bar[XB_XSUB(b.x)], 1u);
        const unsigned gen = old / nloc;
        if (old + 1u == (gen + 1u) * nloc) {
            __builtin_amdgcn_fence(__ATOMIC_RELEASE, "agent");
            asm volatile("s_waitcnt vmcnt(0)" ::: "memory");
            const unsigned og = xb_add(&bar[XB_TOP], 1u);
            const unsigned tg = og / nx;
            if (og + 1u == (tg + 1u) * nx) xb_add(&bar[XB_TOPGEN], 1u);
            else XB_SPIN(xb_ld(&bar[XB_TOPGEN]) == tg, bar);
            __builtin_amdgcn_fence(__ATOMIC_ACQUIRE, "agent");
            xb_add(&bar[XB_XGEN(b.x)], 1u);
            asm volatile("s_waitcnt vmcnt(0)" ::: "memory");
        } else {
            XB_SPIN(xb_ld(&bar[XB_XGEN(b.x)]) == gen, bar);
            __builtin_amdgcn_fence(__ATOMIC_ACQUIRE, "agent");
            asm volatile("s_waitcnt vmcnt(0)" ::: "memory");
        }
    }
    __syncthreads();
}

#define SWZ_XOR(v, m) __int_as_float(__builtin_amdgcn_ds_swizzle(__float_as_int(v), ((m) << 10) | 0x1f))
__device__ __forceinline__ float wave_sum(float v) {
    v += SWZ_XOR(v, 1); v += SWZ_XOR(v, 2); v += SWZ_XOR(v, 4); v += SWZ_XOR(v, 8); v += SWZ_XOR(v, 16);
    auto rr = __builtin_amdgcn_permlane32_swap(__float_as_uint(v), __float_as_uint(v), false, false); return __uint_as_float(rr[0]) + __uint_as_float(rr[1]);
}
__device__ __forceinline__ float logsig(float x) { return fminf(x, 0.f) - log1pf(expf(-fabsf(x))); }
__device__ __forceinline__ float gelu_erf(float x) { return 0.5f * x * (1.f + erff(x * 0.70710678118654752f)); }

__device__ __forceinline__ const float* ldp(volatile LAS unsigned* tab0, int i) {
    unsigned a = (unsigned)(unsigned long long)tab0; asm volatile("" : "+v"(a));
    volatile LAS unsigned* tab = (volatile LAS unsigned*)(unsigned long long)a;
    unsigned lo = tab[2 * i], hi = tab[2 * i + 1];
    lo = __builtin_amdgcn_readfirstlane(lo); hi = __builtin_amdgcn_readfirstlane(hi);
    return (const float*)(const GAS float*)(((unsigned long long)hi << 32) | lo);
}
typedef float vf4_ __attribute__((ext_vector_type(4)));
typedef float vf2_ __attribute__((ext_vector_type(2)));
__device__ __forceinline__ float4 ldnt4(const float* p) { const vf4_ v = __builtin_nontemporal_load((const vf4_*)p); return make_float4(v[0], v[1], v[2], v[3]); }
__device__ __forceinline__ float2 ldnt2(const float* p) { const vf2_ v = __builtin_nontemporal_load((const vf2_*)p); return make_float2(v[0], v[1]); }
__device__ __forceinline__ float ldnt1(const float* p) { return __builtin_nontemporal_load(p); }
__device__ __forceinline__ float4 ldx4(const void* X, const bool f32, const size_t idx) {
    if (f32) return *(const float4*)((const float*)X + idx);
    const uint2 w = *(const uint2*)((const unsigned short*)X + idx);
    return make_float4(__uint_as_float(w.x << 16), __uint_as_float(w.x & 0xffff0000u), __uint_as_float(w.y << 16), __uint_as_float(w.y & 0xffff0000u));
}
__device__ __forceinline__ size_t gaddr(const int t, const int e) { return ((((size_t)(t >> 8) * 64 + (size_t)(e >> 8)) * 256 + (size_t)(t & 255)) * 256) + (size_t)(e & 255); }
struct Args {
    const float* in[23];
    float* out; unsigned char* ws;
};

namespace pg8 {
#define PG8_LAS __attribute__((address_space(3)))
typedef unsigned short bf16_t;
typedef short bf16x8 __attribute__((ext_vector_type(8)));
typedef float f32x4 __attribute__((ext_vector_type(4)));
typedef unsigned u32x4 __attribute__((ext_vector_type(4)));
constexpr int BM = 256, BK = 64, HALF = 128, HTB = HALF * BK * 2  , STAGE_BYTES = 8 * HTB, NXCD = 8, WGM = 8;

__host__ __device__ __forceinline__ int lds_byte(int r, int c) { const int st = (r >> 4) * 2 + (c >> 5), rr = r & 15, cc = c & 31, ob = rr * 64 + cc * 2; return st * 1024 + (ob ^ (((ob >> 9) & 1) << 5)); }
__host__ __device__ __forceinline__ void stage_rc(int b, int& R, int& C) { const int st = b / 1024, sb = b % 1024, swz = sb ^ (((sb >> 9) & 1) << 5); R = (st >> 1) * 16 + swz / 64; C = (st & 1) * 32 + (swz % 64) / 2; }
__host__ __device__ __forceinline__ int perm32(int rho) { const int n = rho >> 4, i = rho & 15; return 8 * (i >> 2) + 4 * n + (i & 3); }

struct Unit { int pm, pn; };
struct Gemm { const bf16_t* A; const bf16_t* Bt; int M, N, K, lda, ldb; };

struct StaticOrder {
    int nM, nN, nwg, G, c;
    __host__ __device__ __forceinline__ void init(int M, int N, int G_, int c_) { nM = M / BM; nN = N / BM; nwg = nM * nN; G = G_; c = c_; }
    __host__ __device__ __forceinline__ bool next(int i, Unit& u) const {
        const long L = (long)i * G + c; if (L >= nwg) return false;
        int wgid = (int)L; { const int q = nwg / NXCD, r = nwg % NXCD, xcd = wgid % NXCD, off = wgid / NXCD; wgid = (xcd < r ? xcd * (q + 1) : r * (q + 1) + (xcd - r) * q) + off; }
        const int nig = WGM * nN, gid = wgid / nig, fm = gid * WGM, gsz = (nM - fm) < WGM ? (nM - fm) : WGM;
        u.pm = fm + ((wgid % nig) % gsz); u.pn = (wgid % nig) / gsz; return true;
    }
    __device__ __forceinline__ void a_ready(const Unit&) const {}
    __device__ __forceinline__ void done(const Unit&) const {}
    __device__ __forceinline__ size_t a_byte(const Unit& u, size_t tstep) const { return (size_t)u.pm * tstep; }
    __device__ __forceinline__ size_t b_byte(const Unit& u, size_t tstep) const { return (size_t)u.pn * tstep; }
    __device__ __forceinline__ int ktiles(const Unit&, int nt) const { return nt; }
};
struct BranchOrder {
    StaticOrder base;
    __device__ void init(int M, int N, int G_, int c_) { base.init(M, N, G_, c_); }
    __device__ bool next(int i, Unit& u) const { if (i >= 3) return false; if (!base.next(0, u)) return false; u.pn += 8 * i; return true; }
    __device__ __forceinline__ void a_ready(const Unit&) const {}
    __device__ __forceinline__ void done(const Unit&) const {}
    __device__ __forceinline__ size_t a_byte(const Unit& u, size_t tstep) const { return (size_t)u.pm * tstep + (size_t)((u.pn >> 3) * 768) * 2; }
    __device__ __forceinline__ size_t b_byte(const Unit& u, size_t) const { return ((size_t)(u.pn >> 3) * 2048 + (size_t)(u.pn & 7) * 256) * 768 * 2; }
    __device__ __forceinline__ int ktiles(const Unit& u, int) const { return (u.pn >> 3) < 2 ? 12 : 8; }
};

__device__ __forceinline__ unsigned cvt_pk_bf16(float lo, float hi) { unsigned r; asm volatile("v_cvt_pk_bf16_f32 %0, %1, %2" : "=v"(r) : "v"(lo), "v"(hi)); return r; }
typedef float f32x2 __attribute__((ext_vector_type(2)));
__device__ __forceinline__ f32x2 gelu_pk(f32x2 v) {
    const f32x2 av = __builtin_elementwise_abs(v), d = av * 0.2316418882f + 1.0f;
    f32x2 t; t.x = __builtin_amdgcn_rcpf(d.x); t.y = __builtin_amdgcn_rcpf(d.y);
    f32x2 q = t * 0.5307027145f + (-0.7265760135f); q = q * t + 0.7107068705f; q = q * t + (-0.142248368f); q = q * t + 0.127414796f; q = q * t;
    const f32x2 s = (v * v) * (-0.72134752044f);
    f32x2 e; e.x = __builtin_amdgcn_exp2f(s.x); e.y = __builtin_amdgcn_exp2f(s.y);
    const f32x2 m = v * (q * e), r = v - m;
    f32x2 o; o.x = v.x < 0.f ? m.x : r.x; o.y = v.y < 0.f ? m.y : r.y; return o;
}

template <class Epi, class Sched, bool ALIGN_EPI = false, bool SP2 = false>
__device__ __forceinline__ void gemm_phase(const int tid, PG8_LAS unsigned char* lds, const Gemm g, const Sched& S, const Epi& E) {
    const int wid = __builtin_amdgcn_readfirstlane(tid >> 6), lane = tid & 63, wr = wid >> 2, wc = wid & 3, fr = lane & 15, fq = lane >> 4;
    const int K = g.K, ntK = K / BK;
    unsigned voffA[2], voffB[2];
#pragma unroll
    for (int i = 0; i < 2; ++i) { int R, C; stage_rc(tid * 16 + i * 8192, R, C); const int Rb = Epi::PERM ? ((R & ~31) + perm32(R & 31)) : R;
        voffA[i] = (unsigned)(R * g.lda + C) * 2u; voffB[i] = (unsigned)(Rb * g.ldb + C) * 2u; }
    const size_t kstep = (size_t)(BK * 2);
    const size_t hstepA = (size_t)HALF * g.lda * 2, hstepB = (size_t)HALF * g.ldb * 2;
    const size_t tstepA = 2 * hstepA, tstepB = 2 * hstepB;
    const unsigned ldsw = (unsigned)wid * 1024u;
    const int aoff = lds_byte(wr * 64 + fr, fq * 8), boff = lds_byte(wc * 32 + fr, fq * 8);
#define PG8_SA(b, h) (((b) * 2 + (h)) * HTB)
#define PG8_SB(b, h) ((4 + (b) * 2 + (h)) * HTB)
#define PG8_STAGE(bufoff, gbase, voff) do { _Pragma("unroll") for (int _i = 0; _i < 2; ++_i) \
        __builtin_amdgcn_global_load_lds((const unsigned*)((const char*)(gbase) + (voff)[_i]), (PG8_LAS unsigned*)(lds + (bufoff) + ldsw + _i * 8192), 16, 0, 0); } while (0)
#define PG8_LDA(dst, b, h) do { _Pragma("unroll") for (int m = 0; m < 4; ++m) _Pragma("unroll") for (int k = 0; k < 2; ++k) dst[m][k] = *(const PG8_LAS bf16x8*)(lds + PG8_SA(b, h) + aoff + m * 2048 + k * 1024); } while (0)
#define PG8_LDB(dst, b, h) do { _Pragma("unroll") for (int n = 0; n < 2; ++n) _Pragma("unroll") for (int k = 0; k < 2; ++k) dst[n][k] = *(const PG8_LAS bf16x8*)(lds + PG8_SB(b, h) + boff + n * 2048 + k * 1024); } while (0)
#define PG8_MMA(ai, bj, At, Bt) do { __builtin_amdgcn_s_setprio(1); _Pragma("unroll") for (int m = 0; m < 4; ++m) _Pragma("unroll") for (int n = 0; n < 2; ++n) _Pragma("unroll") for (int k = 0; k < 2; ++k) \
        acc[ai][bj][m][n] = __builtin_amdgcn_mfma_f32_16x16x32_bf16(Bt[n][k], At[m][k], acc[ai][bj][m][n], 0, 0, 0); __builtin_amdgcn_s_setprio(0); } while (0)
#define PG8_WAIT_V(n) asm volatile("s_waitcnt vmcnt(" #n ")" ::: "memory")
#define PG8_WAIT_L(n) asm volatile("s_waitcnt lgkmcnt(" #n ")" ::: "memory")
#define PG8_BAR __builtin_amdgcn_s_barrier()
#define PG8_SCHED __builtin_amdgcn_sched_barrier(0)
    Unit cur, nxt; int ui = 0;
    if (!S.next(0, cur)) return;
    f32x4 acc[2][2][4][2];
#pragma unroll
    for (int a = 0; a < 2; ++a)
#pragma unroll
        for (int b = 0; b < 2; ++b)
#pragma unroll
            for (int m = 0; m < 4; ++m)
#pragma unroll
                for (int n = 0; n < 2; ++n) acc[a][b][m][n] = (f32x4){0.f, 0.f, 0.f, 0.f};
    bf16x8 At[4][2], B0[2][2], B1[2][2];
    const char* cA = (const char*)g.A + S.a_byte(cur, tstepA); const char* cB = (const char*)g.Bt + S.b_byte(cur, tstepB);
    S.a_ready(cur);
    if constexpr (SP2) {
        PG8_STAGE(PG8_SB(0, 0), cB, voffB); PG8_STAGE(PG8_SB(0, 1), cB + hstepB, voffB); PG8_STAGE(PG8_SA(0, 0), cA, voffA); PG8_STAGE(PG8_SA(0, 1), cA + hstepA, voffA);
        if (wr == 1) PG8_BAR;
        PG8_WAIT_V(2); PG8_BAR;
        PG8_STAGE(PG8_SB(1, 0), cB + kstep, voffB); PG8_STAGE(PG8_SA(1, 0), cA + kstep, voffA); PG8_STAGE(PG8_SB(1, 1), cB + hstepB + kstep, voffB);
        PG8_WAIT_V(6); PG8_BAR;
    } else {
        PG8_STAGE(PG8_SB(0, 0), cB, voffB); PG8_STAGE(PG8_SA(0, 0), cA, voffA); PG8_STAGE(PG8_SB(0, 1), cB + hstepB, voffB); PG8_STAGE(PG8_SA(0, 1), cA + hstepA, voffA);
        if (wr == 1) PG8_BAR;
        PG8_WAIT_V(4); PG8_BAR;
        PG8_STAGE(PG8_SB(1, 0), cB + kstep, voffB); PG8_STAGE(PG8_SA(1, 0), cA + kstep, voffA); PG8_STAGE(PG8_SB(1, 1), cB + hstepB + kstep, voffB);
        PG8_WAIT_V(6); PG8_BAR;
    }
    for (;;) {
        const bool has_next = S.next(ui + 1, nxt);
        const char* nA = has_next ? (const char*)g.A + S.a_byte(nxt, tstepA) : cA; const char* nB = has_next ? (const char*)g.Bt + S.b_byte(nxt, tstepB) : cB;
        const int nt = S.ktiles(cur, ntK);
        for (int t = 0; t < nt; t += 2) {
            const bool last = (t == nt - 2);
            const char* a1 = cA + (size_t)(t + 1) * kstep;
            const char* a2 = last ? nA : cA + (size_t)(t + 2) * kstep; const char* b2 = last ? nB : cB + (size_t)(t + 2) * kstep;
            const char* a3 = a2 + kstep; const char* b3 = b2 + kstep;
            if (last && has_next) S.a_ready(nxt);
            if constexpr (SP2) {
            PG8_LDB(B0, 0, 0); PG8_LDB(B1, 0, 1); PG8_SCHED; PG8_LDA(At, 0, 0); PG8_STAGE(PG8_SA(1, 1), a1 + hstepA, voffA);
            PG8_WAIT_V(8); PG8_WAIT_L(0); PG8_BAR; PG8_MMA(0, 0, At, B0); PG8_MMA(0, 1, At, B1); PG8_BAR; PG8_SCHED;
            PG8_LDA(At, 0, 1); PG8_STAGE(PG8_SB(0, 0), b2, voffB); PG8_STAGE(PG8_SB(0, 1), b2 + hstepB, voffB); PG8_STAGE(PG8_SA(0, 0), a2, voffA);
            PG8_WAIT_V(8); PG8_WAIT_L(0); PG8_BAR; PG8_MMA(1, 0, At, B0); PG8_MMA(1, 1, At, B1); PG8_BAR; PG8_SCHED;
            PG8_LDB(B0, 1, 0); PG8_LDB(B1, 1, 1); PG8_SCHED; PG8_LDA(At, 1, 0); PG8_STAGE(PG8_SA(0, 1), a2 + hstepA, voffA);
            PG8_WAIT_V(8); PG8_WAIT_L(0); PG8_BAR; PG8_MMA(0, 0, At, B0); PG8_MMA(0, 1, At, B1); PG8_BAR; PG8_SCHED;
            PG8_LDA(At, 1, 1); PG8_STAGE(PG8_SB(1, 0), b3, voffB); PG8_STAGE(PG8_SB(1, 1), b3 + hstepB, voffB); PG8_STAGE(PG8_SA(1, 0), a3, voffA);
            PG8_WAIT_V(8); PG8_WAIT_L(0); PG8_BAR; PG8_MMA(1, 0, At, B0); PG8_MMA(1, 1, At, B1); PG8_BAR; PG8_SCHED;
            } else {
            PG8_LDB(B0, 0, 0); PG8_SCHED; PG8_LDA(At, 0, 0); PG8_STAGE(PG8_SA(1, 1), a1 + hstepA, voffA);
            PG8_WAIT_L(8); PG8_BAR; PG8_WAIT_L(0); PG8_MMA(0, 0, At, B0); PG8_BAR; PG8_SCHED;
            PG8_LDB(B1, 0, 1); PG8_STAGE(PG8_SB(0, 0), b2, voffB);
            PG8_BAR; PG8_WAIT_L(0); PG8_MMA(0, 1, At, B1); PG8_BAR;
            PG8_LDA(At, 0, 1); PG8_STAGE(PG8_SA(0, 0), a2, voffA);
            PG8_BAR; PG8_WAIT_L(0); PG8_MMA(1, 0, At, B0); PG8_BAR; PG8_SCHED;
            PG8_STAGE(PG8_SB(0, 1), b2 + hstepB, voffB);
            PG8_WAIT_V(6); PG8_BAR; PG8_MMA(1, 1, At, B1); PG8_BAR;
            PG8_LDB(B0, 1, 0); PG8_SCHED; PG8_LDA(At, 1, 0); PG8_STAGE(PG8_SA(0, 1), a2 + hstepA, voffA);
            PG8_WAIT_L(8); PG8_BAR; PG8_WAIT_L(0); PG8_MMA(0, 0, At, B0); PG8_BAR; PG8_SCHED;
            PG8_LDB(B1, 1, 1); PG8_STAGE(PG8_SB(1, 0), b3, voffB);
            PG8_BAR; PG8_WAIT_L(0); PG8_MMA(0, 1, At, B1); PG8_BAR;
            PG8_LDA(At, 1, 1); PG8_STAGE(PG8_SA(1, 0), a3, voffA);
            PG8_BAR; PG8_WAIT_L(0); PG8_MMA(1, 0, At, B0); PG8_BAR; PG8_SCHED;
            PG8_STAGE(PG8_SB(1, 1), b3 + hstepB, voffB);
            PG8_WAIT_V(6); PG8_BAR; PG8_MMA(1, 1, At, B1); PG8_BAR;
            }
        }
        if constexpr (ALIGN_EPI) { if (wr == 0) PG8_BAR; }
        if constexpr (!Epi::AFTER_DRAIN) { E(acc, cur, wr, wc, fr, fq); S.done(cur); }
        if (!has_next) break;
        if constexpr (!Epi::CARRY) {
#pragma unroll
        for (int a = 0; a < 2; ++a)
#pragma unroll
            for (int b = 0; b < 2; ++b)
#pragma unroll
                for (int m = 0; m < 4; ++m)
#pragma unroll
                    for (int n = 0; n < 2; ++n) acc[a][b][m][n] = (f32x4){0.f, 0.f, 0.f, 0.f};
        }
        cur = nxt; cA = nA; cB = nB; ++ui;
        if constexpr (ALIGN_EPI) { if (wr == 1) PG8_BAR; }
    }
    PG8_WAIT_V(0);
    if constexpr (!ALIGN_EPI) { if (wr == 0) PG8_BAR; }
    PG8_BAR;
    if constexpr (Epi::AFTER_DRAIN) { E.fused(acc, cur, wr, wc, fr, fq, lds, wid, lane); S.done(cur); }
#undef PG8_SA
#undef PG8_SB
#undef PG8_STAGE
#undef PG8_LDA
#undef PG8_LDB
#undef PG8_MMA
#undef PG8_WAIT_V
#undef PG8_WAIT_L
#undef PG8_BAR
#undef PG8_SCHED
}

typedef int i32x4 __attribute__((ext_vector_type(4)));
struct Gemm8 { const signed char* A; const signed char* Bt; int M, N, K, lda, ldb; };
template <class Epi, class Sched, bool ALIGN_EPI = false, bool SP2 = false, bool A_TILED = false>
__device__ __forceinline__ void gemm_phase_i8(const int tid, PG8_LAS unsigned char* lds, const Gemm8 g, const Sched& S, const Epi& E) {
    const int wid = __builtin_amdgcn_readfirstlane(tid >> 6), lane = tid & 63, wr = wid >> 2, wc = wid & 3, fr = lane & 15, fq = lane >> 4;
    const int K = g.K, nt = K / 128;
    unsigned voffA[2], voffB[2];
#pragma unroll
    for (int i = 0; i < 2; ++i) { int R, C; stage_rc(tid * 16 + i * 8192, R, C); const int Rb = Epi::PERM ? ((R & ~31) + perm32(R & 31)) : R;
        voffA[i] = (unsigned)(R * g.lda + 2 * C); voffB[i] = (unsigned)(Rb * g.ldb + 2 * C); }
    const size_t kstep = (size_t)128;
    const size_t hstepA = (size_t)HALF * g.lda, hstepB = (size_t)HALF * g.ldb;
    const size_t tstepA = A_TILED ? (size_t)(g.K / 256) * 65536 : 2 * hstepA, tstepB = 2 * hstepB;
    const unsigned ldsw = (unsigned)wid * 1024u;
    const int aoff = lds_byte(wr * 64 + fr, fq * 8), boff = lds_byte(wc * 32 + fr, fq * 8);
#define PG8_SA(b, h) (((b) * 2 + (h)) * HTB)
#define PG8_SB(b, h) ((4 + (b) * 2 + (h)) * HTB)
#define PG8_STAGE(bufoff, gbase, voff) do { _Pragma("unroll") for (int _i = 0; _i < 2; ++_i) \
        __builtin_amdgcn_global_load_lds((const unsigned*)((const char*)(gbase) + (voff)[_i]), (PG8_LAS unsigned*)(lds + (bufoff) + ldsw + _i * 8192), 16, 0, 0); } while (0)
#define PG8_LDA(dst, b, h) do { _Pragma("unroll") for (int m = 0; m < 4; ++m) _Pragma("unroll") for (int k = 0; k < 2; ++k) dst[m][k] = *(const PG8_LAS bf16x8*)(lds + PG8_SA(b, h) + aoff + m * 2048 + k * 1024); } while (0)
#define PG8_LDB(dst, b, h) do { _Pragma("unroll") for (int n = 0; n < 2; ++n) _Pragma("unroll") for (int k = 0; k < 2; ++k) dst[n][k] = *(const PG8_LAS bf16x8*)(lds + PG8_SB(b, h) + boff + n * 2048 + k * 1024); } while (0)
#define PG8_MMA(ai, bj, At, Bt) do { __builtin_amdgcn_s_setprio(1); _Pragma("unroll") for (int m = 0; m < 4; ++m) _Pragma("unroll") for (int n = 0; n < 2; ++n) _Pragma("unroll") for (int k = 0; k < 2; ++k) \
        acc[ai][bj][m][n] = __builtin_amdgcn_mfma_i32_16x16x64_i8(__builtin_bit_cast(i32x4, Bt[n][k]), __builtin_bit_cast(i32x4, At[m][k]), acc[ai][bj][m][n], 0, 0, 0); __builtin_amdgcn_s_setprio(0); } while (0)
#define PG8_WAIT_V(n) asm volatile("s_waitcnt vmcnt(" #n ")" ::: "memory")
#define PG8_WAIT_L(n) asm volatile("s_waitcnt lgkmcnt(" #n ")" ::: "memory")
#define PG8_BAR __builtin_amdgcn_s_barrier()
#define PG8_SCHED __builtin_amdgcn_sched_barrier(0)
    Unit cur, nxt; int ui = 0;
    if (!S.next(0, cur)) return;
    i32x4 acc[2][2][4][2];
#pragma unroll
    for (int a = 0; a < 2; ++a)
#pragma unroll
        for (int b = 0; b < 2; ++b)
#pragma unroll
            for (int m = 0; m < 4; ++m)
#pragma unroll
                for (int n = 0; n < 2; ++n) acc[a][b][m][n] = (i32x4){0, 0, 0, 0};
    bf16x8 At[4][2], B0[2][2], B1[2][2];
    const char* cA = (const char*)g.A + (size_t)cur.pm * tstepA; const char* cB = (const char*)g.Bt + (size_t)cur.pn * tstepB;
    S.a_ready(cur);
    if constexpr (SP2) {
        PG8_STAGE(PG8_SB(0, 0), cB, voffB); PG8_STAGE(PG8_SB(0, 1), cB + hstepB, voffB); PG8_STAGE(PG8_SA(0, 0), cA, voffA); PG8_STAGE(PG8_SA(0, 1), cA + hstepA, voffA);
        if (wr == 1) PG8_BAR;
        PG8_WAIT_V(2); PG8_BAR;
        PG8_STAGE(PG8_SB(1, 0), cB + kstep, voffB); PG8_STAGE(PG8_SA(1, 0), cA + kstep, voffA); PG8_STAGE(PG8_SB(1, 1), cB + hstepB + kstep, voffB);
        PG8_WAIT_V(6); PG8_BAR;
    } else {
        PG8_STAGE(PG8_SB(0, 0), cB, voffB); PG8_STAGE(PG8_SA(0, 0), cA, voffA); PG8_STAGE(PG8_SB(0, 1), cB + hstepB, voffB); PG8_STAGE(PG8_SA(0, 1), cA + hstepA, voffA);
        if (wr == 1) PG8_BAR;
        PG8_WAIT_V(4); PG8_BAR;
        PG8_STAGE(PG8_SB(1, 0), cB + kstep, voffB); PG8_STAGE(PG8_SA(1, 0), cA + kstep, voffA); PG8_STAGE(PG8_SB(1, 1), cB + hstepB + kstep, voffB);
        PG8_WAIT_V(6); PG8_BAR;
    }
    for (;;) {
        const bool has_next = S.next(ui + 1, nxt);
        const char* nA = has_next ? (const char*)g.A + (size_t)nxt.pm * tstepA : cA; const char* nB = has_next ? (const char*)g.Bt + (size_t)nxt.pn * tstepB : cB;
        for (int t = 0; t < nt; t += 2) {
            const bool last = (t == nt - 2);
            const char* a1 = A_TILED ? cA + (size_t)(t >> 1) * 65536 + 128 : cA + (size_t)(t + 1) * kstep;
            const char* a2 = last ? nA : (A_TILED ? cA + (size_t)((t >> 1) + 1) * 65536 : cA + (size_t)(t + 2) * kstep); const char* b2 = last ? nB : cB + (size_t)(t + 2) * kstep;
            const char* a3 = a2 + kstep; const char* b3 = b2 + kstep;
            if (last && has_next) S.a_ready(nxt);
            if constexpr (SP2) {
            PG8_LDB(B0, 0, 0); PG8_LDB(B1, 0, 1); PG8_SCHED; PG8_LDA(At, 0, 0); PG8_STAGE(PG8_SA(1, 1), a1 + hstepA, voffA);
            PG8_WAIT_V(8); PG8_WAIT_L(0); PG8_BAR; PG8_MMA(0, 0, At, B0); PG8_MMA(0, 1, At, B1); PG8_BAR; PG8_SCHED;
            PG8_LDA(At, 0, 1); PG8_STAGE(PG8_SB(0, 0), b2, voffB); PG8_STAGE(PG8_SB(0, 1), b2 + hstepB, voffB); PG8_STAGE(PG8_SA(0, 0), a2, voffA);
            PG8_WAIT_V(8); PG8_WAIT_L(0); PG8_BAR; PG8_MMA(1, 0, At, B0); PG8_MMA(1, 1, At, B1); PG8_BAR; PG8_SCHED;
            PG8_LDB(B0, 1, 0); PG8_LDB(B1, 1, 1); PG8_SCHED; PG8_LDA(At, 1, 0); PG8_STAGE(PG8_SA(0, 1), a2 + hstepA, voffA);
            PG8_WAIT_V(8); PG8_WAIT_L(0); PG8_BAR; PG8_MMA(0, 0, At, B0); PG8_MMA(0, 1, At, B1); PG8_BAR; PG8_SCHED;
            PG8_LDA(At, 1, 1); PG8_STAGE(PG8_SB(1, 0), b3, voffB); PG8_STAGE(PG8_SB(1, 1), b3 + hstepB, voffB); PG8_STAGE(PG8_SA(1, 0), a3, voffA);
            PG8_WAIT_V(8); PG8_WAIT_L(0); PG8_BAR; PG8_MMA(1, 0, At, B0); PG8_MMA(1, 1, At, B1); PG8_BAR; PG8_SCHED;
            } else {
            PG8_LDB(B0, 0, 0); PG8_SCHED; PG8_LDA(At, 0, 0); PG8_STAGE(PG8_SA(1, 1), a1 + hstepA, voffA);
            PG8_WAIT_L(8); PG8_BAR; PG8_WAIT_L(0); PG8_MMA(0, 0, At, B0); PG8_BAR; PG8_SCHED;
            PG8_LDB(B1, 0, 1); PG8_STAGE(PG8_SB(0, 0), b2, voffB);
            PG8_BAR; PG8_WAIT_L(0); PG8_MMA(0, 1, At, B1); PG8_BAR;
            PG8_LDA(At, 0, 1); PG8_STAGE(PG8_SA(0, 0), a2, voffA);
            PG8_BAR; PG8_WAIT_L(0); PG8_MMA(1, 0, At, B0); PG8_BAR; PG8_SCHED;
            PG8_STAGE(PG8_SB(0, 1), b2 + hstepB, voffB);
            PG8_WAIT_V(6); PG8_BAR; PG8_MMA(1, 1, At, B1); PG8_BAR;
            PG8_LDB(B0, 1, 0); PG8_SCHED; PG8_LDA(At, 1, 0); PG8_STAGE(PG8_SA(0, 1), a2 + hstepA, voffA);
            PG8_WAIT_L(8); PG8_BAR; PG8_WAIT_L(0); PG8_MMA(0, 0, At, B0); PG8_BAR; PG8_SCHED;
            PG8_LDB(B1, 1, 1); PG8_STAGE(PG8_SB(1, 0), b3, voffB);
            PG8_BAR; PG8_WAIT_L(0); PG8_MMA(0, 1, At, B1); PG8_BAR;
            PG8_LDA(At, 1, 1); PG8_STAGE(PG8_SA(1, 0), a3, voffA);
            PG8_BAR; PG8_WAIT_L(0); PG8_MMA(1, 0, At, B0); PG8_BAR; PG8_SCHED;
            PG8_STAGE(PG8_SB(1, 1), b3 + hstepB, voffB);
            PG8_WAIT_V(6); PG8_BAR; PG8_MMA(1, 1, At, B1); PG8_BAR;
            }
        }
        if constexpr (ALIGN_EPI) { if (wr == 0) PG8_BAR; }
        if constexpr (!Epi::AFTER_DRAIN) { E(acc, cur, wr, wc, fr, fq); S.done(cur); }
        if (!has_next) break;
#pragma unroll
        for (int a = 0; a < 2; ++a)
#pragma unroll
            for (int b = 0; b < 2; ++b)
#pragma unroll
                for (int m = 0; m < 4; ++m)
#pragma unroll
                    for (int n = 0; n < 2; ++n) acc[a][b][m][n] = (i32x4){0, 0, 0, 0};
        cur = nxt; cA = nA; cB = nB; ++ui;
        if constexpr (ALIGN_EPI) { if (wr == 1) PG8_BAR; }
    }
    PG8_WAIT_V(0);
    if constexpr (!ALIGN_EPI) { if (wr == 0) PG8_BAR; }
    PG8_BAR;
    if constexpr (Epi::AFTER_DRAIN) { E.fused(acc, cur, wr, wc, fr, fq, lds, wid, lane); S.done(cur); }
#undef PG8_SA
#undef PG8_SB
#undef PG8_STAGE
#undef PG8_LDA
#undef PG8_LDB
#undef PG8_MMA
#undef PG8_WAIT_V
#undef PG8_WAIT_L
#undef PG8_BAR
#undef PG8_SCHED
}

}

__device__ __forceinline__ unsigned pk_i8x4(float a, float b, float c, float d) {
    const int ia = (int)rintf(a), ib = (int)rintf(b), ic = (int)rintf(c), id = (int)rintf(d);
    return ((unsigned)ia & 0xffu) | (((unsigned)ib & 0xffu) << 8) | (((unsigned)ic & 0xffu) << 16) | (((unsigned)id & 0xffu) << 24); }
__device__ __forceinline__ float wave_max(float v) {
    v = fmaxf(v, SWZ_XOR(v, 1)); v = fmaxf(v, SWZ_XOR(v, 2)); v = fmaxf(v, SWZ_XOR(v, 4)); v = fmaxf(v, SWZ_XOR(v, 8)); v = fmaxf(v, SWZ_XOR(v, 16));
    auto rr = __builtin_amdgcn_permlane32_swap(__float_as_uint(v), __float_as_uint(v), false, false); return fmaxf(__uint_as_float(rr[0]), __uint_as_float(rr[1])); }
typedef unsigned short bf16_t;

struct EpiProj {
    static constexpr bool PERM = true, AFTER_DRAIN = false;
    bf16_t* ATT; bf16_t* GATES; const float* ROPE; const float* SH; const float* SW; unsigned* KINF;
    template <int MODE, bool KT>
    __device__ __forceinline__ void run(const pg8::i32x4 (&acc)[2][2][4][2], const pg8::Unit& u, int wr, int wc, int fr, int fq) const {
        using pg8::f32x4; using pg8::u32x4; using pg8::cvt_pk_bf16;
        const int row0 = u.pm * 256 + wr * 64 + fr, pn = u.pn;
        float mxk[2] = {0.f, 0.f};
        bf16_t* base = (MODE == 2) ? GATES : ATT; const int colt = (MODE == 2) ? (pn - 24) * 256 : pn * 256;
        float shr[2][4]; f32x4 sw[2][2];
#pragma unroll
        for (int ai = 0; ai < 2; ++ai)
#pragma unroll
            for (int m = 0; m < 4; ++m) shr[ai][m] = SH[row0 + ai * 128 + m * 16];
#pragma unroll
        for (int bj = 0; bj < 2; ++bj) { const int ncol = pn * 256 + bj * 128 + wc * 32 + 8 * fq; sw[bj][0] = *(const f32x4*)(SW + ncol); sw[bj][1] = *(const f32x4*)(SW + ncol + 4); }
#pragma unroll
        for (int ai = 0; ai < 2; ++ai)
#pragma unroll
            for (int m = 0; m < 4; ++m) { const int row = row0 + ai * 128 + m * 16;
#pragma unroll
                for (int bj = 0; bj < 2; ++bj) { const int col = colt + bj * 128 + wc * 32 + 8 * fq;
                    const pg8::i32x4 i0 = acc[ai][bj][m][0], i1 = acc[ai][bj][m][1]; const f32x4 w0 = sw[bj][0] * shr[ai][m], w1 = sw[bj][1] * shr[ai][m];
                    f32x4 v0 = {(float)i0[0] * w0[0], (float)i0[1] * w0[1], (float)i0[2] * w0[2], (float)i0[3] * w0[3]}, v1 = {(float)i1[0] * w1[0], (float)i1[1] * w1[1], (float)i1[2] * w1[2], (float)i1[3] * w1[3]};
                    if constexpr (MODE == 1) { const int j = (col & 63) >> 3; const f32x4 cs0 = *(const f32x4*)(ROPE + (size_t)row * 64 + 8 * j), cs1 = *(const f32x4*)(ROPE + (size_t)row * 64 + 8 * j + 4);
                        f32x4 y0, y1;
                        y0[0] = v0[0] * cs0[0] - v1[0] * cs0[1]; y1[0] = v0[0] * cs0[1] + v1[0] * cs0[0];
                        y0[1] = v0[1] * cs0[2] - v1[1] * cs0[3]; y1[1] = v0[1] * cs0[3] + v1[1] * cs0[2];
                        y0[2] = v0[2] * cs1[0] - v1[2] * cs1[1]; y1[2] = v0[2] * cs1[1] + v1[2] * cs1[0];
                        y0[3] = v0[3] * cs1[2] - v1[3] * cs1[3]; y1[3] = v0[3] * cs1[3] + v1[3] * cs1[2];
                        v0 = y0; v1 = y1; }
                    if constexpr (MODE == 2) {
#pragma unroll
                        for (int e = 0; e < 4; ++e) { v0[e] = fminf(1.f + __expf(-v0[e]), 1e12f); v1[e] = fminf(1.f + __expf(-v1[e]), 1e12f); } }
                    if constexpr (KT) mxk[bj] = fmaxf(fmaxf(mxk[bj], fmaxf(fmaxf(fabsf(v0[0]), fabsf(v0[1])), fmaxf(fabsf(v0[2]), fabsf(v0[3])))), fmaxf(fmaxf(fabsf(v1[0]), fabsf(v1[1])), fmaxf(fabsf(v1[2]), fabsf(v1[3]))));
                    u32x4 w; w.x = cvt_pk_bf16(v0[0], v0[1]); w.y = cvt_pk_bf16(v0[2], v0[3]); w.z = cvt_pk_bf16(v1[0], v1[1]); w.w = cvt_pk_bf16(v1[2], v1[3]);
                    *(u32x4*)(base + (size_t)row * 6144 + col) = w; } }
        if constexpr (KT) {
#pragma unroll
            for (int bj = 0; bj < 2; ++bj) { const float mw = wave_max(mxk[bj]); if (fr == 0 && fq == 0) atomicMax(KINF + ((u.pm * 256) / SEQ) * 8 + 2 * (pn - 3) + bj, __float_as_uint(mw)); } }
    }
    __device__ __forceinline__ void operator()(const pg8::i32x4 (&acc)[2][2][4][2], const pg8::Unit& u, int wr, int wc, int fr, int fq) const {
        const int pn = u.pn;
        if (pn >= 24) run<2, false>(acc, u, wr, wc, fr, fq);
        else if (pn >= 18 && pn < 22) run<1, false>(acc, u, wr, wc, fr, fq);
        else if (pn >= 3 && pn < 6) run<0, true>(acc, u, wr, wc, fr, fq);
        else run<0, false>(acc, u, wr, wc, fr, fq);
    }
};

template <int MODE> struct EpiBranch {
    static constexpr bool PERM = false, AFTER_DRAIN = false, CARRY = false;
    float* YP; bf16_t* YB; const bf16_t* GATES; int gcol;
    __device__ __forceinline__ void operator()(const pg8::f32x4 (&acc)[2][2][4][2], const pg8::Unit& u, int wr, int wc, int fr, int fq) const {
        using pg8::f32x4;
        const int row0 = u.pm * 256 + wr * 64 + fr, col0 = u.pn * 256 + wc * 32 + 4 * fq;
#pragma unroll
        for (int ai = 0; ai < 2; ++ai)
#pragma unroll
            for (int m = 0; m < 4; ++m) { const size_t row = row0 + ai * 128 + m * 16;
#pragma unroll
                for (int bj = 0; bj < 2; ++bj)
#pragma unroll
                    for (int n = 0; n < 2; ++n) { const int col = col0 + bj * 128 + n * 16; const uint2 gw2 = *(const uint2*)(GATES + row * 6144 + gcol + col);
                        f32x4 g; g[0] = __uint_as_float(gw2.x << 16); g[1] = __uint_as_float(gw2.x & 0xffff0000u); g[2] = __uint_as_float(gw2.y << 16); g[3] = __uint_as_float(gw2.y & 0xffff0000u);
                        f32x4 v = g * acc[ai][bj][m][n]; float* yp = YP + row * DM + col;
                        if (MODE >= 1) v = v + *(const f32x4*)yp;
                        if (MODE <= 1) *(f32x4*)yp = v;
                        else { uint2 w; w.x = pg8::cvt_pk_bf16(v[0], v[1]); w.y = pg8::cvt_pk_bf16(v[2], v[3]); *(uint2*)(YB + row * DM + col) = w; } } }
    }
};
struct EpiBranchAll {
    static constexpr bool PERM = false, AFTER_DRAIN = false, CARRY = false;
    float* YP; bf16_t* YB; const bf16_t* GATES;
    __device__ __forceinline__ void operator()(const pg8::f32x4 (&acc)[2][2][4][2], const pg8::Unit& u, int wr, int wc, int fr, int fq) const {
        const pg8::Unit v{u.pm, u.pn & 7}; const int br = u.pn >> 3;
        if (br == 0) { EpiBranch<0> e{YP, YB, GATES, 0}; e(acc, v, wr, wc, fr, fq); }
        else if (br == 1) { EpiBranch<1> e{YP, YB, GATES, 2048}; e(acc, v, wr, wc, fr, fq); }
        else { EpiBranch<2> e{YP, YB, GATES, 4096}; e(acc, v, wr, wc, fr, fq); }
    }
};
struct EpiBranchCarry {
    static constexpr bool PERM = false, AFTER_DRAIN = false, CARRY = true;
    bf16_t* YB; const bf16_t* GATES;
    static __device__ __forceinline__ pg8::f32x4 gate4(const uint2 w) { pg8::f32x4 g; g[0] = __uint_as_float(w.x << 16); g[1] = __uint_as_float(w.x & 0xffff0000u); g[2] = __uint_as_float(w.y << 16); g[3] = __uint_as_float(w.y & 0xffff0000u); return g; }
    __device__ __forceinline__ void operator()(pg8::f32x4 (&acc)[2][2][4][2], const pg8::Unit& u, int wr, int wc, int fr, int fq) const {
        using pg8::f32x4;
        const int br = u.pn >> 3, row0 = u.pm * 256 + wr * 64 + fr, col0 = (u.pn & 7) * 256 + wc * 32 + 4 * fq; const bf16_t* ga = GATES + br * 2048;
        if (br < 2) {
#pragma unroll
            for (int ai = 0; ai < 2; ++ai) { uint2 gq[4][2][2], hq[4][2][2];
#pragma unroll
                for (int m = 0; m < 4; ++m) { const size_t row = row0 + ai * 128 + m * 16;
#pragma unroll
                    for (int bj = 0; bj < 2; ++bj)
#pragma unroll
                        for (int n = 0; n < 2; ++n) { const int col = col0 + bj * 128 + n * 16; gq[m][bj][n] = *(const uint2*)(ga + row * 6144 + col); hq[m][bj][n] = *(const uint2*)(ga + row * 6144 + 2048 + col); } }
                asm volatile("" ::: "memory");
#pragma unroll
                for (int m = 0; m < 4; ++m)
#pragma unroll
                    for (int bj = 0; bj < 2; ++bj)
#pragma unroll
                        for (int n = 0; n < 2; ++n) { const f32x4 g = gate4(gq[m][bj][n]), h = gate4(hq[m][bj][n]);
                            f32x4 r; r[0] = h[0] * __builtin_amdgcn_rcpf(g[0]); r[1] = h[1] * __builtin_amdgcn_rcpf(g[1]); r[2] = h[2] * __builtin_amdgcn_rcpf(g[2]); r[3] = h[3] * __builtin_amdgcn_rcpf(g[3]);
                            acc[ai][bj][m][n] = acc[ai][bj][m][n] * r; } }
        } else {
#pragma unroll
            for (int ai = 0; ai < 2; ++ai) { uint2 gq[4][2][2];
#pragma unroll
                for (int m = 0; m < 4; ++m) { const size_t row = row0 + ai * 128 + m * 16;
#pragma unroll
                    for (int bj = 0; bj < 2; ++bj)
#pragma unroll
                        for (int n = 0; n < 2; ++n) gq[m][bj][n] = *(const uint2*)(ga + row * 6144 + col0 + bj * 128 + n * 16); }
                asm volatile("" ::: "memory");
#pragma unroll
                for (int m = 0; m < 4; ++m) { const size_t row = row0 + ai * 128 + m * 16;
#pragma unroll
                    for (int bj = 0; bj < 2; ++bj)
#pragma unroll
                        for (int n = 0; n < 2; ++n) { const int col = col0 + bj * 128 + n * 16; const f32x4 e4 = gate4(gq[m][bj][n]), a4 = acc[ai][bj][m][n]; const f32x4 v = {a4[0] * __builtin_amdgcn_rcpf(e4[0]), a4[1] * __builtin_amdgcn_rcpf(e4[1]), a4[2] * __builtin_amdgcn_rcpf(e4[2]), a4[3] * __builtin_amdgcn_rcpf(e4[3])};
                            uint2 w; w.x = pg8::cvt_pk_bf16(v[0], v[1]); w.y = pg8::cvt_pk_bf16(v[2], v[3]); *(uint2*)(YB + row * DM + col) = w; } } }
        }
    }
};
struct EpiResidM {
    static constexpr bool PERM = false, AFTER_DRAIN = false, CARRY = false;
    bf16_t* X; const float* gt; const void* Xb; bool xb_f32;
    __device__ __forceinline__ void operator()(const pg8::f32x4 (&acc)[2][2][4][2], const pg8::Unit& u, int wr, int wc, int fr, int fq) const {
        using pg8::f32x4;
        const int row0 = u.pm * 256 + wr * 64 + fr, col0 = u.pn * 256 + wc * 32 + 4 * fq; const float* gtb = gt + (size_t)((u.pm * 256) / SEQ) * NMOD;
        f32x4 g4[2][2];
#pragma unroll
        for (int bj = 0; bj < 2; ++bj)
#pragma unroll
            for (int n = 0; n < 2; ++n) g4[bj][n] = *(const f32x4*)(gtb + col0 + bj * 128 + n * 16);
#pragma unroll
        for (int ai = 0; ai < 2; ++ai) { float4 xq[4][2][2];
#pragma unroll
            for (int m = 0; m < 4; ++m) { const size_t row = row0 + ai * 128 + m * 16;
#pragma unroll
                for (int bj = 0; bj < 2; ++bj)
#pragma unroll
                    for (int n = 0; n < 2; ++n) xq[m][bj][n] = ldx4(Xb, xb_f32, row * DM + col0 + bj * 128 + n * 16); }
            asm volatile("" ::: "memory");
#pragma unroll
            for (int m = 0; m < 4; ++m) { const size_t row = row0 + ai * 128 + m * 16;
#pragma unroll
                for (int bj = 0; bj < 2; ++bj)
#pragma unroll
                    for (int n = 0; n < 2; ++n) { const float4 xb = xq[m][bj][n]; const f32x4 g = g4[bj][n], a = acc[ai][bj][m][n];
                        uint2 w; w.x = pg8::cvt_pk_bf16(xb.x + g[0] * a[0], xb.y + g[1] * a[1]); w.y = pg8::cvt_pk_bf16(xb.z + g[2] * a[2], xb.w + g[3] * a[3]);
                        *(uint2*)(X + row * DM + col0 + bj * 128 + n * 16) = w; } } }
    }
};
struct EpiStoreF32 {
    static constexpr bool PERM = false, AFTER_DRAIN = false, CARRY = false;
    float* C; int ldc;
    __device__ __forceinline__ void operator()(const pg8::f32x4 (&acc)[2][2][4][2], const pg8::Unit& u, int wr, int wc, int fr, int fq) const {
        const int row0 = u.pm * 256 + wr * 64 + fr, col0 = u.pn * 256 + wc * 32 + 4 * fq;
#pragma unroll
        for (int ai = 0; ai < 2; ++ai)
#pragma unroll
            for (int m = 0; m < 4; ++m) { const size_t row = row0 + ai * 128 + m * 16;
#pragma unroll
                for (int bj = 0; bj < 2; ++bj)
#pragma unroll
                    for (int n = 0; n < 2; ++n) *(pg8::f32x4*)(C + row * ldc + col0 + bj * 128 + n * 16) = acc[ai][bj][m][n]; }
    }
};

__device__ __forceinline__ int win_src_col(int n) {
    if (n >= 6144) return n + 6;
    if (n >= C_DQ && n < C_DV) { const int p = n & 63, base = n & ~63, j = p >> 3, m = p & 3, hi = (p >> 2) & 1; return base + (hi ? 32 : 0) + 4 * j + m; }
    return n;
}
__device__ __forceinline__ void transpose_item_win8(const float* W, signed char* WT, const unsigned* cmax, float* scr, int kb, int nb, int lane) {
    const int k0 = 64 * kb, n0 = 32 * nb; const int sc = win_src_col(n0 + (lane & 31)); const float q = 127.f / fmaxf(__uint_as_float(cmax[n0 + (lane & 31)]), 1e-30f);
#pragma unroll
    for (int i = 0; i < 32; ++i) { const int kk = 2 * i + (lane >> 5); scr[kk * 33 + (lane & 31)] = W[(size_t)(k0 + kk) * INW + sc] * q; }
    const int c = lane & 7;
#pragma unroll
    for (int j = 0; j < 4; ++j) { const int n = (lane >> 3) + 8 * j; const float* sp = scr + (8 * c) * 33 + n;
        uint2 o; o.x = pk_i8x4(sp[0 * 33], sp[1 * 33], sp[2 * 33], sp[3 * 33]); o.y = pk_i8x4(sp[4 * 33], sp[5 * 33], sp[6 * 33], sp[7 * 33]);
        *(uint2*)(WT + (size_t)(n0 + n) * DM + k0 + 8 * c) = o; }
}
struct EpiPeerHid {
    static constexpr bool PERM = true, AFTER_DRAIN = false;
    const unsigned char* Sm; const float* SH; const float* SU; float* HID;
    __device__ __forceinline__ void operator()(const pg8::i32x4 (&acc)[2][2][4][2], const pg8::Unit& u, int wr, int wc, int fr, int fq) const {
        using pg8::f32x4;
        const int row0 = u.pm * 256 + wr * 64 + fr, col0 = u.pn * 256 + wc * 32 + 8 * fq;
        f32x4 su[2][2];
#pragma unroll
        for (int bj = 0; bj < 2; ++bj) { su[bj][0] = *(const f32x4*)(SU + col0 + bj * 128); su[bj][1] = *(const f32x4*)(SU + col0 + bj * 128 + 4); }
        uint2 w[2][4][2]; float shr[2][4];
#pragma unroll
        for (int ai = 0; ai < 2; ++ai)
#pragma unroll
            for (int m = 0; m < 4; ++m) { const size_t row = row0 + ai * 128 + m * 16; shr[ai][m] = SH[row];
#pragma unroll
                for (int bj = 0; bj < 2; ++bj) w[ai][m][bj] = *(const uint2*)(Sm + (((size_t)u.pm * 64 + u.pn) * 256 + (row & 255)) * 256 + (col0 & 255) + bj * 128); }
#pragma unroll
        for (int ai = 0; ai < 2; ++ai)
#pragma unroll
            for (int m = 0; m < 4; ++m) { const size_t row = row0 + ai * 128 + m * 16;
#pragma unroll
                for (int bj = 0; bj < 2; ++bj) { const uint2 ww = w[ai][m][bj];
                    if ((ww.x | ww.y) != 0u) {
                        const pg8::i32x4 v0 = acc[ai][bj][m][0], v1 = acc[ai][bj][m][1];
                        const int hv[8] = {v0[0], v0[1], v0[2], v0[3], v1[0], v1[1], v1[2], v1[3]};
                        const float sc[8] = {su[bj][0][0], su[bj][0][1], su[bj][0][2], su[bj][0][3], su[bj][1][0], su[bj][1][1], su[bj][1][2], su[bj][1][3]};
#pragma unroll
                        for (int e = 0; e < 8; ++e) { const unsigned sb = ((e < 4 ? ww.x : ww.y) >> (8 * (e & 3))) & 0xffu;
                            if (sb != 0u) HID[row * PE_E + (sb - 1u)] = (float)hv[e] * shr[ai][m] * sc[e]; } } } }
    }
};
struct EpiStoreI8 {
    static constexpr bool PERM = false, AFTER_DRAIN = false;
    float* C; int ldc; const float* SH; const float* SC;
    __device__ __forceinline__ void operator()(const pg8::i32x4 (&acc)[2][2][4][2], const pg8::Unit& u, int wr, int wc, int fr, int fq) const {
        using pg8::f32x4;
        const int row0 = u.pm * 256 + wr * 64 + fr, col0 = u.pn * 256 + wc * 32 + 4 * fq;
        float sh[2][4]; f32x4 sc[2][2];
#pragma unroll
        for (int ai = 0; ai < 2; ++ai)
#pragma unroll
            for (int m = 0; m < 4; ++m) sh[ai][m] = SH[row0 + ai * 128 + m * 16];
#pragma unroll
        for (int bj = 0; bj < 2; ++bj)
#pragma unroll
            for (int n = 0; n < 2; ++n) sc[bj][n] = *(const f32x4*)(SC + col0 + bj * 128 + n * 16);
        asm volatile("" ::: "memory");
#pragma unroll
        for (int ai = 0; ai < 2; ++ai)
#pragma unroll
            for (int m = 0; m < 4; ++m) { const size_t row = row0 + ai * 128 + m * 16;
#pragma unroll
                for (int bj = 0; bj < 2; ++bj)
#pragma unroll
                    for (int n = 0; n < 2; ++n) { const int col = col0 + bj * 128 + n * 16; const pg8::i32x4 a = acc[ai][bj][m][n]; const f32x4 q = sc[bj][n] * sh[ai][m];
                        *(f32x4*)(C + row * ldc + col) = (f32x4){(float)a[0] * q[0], (float)a[1] * q[1], (float)a[2] * q[2], (float)a[3] * q[3]}; } }
    }
};
struct EpiResidI8 {
    static constexpr bool PERM = false, AFTER_DRAIN = false;
    bf16_t* X; const float* gt; const float* SA;
    __device__ __forceinline__ void operator()(const pg8::i32x4 (&acc)[2][2][4][2], const pg8::Unit& u, int wr, int wc, int fr, int fq) const {
        using pg8::f32x4;
        const int row0 = u.pm * 256 + wr * 64 + fr, col0 = u.pn * 256 + wc * 32 + 4 * fq; const float* gtb = gt + (size_t)((u.pm * 256) / SEQ) * NMOD;
        f32x4 g4[2][2];
#pragma unroll
        for (int bj = 0; bj < 2; ++bj)
#pragma unroll
            for (int n = 0; n < 2; ++n) g4[bj][n] = *(const f32x4*)(gtb + col0 + bj * 128 + n * 16);
#pragma unroll
        for (int ai = 0; ai < 2; ++ai) { uint2 xw[4][2][2]; float sa[4];
#pragma unroll
            for (int m = 0; m < 4; ++m) { const size_t row = row0 + ai * 128 + m * 16; sa[m] = SA[row];
#pragma unroll
                for (int bj = 0; bj < 2; ++bj)
#pragma unroll
                    for (int n = 0; n < 2; ++n) xw[m][bj][n] = *(const uint2*)(X + row * DM + col0 + bj * 128 + n * 16); }
            asm volatile("" ::: "memory");
#pragma unroll
            for (int m = 0; m < 4; ++m) { const size_t row = row0 + ai * 128 + m * 16;
#pragma unroll
                for (int bj = 0; bj < 2; ++bj)
#pragma unroll
                    for (int n = 0; n < 2; ++n) { const pg8::i32x4 a = acc[ai][bj][m][n]; const uint2 xq = xw[m][bj][n]; const f32x4 g = g4[bj][n]; const float s_ = sa[m];
                        uint2 w; w.x = pg8::cvt_pk_bf16(__uint_as_float(xq.x << 16) + g[0] * ((float)a[0] * s_), __uint_as_float(xq.x & 0xffff0000u) + g[1] * ((float)a[1] * s_));
                        w.y = pg8::cvt_pk_bf16(__uint_as_float(xq.y << 16) + g[2] * ((float)a[2] * s_), __uint_as_float(xq.y & 0xffff0000u) + g[3] * ((float)a[3] * s_));
                        *(uint2*)(X + row * DM + col0 + bj * 128 + n * 16) = w; } } }
    }
};

template <bool MAPW>
__device__ __forceinline__ void transpose_item(const float* W, int ldw, bf16_t* WT, int K, float* scr, int kb, int nb, int lane) {
    const int k0 = 64 * kb, n0 = 32 * nb; const int sc = MAPW ? win_src_col(n0 + (lane & 31)) : (n0 + (lane & 31));
#pragma unroll
    for (int i = 0; i < 32; ++i) { const int kk = 2 * i + (lane >> 5); scr[kk * 33 + (lane & 31)] = ldnt1(W + (size_t)(k0 + kk) * ldw + sc); }
    const int c = lane & 7;
#pragma unroll
    for (int j = 0; j < 4; ++j) { const int n = (lane >> 3) + 8 * j; const float* sp = scr + (8 * c) * 33 + n;
        pg8::u32x4 o; o.x = pg8::cvt_pk_bf16(sp[0 * 33], sp[1 * 33]); o.y = pg8::cvt_pk_bf16(sp[2 * 33], sp[3 * 33]); o.z = pg8::cvt_pk_bf16(sp[4 * 33], sp[5 * 33]); o.w = pg8::cvt_pk_bf16(sp[6 * 33], sp[7 * 33]);
        *(pg8::u32x4*)(WT + (size_t)(n0 + n) * K + k0 + 8 * c) = o; }
}

namespace att {
typedef short bf16x8 __attribute__((ext_vector_type(8)));
typedef short s16x4 __attribute__((ext_vector_type(4)));
typedef float f32x16 __attribute__((ext_vector_type(16)));
typedef float f32x4 __attribute__((ext_vector_type(4)));
typedef unsigned u32x4 __attribute__((ext_vector_type(4)));
constexpr int SHM_K = 16384, SHM_V = 16384;
constexpr int OFF_V = 0, OFF_K = 2 * SHM_V, OFF_CK = 2 * SHM_V + 2 * SHM_K, OFF_WS = OFF_CK + 512, OFF_Q = OFF_WS + 8 * 64 * 4, LDS_ATT = OFF_Q + 8 * 8 * 1024;
constexpr float LOG2E = 1.4426950408889634f;
#define KSWZ(row, colB) ((row) * 256 + ((colB) ^ (((row) & 7) << 4)))
#define SBAR() __builtin_amdgcn_sched_barrier(0)
__device__ __forceinline__ int v_st(int k, int c) { const int kk = (k & ~0xC) | ((k & 4) << 1) | ((k & 8) >> 1); return ((kk >> 3) * 4 + (c >> 5)) * 512 + ((kk & 7) * 32 + (c & 31)) * 2; }
__device__ __forceinline__ int v_rd_base(int lane) { return ((lane & 3) << 3) | (((lane >> 2) & 3) << 6) | (((lane >> 4) & 1) << 5) | (((lane >> 5) & 1) << 8); }
constexpr int v_rd_off(int d0, int ks, int half) { return d0 * 512 + ks * 4096 + half * 2048; }
__device__ __forceinline__ int crow(int r, int hi) { return (r & 3) + 8 * (r >> 2) + 4 * hi; }
__device__ __forceinline__ unsigned cvtpk(float lo, float hi) { unsigned r; asm volatile("v_cvt_pk_bf16_f32 %0, %1, %2" : "=v"(r) : "v"(lo), "v"(hi)); return r; }
__device__ __forceinline__ float psum2(float v) { auto rr = __builtin_amdgcn_permlane32_swap(__float_as_uint(v), __float_as_uint(v), false, false); return __uint_as_float(rr[0]) + __uint_as_float(rr[1]); }
__device__ __forceinline__ float pmax2(float v) { auto rr = __builtin_amdgcn_permlane32_swap(__float_as_uint(v), __float_as_uint(v), false, false); return fmaxf(__uint_as_float(rr[0]), __uint_as_float(rr[1])); }

template <int KB, int D0, int D1>
__device__ __forceinline__ void qkt(f32x16& p0, f32x16& p1, const char* K_lds, int r32, int hi, const char* qr) {
    p0 = f32x16{}; p1 = f32x16{};
    const char* kb[4];
#pragma unroll
    for (int dd = 0; dd < 4; ++dd) kb[dd] = K_lds + KB * SHM_K + KSWZ(r32, (dd * 16 + hi * 8) * 2);
#pragma unroll
    for (int d0 = D0; d0 < D1; ++d0) { const char* a = kb[d0 & 3] + (d0 >> 2) * 128;
        bf16x8 b0 = *reinterpret_cast<const bf16x8*>(a);
        bf16x8 b1 = *reinterpret_cast<const bf16x8*>(a + 32 * 256);
        const bf16x8 qf = *reinterpret_cast<const bf16x8*>(qr + d0 * 1024);
        p0 = __builtin_amdgcn_mfma_f32_32x32x16_bf16(b0, qf, p0, 0, 0, 0);
        p1 = __builtin_amdgcn_mfma_f32_32x32x16_bf16(b1, qf, p1, 0, 0, 0); }
}
template <int VB>
__device__ __forceinline__ void pv_tile(f32x16* o, int vb0, bf16x8 pa0, bf16x8 pa1, bf16x8 pa2, bf16x8 pa3) {
#define TRRD(dst, off) asm volatile("ds_read_b64_tr_b16 %0, %1 offset:%2" : "=&v"(dst) : "v"(vb0), "i"(off) : "memory")
#define PV_D0(d0) do { s16x4 l0, l1, l2, l3, h0, h1, h2, h3; constexpr int b_ = VB * SHM_V + v_rd_off(d0, 0, 0); \
        TRRD(l0, b_); TRRD(h0, b_ + 2048); TRRD(l1, b_ + 4096); TRRD(h1, b_ + 6144); TRRD(l2, b_ + 8192); TRRD(h2, b_ + 10240); TRRD(l3, b_ + 12288); TRRD(h3, b_ + 14336); \
        asm volatile("s_waitcnt lgkmcnt(0)" ::: "memory"); SBAR(); \
        o[d0] = __builtin_amdgcn_mfma_f32_32x32x16_bf16(pa0, (bf16x8){l0[0], l0[1], l0[2], l0[3], h0[0], h0[1], h0[2], h0[3]}, o[d0], 0, 0, 0); \
        o[d0] = __builtin_amdgcn_mfma_f32_32x32x16_bf16(pa1, (bf16x8){l1[0], l1[1], l1[2], l1[3], h1[0], h1[1], h1[2], h1[3]}, o[d0], 0, 0, 0); \
        o[d0] = __builtin_amdgcn_mfma_f32_32x32x16_bf16(pa2, (bf16x8){l2[0], l2[1], l2[2], l2[3], h2[0], h2[1], h2[2], h2[3]}, o[d0], 0, 0, 0); \
        o[d0] = __builtin_amdgcn_mfma_f32_32x32x16_bf16(pa3, (bf16x8){l3[0], l3[1], l3[2], l3[3], h3[0], h3[1], h3[2], h3[3]}, o[d0], 0, 0, 0); } while (0)
    PV_D0(0); PV_D0(1); PV_D0(2); PV_D0(3);
#undef PV_D0
#undef TRRD
}
__device__ __forceinline__ void pack_p(const f32x16& p0, const f32x16& p1, bf16x8& pa0, bf16x8& pa1, bf16x8& pa2, bf16x8& pa3) {
#define PK4(P, B_, OUT) do { unsigned a0 = cvtpk(P[B_+0], P[B_+1]), a1 = cvtpk(P[B_+2], P[B_+3]); \
        unsigned b0 = cvtpk(P[B_+4], P[B_+5]), b1 = cvtpk(P[B_+6], P[B_+7]); \
        auto r0 = __builtin_amdgcn_permlane32_swap(a0, b0, false, false); auto r1 = __builtin_amdgcn_permlane32_swap(a1, b1, false, false); \
        u32x4 w = {r0[0], r1[0], r0[1], r1[1]}; OUT = *reinterpret_cast<bf16x8*>(&w); } while (0)
    PK4(p0, 0, pa0); PK4(p0, 8, pa1); PK4(p1, 0, pa2); PK4(p1, 8, pa3);
#undef PK4
}
__device__ __forceinline__ void mask_tile(f32x16& p0, f32x16& p1, int dq) {
    const float NEG = -__builtin_inff();
#pragma unroll
    for (int r = 0; r < 16; ++r) { const int c = (r & 3) + 8 * (r >> 2); if (dq - c < 0) p0[r] = NEG; if (dq - c - 32 < 0) p1[r] = NEG; }
}
constexpr float THR2 = 11.5f;
__device__ __forceinline__ float softmax_step(f32x16& p0, f32x16& p1, float& m_reg, float& l_reg) {
    float pmax = p0[0];
#pragma unroll
    for (int r = 1; r < 16; ++r) pmax = fmaxf(pmax, p0[r]);
#pragma unroll
    for (int r = 0; r < 16; ++r) pmax = fmaxf(pmax, p1[r]);
    pmax = pmax2(pmax);
    float alpha = 1.f;
    if (!__all(pmax - m_reg <= THR2)) { const float mn = fmaxf(m_reg, pmax); alpha = __builtin_amdgcn_exp2f(m_reg - mn); m_reg = mn; }
    float ps = 0.f;
#pragma unroll
    for (int r = 0; r < 16; ++r) { p0[r] = __builtin_amdgcn_exp2f(p0[r] - m_reg); ps += p0[r]; }
#pragma unroll
    for (int r = 0; r < 16; ++r) { p1[r] = __builtin_amdgcn_exp2f(p1[r] - m_reg); ps += p1[r]; }
    l_reg = l_reg * alpha + psum2(ps);
    return alpha;
}
__device__ __forceinline__ void rescale_o(f32x16* o, float alpha, float* al_l, int r32, int hi) {
    if (__any(alpha < 1.f)) { if (hi == 0) al_l[r32] = alpha; asm volatile("s_waitcnt lgkmcnt(0)" ::: "memory");
#pragma unroll
        for (int r = 0; r < 16; ++r) { const float a = al_l[crow(r, hi)];
#pragma unroll
            for (int d = 0; d < 4; ++d) o[d][r] *= a; } }
}

template <int MODE, int KB>
__device__ __forceinline__ void tile_compute(const int t, const int q0, const int r32, const int hi, const char* K_lds, const int vb0, const float* ck_l, float* al_l, const char* qr,
                                             f32x16* o, f32x16* o2, float& m1, float& l1, float& m2, float& l2, float& carry, const float cq2) {
    constexpr float C2 = (MODE >= 2 ? 0.125f : 0.08838834764831845f) * LOG2E;
    const int dq = q0 + r32 - t * 64 - 4 * hi;
    bf16x8 pa0, pa1, pa2, pa3; f32x16 p0, p1;
    if constexpr (MODE == 0) {
        qkt<KB, 0, 8>(p0, p1, K_lds, r32, hi, qr);
        const float* ck = ck_l + KB * 64 + 4 * hi;
#pragma unroll
        for (int g = 0; g < 4; ++g) { const f32x4 c0 = *(const f32x4*)(ck + 8 * g), c1 = *(const f32x4*)(ck + 32 + 8 * g);
#pragma unroll
            for (int e = 0; e < 4; ++e) { p0[4 * g + e] = fmaf(p0[4 * g + e], C2, cq2 - c0[e]); p1[4 * g + e] = fmaf(p1[4 * g + e], C2, cq2 - c1[e]); } }
        if (t * 64 + 63 > q0) mask_tile(p0, p1, dq);
        const float alpha = softmax_step(p0, p1, m1, l1);
        pack_p(p0, p1, pa0, pa1, pa2, pa3);
        rescale_o(o, alpha, al_l, r32, hi);
        pv_tile<KB>(o, vb0, pa0, pa1, pa2, pa3);
    } else if constexpr (MODE == 1) {
        qkt<KB, 0, 8>(p0, p1, K_lds, r32, hi, qr);
        const bool nm = (t * 64 + 63 >= q0);
        f32x16 k0, k1; float gs[8];
#pragma unroll
        for (int r = 0; r < 16; ++r) { const int c = (r & 3) + 8 * (r >> 2);
            { const float z2 = p0[r] * C2, sp = fmaxf(z2, 0.f) + __builtin_amdgcn_logf(1.f + __builtin_amdgcn_exp2f(-fabsf(z2))); const bool valid = !nm || (dq - c - 1 >= 0);
              p0[r] = valid ? (z2 - sp) : -__builtin_inff(); k0[r] = valid ? -sp : 0.f; }
            { const float z2 = p1[r] * C2, sp = fmaxf(z2, 0.f) + __builtin_amdgcn_logf(1.f + __builtin_amdgcn_exp2f(-fabsf(z2))); const bool valid = !nm || (dq - c - 33 >= 0);
              p1[r] = valid ? (z2 - sp) : -__builtin_inff(); k1[r] = valid ? -sp : 0.f; } }
#pragma unroll
        for (int g = 0; g < 4; ++g) { gs[g] = (k0[4 * g] + k0[4 * g + 1]) + (k0[4 * g + 2] + k0[4 * g + 3]); gs[4 + g] = (k1[4 * g] + k1[4 * g + 1]) + (k1[4 * g + 2] + k1[4 * g + 3]); }
        float run = carry;
#pragma unroll
        for (int g = 7; g >= 0; --g) {
            const float tot = psum2(gs[g]); float base = run + (hi == 0 ? (tot - gs[g]) : 0.f);
#pragma unroll
            for (int e = 3; e >= 0; --e) { const int r = 4 * (g & 3) + e;
                if (g >= 4) { const float w = __builtin_amdgcn_exp2f(p1[r] + base); base += k1[r]; p1[r] = w; }
                else { const float w = __builtin_amdgcn_exp2f(p0[r] + base); base += k0[r]; p0[r] = w; } }
            run += tot; }
        carry = run;
        pack_p(p0, p1, pa0, pa1, pa2, pa3);
        pv_tile<KB>(o, vb0, pa0, pa1, pa2, pa3);
    } else {
        qkt<KB, (MODE == 2 ? 0 : 4), (MODE == 2 ? 4 : 8)>(p0, p1, K_lds, r32, hi, qr);
#pragma unroll
        for (int r = 0; r < 16; ++r) { p0[r] *= C2; p1[r] *= C2; }
        const float a1 = softmax_step(p0, p1, m1, l1);
        pack_p(p0, p1, pa0, pa1, pa2, pa3);
        rescale_o(o, a1, al_l, r32, hi);
        pv_tile<KB>(o, vb0, pa0, pa1, pa2, pa3);
    }
}

template <int MODE>
__device__ __forceinline__ void attn_unit(const int tid, char* lds, const bf16_t* ATT, const float* CUM2, bf16_t* OB, float* ODF, int b, int h, int qb, const unsigned* KINF, unsigned char* Gz, const unsigned rank) {
    const int wid = __builtin_amdgcn_readfirstlane(tid >> 6), lane = tid & 63, r32 = lane & 31, hi = lane >> 5;
    const int qc = (MODE == 0 ? C_FQ : MODE == 1 ? C_SQ : C_DQ) + h * 128, kc = (MODE == 0 ? C_FK : MODE == 1 ? C_SK : C_DK) + h * 128, vc = (MODE == 0 ? C_FV : MODE == 1 ? C_SV : C_DV) + h * 128;
    const int oc = (MODE == 0 ? 0 : MODE == 1 ? 768 : 1536) + h * 128;
    const size_t rowb = (size_t)b * SEQ;
    const int q0 = qb * 256 + wid * 32;
    const int NT = 4 * qb + 4;
    char* V_lds = lds + OFF_V; char* K_lds = lds + OFF_K; float* ck_l = (float*)(lds + OFF_CK); float* wsl = (float*)(lds + OFF_WS) + wid * 64; float* li_l = wsl; float* al_l = wsl + 32;
    const int vb0 = (int)(uintptr_t)V_lds + v_rd_base(lane);
    int koff, voff;
    { const int row = tid >> 4, cb = (tid & 15) ^ (row & 7); koff = row * 6144 + cb * 8;
      const int sub = tid >> 5, w = tid & 31, kk = (sub >> 2) * 8 + (w >> 2), k = (kk & ~0xC) | ((kk & 4) << 1) | ((kk & 8) >> 1); voff = k * 6144 + (sub & 3) * 32 + (w & 3) * 8; }
    const bf16_t* Kg = ATT + rowb * 6144 + kc; const bf16_t* Vg = ATT + rowb * 6144 + vc;
    const float* cumh = CUM2 + (size_t)(b * 6 + h) * SEQ;
    LAS char* ldsl = (LAS char*)lds;
    char* qr = lds + OFF_Q + wid * 8192 + lane * 16;
    float qa = 0.f;
#pragma unroll
    for (int d0 = 0; d0 < 8; ++d0) { const bf16x8 f = *(const bf16x8*)(ATT + (rowb + q0 + r32) * 6144 + qc + d0 * 16 + hi * 8); *(bf16x8*)(qr + d0 * 1024) = f;
        if (MODE == 0) {
#pragma unroll
            for (int e = 0; e < 8; ++e) qa += fabsf(__uint_as_float(((unsigned)(unsigned short)f[e]) << 16)); } }
    f32x16 o[4] = {}; f32x16 o2[1] = {};
    float m1 = -1e30f, l1 = 0.f, m2 = -1e30f, l2 = 0.f, carry = 0.f, cq2 = 0.f;
    if (MODE == 0) cq2 = cumh[q0 + r32];
    float ub = 0.f; bool deadw = false;
    if (MODE == 0) ub = psum2(qa) * (__uint_as_float(KINF[b * 8 + h]) * 1.01f) * (0.08838834764831845f * LOG2E) + 1.f;
#define TILE(i) ((MODE <= 1) ? (NT - 1 - (i)) : (i))
#define STAGE(t, bf) do { const bf16_t* kp_ = Kg + (size_t)(t) * (64 * 6144) + koff; const bf16_t* vp_ = Vg + (size_t)(t) * (64 * 6144) + voff; \
        __builtin_amdgcn_global_load_lds((const unsigned*)kp_, (LAS unsigned*)(ldsl + OFF_K + (bf) * SHM_K + wid * 1024), 16, 0, 0); \
        __builtin_amdgcn_global_load_lds((const unsigned*)(kp_ + 32 * 6144), (LAS unsigned*)(ldsl + OFF_K + (bf) * SHM_K + 8192 + wid * 1024), 16, 0, 0); \
        __builtin_amdgcn_global_load_lds((const unsigned*)vp_, (LAS unsigned*)(ldsl + OFF_V + (bf) * SHM_V + wid * 1024), 16, 0, 0); \
        __builtin_amdgcn_global_load_lds((const unsigned*)(vp_ + 32 * 6144), (LAS unsigned*)(ldsl + OFF_V + (bf) * SHM_V + 8192 + wid * 1024), 16, 0, 0); \
        if (MODE == 0 && wid == 0) __builtin_amdgcn_global_load_lds((const unsigned*)(cumh + (t) * 64 + lane), (LAS unsigned*)(ldsl + OFF_CK + (bf) * 256), 4, 0, 0); } while (0)
#define ACTIVE(t) ((MODE == 0) ? ((t) * 64 <= q0 + 31) : (MODE == 1) ? ((t) * 64 < q0 + 31) : ((t) * 64 <= q0))
    volatile int* dn_l = (volatile int*)(lds + (MODE == 1 ? OFF_CK : OFF_WS));
    bool stop = false;
    unsigned zz_ = 0u; asm volatile("" : "+v"(zz_)); const u32x4 zv_ = {zz_, zz_, zz_, zz_}; int zk_ = 0;
#define ZST(k) do { const unsigned o_ = (unsigned)(k) * 512u + (unsigned)tid; const size_t g_ = (size_t)rank * 13108u + o_; if (o_ < 13108u && g_ < (size_t)(NB * SEQ) * 1024u) ((u32x4*)Gz)[g_] = zv_; } while (0)
#define BODY(i, KB) do { const int t_ = TILE(i); \
        if (zk_ < 26) { ZST(zk_); ZST(zk_ + 1); zk_ += 2; } \
        if ((i) + 1 < NT) STAGE(TILE((i) + 1), (KB) ^ 1); \
        const bool dead_ = (MODE == 1) ? __all(carry < -130.f) : deadw; \
        if (ACTIVE(t_) && !dead_) { tile_compute<MODE, KB>(t_, q0, r32, hi, K_lds, vb0, ck_l, al_l, qr, o, o2, m1, l1, m2, l2, carry, cq2); \
            if (MODE == 0) deadw = __all(ub + cq2 - ck_l[(KB) * 64] - m1 < -130.f); } \
        if (MODE <= 1 && lane == 0) dn_l[(KB) * 8 + wid] = ((MODE == 0 ? deadw : dead_) || t_ == 0) ? 1 : 0;     \
        asm volatile("s_waitcnt vmcnt(0) lgkmcnt(0)" ::: "memory"); __syncthreads(); \
        if (MODE <= 1) { int a_ = 1; _Pragma("unroll") for (int w_ = 0; w_ < 8; ++w_) a_ &= dn_l[(KB) * 8 + w_]; stop = (a_ != 0); } } while (0)
    STAGE(TILE(0), 0); asm volatile("s_waitcnt vmcnt(0)" ::: "memory"); __syncthreads();
    for (int i = 0; i < NT; i += 2) { BODY(i, 0); if (MODE <= 1 && stop) break; BODY(i + 1, 1); if (MODE <= 1 && stop) break; }
    if (MODE <= 1) __syncthreads();
    for (; zk_ < 26; ++zk_) ZST(zk_);
    if (MODE != 1) { if (hi == 0) li_l[r32] = 1.f / l1; }
    asm volatile("s_waitcnt lgkmcnt(0)" ::: "memory");
    if (MODE != 1) {
#pragma unroll
        for (int r = 0; r < 16; ++r) { const float f1 = li_l[crow(r, hi)];
#pragma unroll
            for (int d = 0; d < 4; ++d) o[d][r] *= f1; }
    }
    if (MODE >= 2) {
        float* Ow = ODF + ((size_t)(MODE - 2) * (NB * SEQ) + rowb + q0) * 512 + h * 128;
#pragma unroll
        for (int r = 0; r < 16; ++r) { const int orow = crow(r, hi);
#pragma unroll
            for (int d = 0; d < 4; ++d) Ow[(size_t)orow * 512 + d * 32 + r32] = o[d][r]; }
    } else {
        bf16_t* Ow = OB + (rowb + q0) * DM + oc;
#pragma unroll
        for (int r = 0; r < 16; ++r) { const int orow = crow(r, hi);
#pragma unroll
            for (int d = 0; d < 4; ++d) { const float v = o[d][r]; const float vn = __shfl_xor(v, 1);
                if ((r32 & 1) == 0) *(unsigned*)(Ow + (size_t)orow * DM + d * 32 + r32) = cvtpk(v, vn); } }
    }
    __syncthreads();
#undef TILE
#undef STAGE
#undef ACTIVE
#undef BODY
#undef ZST
}
#undef KSWZ
#undef SBAR
}

namespace topk {
using att::f32x16; using att::bf16x8;
constexpr int CA[64] = {0, 0, 0, 0, 0, 0, 0, 0, 0, 0, 0, 0, 0, 0, 0, 0, 1, 1, 1, 1, 1, 1, 1, 1, 2, -1, -1, -1, -1, -1, -1, -1, 2, 2, 2, 2, 3, 3, 3, 3, 4, 4, 4, 5, 5, 6, 6, 7, 7, 8, 9, 10, 11, 12, 13, 14, 15, -1, -1, -1, -1, -1, -1, -1};
constexpr int CB[64] = {0, 1, 2, 3, 4, 5, 6, 7, 8, 9, 10, 11, 12, 13, 14, 15, 0, 1, 2, 3, 4, 5, 6, 7, 0, -1, -1, -1, -1, -1, -1, -1, 1, 2, 3, 4, 0, 1, 2, 3, 0, 1, 2, 0, 1, 0, 1, 0, 1, 0, 0, 0, 0, 0, 0, 0, 0, -1, -1, -1, -1, -1, -1, -1};
__device__ __forceinline__ unsigned mono(float f) { const unsigned u = __float_as_uint(f); return u ^ ((unsigned)((int)u >> 31) | 0x80000000u); }
__device__ __forceinline__ float unmono(unsigned k) { return __uint_as_float((k & 0x80000000u) ? (k ^ 0x80000000u) : ~k); }
__device__ __forceinline__ unsigned umax_(unsigned a, unsigned b) { return a > b ? a : b; }
__device__ __forceinline__ unsigned umin_(unsigned a, unsigned b) { return a < b ? a : b; }
__device__ __forceinline__ unsigned partner_u(unsigned v, int hi) { auto rr = __builtin_amdgcn_permlane32_swap(v, v, false, false); return hi ? rr[0] : rr[1]; }

template <int N> __device__ __forceinline__ void sort_blocks16(unsigned (&x)[N]) {
#pragma unroll
    for (int k = 2; k <= 16; k <<= 1)
#pragma unroll
        for (int j = k >> 1; j > 0; j >>= 1)
#pragma unroll
            for (int i = 0; i < N; ++i) { const int l = i ^ j; if (l > i) { const bool desc = ((i & k) == 0); const unsigned a = x[i], b = x[l], mx = umax_(a, b), mn = umin_(a, b); x[i] = desc ? mx : mn; x[l] = desc ? mn : mx; } }
}
template <bool DESC> __device__ __forceinline__ void merge16(unsigned (&x)[16]) {
#pragma unroll
    for (int j = 8; j > 0; j >>= 1)
#pragma unroll
        for (int i = 0; i < 16; ++i) { const int l = i ^ j; if (l > i) { const unsigned a = x[i], b = x[l], mx = umax_(a, b), mn = umin_(a, b); x[i] = DESC ? mx : mn; x[l] = DESC ? mn : mx; } }
}
__device__ __forceinline__ void top16_of_pair(unsigned (&x)[64], unsigned (&w)[16], int hi) {
    sort_blocks16<64>(x);
    unsigned y[16], z[16];
#pragma unroll
    for (int i = 0; i < 16; ++i) { y[i] = umax_(x[i], x[16 + i]); z[i] = umax_(x[32 + i], x[48 + i]); }
    merge16<true>(y); merge16<false>(z);
#pragma unroll
    for (int i = 0; i < 16; ++i) w[i] = umax_(y[i], z[i]);
    merge16<true>(w);
    unsigned pr[16];
#pragma unroll
    for (int i = 0; i < 16; ++i) pr[i] = partner_u(w[i], hi);
#pragma unroll
    for (int i = 0; i < 16; ++i) w[i] = umax_(w[i], pr[15 - i]);
    merge16<true>(w);
}
__device__ __forceinline__ void ce2(float& va, unsigned& pa, float& vb, unsigned& pb, bool desc) {
    const bool sw = desc ? (vb > va) : (va > vb); const float tv = sw ? vb : va, uv = sw ? va : vb; const unsigned tp = sw ? pb : pa, up = sw ? pa : pb; va = tv; pa = tp; vb = uv; pb = up;
}
__device__ __forceinline__ void merge16v(float (&v)[16], unsigned (&p)[16]) {
#pragma unroll
    for (int j = 8; j > 0; j >>= 1)
#pragma unroll
        for (int i = 0; i < 16; ++i) { const int l = i ^ j; if (l > i) ce2(v[i], p[i], v[l], p[l], true); }
}

__device__ __forceinline__ void scores_half(f32x16& pA, f32x16& pB, f32x16& pC, f32x16& pD, const char* imgs, int r32, int hi, const float* qrow) {
    pA = f32x16{}; pB = f32x16{}; pC = f32x16{}; pD = f32x16{};
    int kb[4];
#pragma unroll
    for (int dd = 0; dd < 4; ++dd) kb[dd] = r32 * 256 + (((dd * 16 + hi * 8) * 2) ^ ((r32 & 7) << 4));
    att::f32x4 qa[4], qb[4];
#pragma unroll
    for (int d0 = 0; d0 < 4; ++d0) { qa[d0] = *(const att::f32x4*)(qrow + d0 * 16 + hi * 8); qb[d0] = *(const att::f32x4*)(qrow + d0 * 16 + hi * 8 + 4); }
#pragma unroll
    for (int d0 = 0; d0 < 8; ++d0) { const int a = kb[d0 & 3] + (d0 >> 2) * 128;
        const att::f32x4 fa = d0 < 4 ? qa[d0 & 3] : *(const att::f32x4*)(qrow + d0 * 16 + hi * 8), fb = d0 < 4 ? qb[d0 & 3] : *(const att::f32x4*)(qrow + d0 * 16 + hi * 8 + 4);
        const float f[8] = {fa[0], fa[1], fa[2], fa[3], fb[0], fb[1], fb[2], fb[3]}; unsigned hw[4], lw[4];
#pragma unroll
        for (int e = 0; e < 4; ++e) { const unsigned h2 = att::cvtpk(f[2 * e], f[2 * e + 1]); hw[e] = h2;
            lw[e] = att::cvtpk(f[2 * e] - __uint_as_float(h2 << 16), f[2 * e + 1] - __uint_as_float(h2 & 0xffff0000u)); }
        att::u32x4 hv = {hw[0], hw[1], hw[2], hw[3]}, lv = {lw[0], lw[1], lw[2], lw[3]}; const bf16x8 qh = *reinterpret_cast<bf16x8*>(&hv), ql = *reinterpret_cast<bf16x8*>(&lv);
#pragma unroll
        for (int tl = 0; tl < 2; ++tl) { const char* img_hi = imgs + tl * 32768; const char* img_lo = img_hi + 16384;
            const bf16x8 h0 = *reinterpret_cast<const bf16x8*>(img_hi + a), h1 = *reinterpret_cast<const bf16x8*>(img_hi + a + 32 * 256);
            const bf16x8 l0 = *reinterpret_cast<const bf16x8*>(img_lo + a), l1 = *reinterpret_cast<const bf16x8*>(img_lo + a + 32 * 256);
            f32x16& q0 = tl ? pC : pA; f32x16& q1 = tl ? pD : pB;
            q0 = __builtin_amdgcn_mfma_f32_32x32x16_bf16(h0, qh, q0, 0, 0, 0); q1 = __builtin_amdgcn_mfma_f32_32x32x16_bf16(h1, qh, q1, 0, 0, 0);
            q0 = __builtin_amdgcn_mfma_f32_32x32x16_bf16(l0, qh, q0, 0, 0, 0); q1 = __builtin_amdgcn_mfma_f32_32x32x16_bf16(l1, qh, q1, 0, 0, 0);
            q0 = __builtin_amdgcn_mfma_f32_32x32x16_bf16(h0, ql, q0, 0, 0, 0); q1 = __builtin_amdgcn_mfma_f32_32x32x16_bf16(h1, ql, q1, 0, 0, 0); } }
}
__device__ __forceinline__ void half_top16(const float* qrow, const char* imgs  , int r32, int hi, unsigned (&w)[16]) {
    unsigned x[64]; const unsigned ib = 127u - 4u * (unsigned)hi;
    { f32x16 pA, pB, pC, pD; scores_half(pA, pB, pC, pD, imgs, r32, hi, qrow);
#pragma unroll
      for (int r = 0; r < 16; ++r) { const unsigned c = (unsigned)((r & 3) + 8 * (r >> 2));
          x[r] = (mono(pA[r]) & ~127u) | (ib - c); x[16 + r] = (mono(pB[r]) & ~127u) | (ib - c - 32u);
          x[32 + r] = (mono(pC[r]) & ~127u) | (ib - c - 64u); x[48 + r] = (mono(pD[r]) & ~127u) | (ib - c - 96u); } }
    top16_of_pair(x, w, hi);
}
__device__ __forceinline__ void combine_top16(const unsigned (&w1)[16], const unsigned (&w2)[16], int hi, float (&bv)[16], unsigned (&bp)[16]) {
    float s1[16], s2[16]; unsigned i1[16], i2[16];
#pragma unroll
    for (int i = 0; i < 16; ++i) { s1[i] = unmono(w1[i] & ~127u); s2[i] = unmono(w2[i] & ~127u); i1[i] = 127u - (w1[i] & 127u); i2[i] = 127u - (w2[i] & 127u); }
    float v[32]; unsigned p[32];
#pragma unroll
    for (int k = 0; k < 32; ++k) {
        float v0 = -__builtin_inff(), v1 = -__builtin_inff(); unsigned q0 = 0u, q1 = 0u;
        if (CA[k] >= 0) { v0 = s1[CA[k] < 0 ? 0 : CA[k]] + s2[CB[k] < 0 ? 0 : CB[k]]; q0 = (i1[CA[k] < 0 ? 0 : CA[k]] << 7) | i2[CB[k] < 0 ? 0 : CB[k]]; }
        if (CA[32 + k] >= 0) { v1 = s1[CA[32 + k] < 0 ? 0 : CA[32 + k]] + s2[CB[32 + k] < 0 ? 0 : CB[32 + k]]; q1 = (i1[CA[32 + k] < 0 ? 0 : CA[32 + k]] << 7) | i2[CB[32 + k] < 0 ? 0 : CB[32 + k]]; }
        v[k] = hi ? v1 : v0; p[k] = hi ? q1 : q0; }
#pragma unroll
    for (int kk = 2; kk <= 16; kk <<= 1)
#pragma unroll
        for (int j = kk >> 1; j > 0; j >>= 1)
#pragma unroll
            for (int i = 0; i < 32; ++i) { const int l = i ^ j; if (l > i) ce2(v[i], p[i], v[l], p[l], (i & kk) == 0); }
#pragma unroll
    for (int i = 0; i < 16; ++i) { const bool t = v[16 + i] > v[i]; bv[i] = t ? v[16 + i] : v[i]; bp[i] = t ? p[16 + i] : p[i]; }
    merge16v(bv, bp);
    float pv[16]; unsigned pp[16];
#pragma unroll
    for (int i = 0; i < 16; ++i) { pv[i] = __uint_as_float(partner_u(__float_as_uint(bv[i]), hi)); pp[i] = partner_u(bp[i], hi); }
#pragma unroll
    for (int i = 0; i < 16; ++i) { const bool t = pv[15 - i] > bv[i]; bv[i] = t ? pv[15 - i] : bv[i]; bp[i] = t ? pp[15 - i] : bp[i]; }
    merge16v(bv, bp);
}
}

static __device__ const unsigned short ATT_UNITS[640] = {8207, 8223, 8239, 8255, 10255, 10271, 10287, 10303, 12303, 12319, 12335, 12351, 14351, 14367, 14383, 14399, 8206, 8222, 8238, 8254, 10254, 10270, 10286, 10302, 12302, 12318, 12334, 12350, 14350, 14366, 14382, 14398, 8205, 8221, 8237, 8253, 10253, 10269, 10285, 10301, 12301, 12317, 12333, 12349, 14349, 14365, 14381, 14397, 8204, 8220, 8236, 8252, 10252, 10268, 10284, 10300, 12300, 12316, 12332, 12348, 14348, 14364, 14380, 14396, 8203, 8219, 8235, 8251, 10251, 10267, 10283, 10299, 12299, 12315, 12331, 12347, 14347, 14363, 14379, 14395, 8202, 8218, 8234, 8250, 10250, 10266, 10282, 10298, 12298, 12314, 12330, 12346, 14346, 14362, 14378, 14394, 8201, 8217, 8233, 8249, 10249, 10265, 10281, 10297, 12297, 12313, 12329, 12345, 14345, 14361, 14377, 14393, 8200, 8216, 8232, 8248, 10248, 10264, 10280, 10296, 12296, 12312, 12328, 12344, 14344, 14360, 14376, 14392, 8199, 8215, 8231, 8247, 10247, 10263, 10279, 10295, 12295, 12311, 12327, 12343, 14343, 14359, 14375, 14391, 8198, 8214, 8230, 8246, 10246, 10262, 10278, 10294, 12294, 12310, 12326, 12342, 14342, 14358, 14374, 14390, 4, 20, 36, 52, 68, 84, 2052, 2068, 2084, 2100, 2116, 2132, 5, 21, 37, 53, 69, 85, 2053, 2069, 2085, 2101, 2117, 2133, 6, 22, 38, 54, 70, 86, 2054, 2070, 2086, 2102, 2118, 2134, 7, 23, 39, 55, 71, 87, 2055, 2071, 2087, 2103, 2119, 2135, 8, 24, 40, 56, 72, 88, 2056, 2072, 2088, 2104, 2120, 2136, 9, 25, 41, 57, 73, 89, 2057, 2073, 2089, 2105, 2121, 2137, 10, 26, 42, 58, 74, 90, 2058, 2074, 2090, 2106, 2122, 2138, 11, 27, 43, 59, 75, 91, 2059, 2075, 2091, 2107, 2123, 2139, 12, 28, 44, 60, 76, 92, 2060, 2076, 2092, 2108, 2124, 2140, 13, 29, 45, 61, 77, 93, 2061, 2077, 2093, 2109, 2125, 2141, 14, 30, 46, 62, 78, 94, 2062, 2078, 2094, 2110, 2126, 2142, 15, 31, 47, 63, 79, 95, 2063, 2079, 2095, 2111, 2127, 2143, 8197, 8213, 8229, 8245, 10245, 10261, 10277, 10293, 12293, 12309, 12325, 12341, 14341, 14357, 14373, 14389, 3, 19, 35, 51, 67, 83, 2051, 2067, 2083, 2099, 2115, 2131, 8196, 8212, 8228, 8244, 10244, 10260, 10276, 10292, 12292, 12308, 12324, 12340, 14340, 14356, 14372, 14388, 8195, 8211, 8227, 8243, 10243, 10259, 10275, 10291, 12291, 12307, 12323, 12339, 14339, 14355, 14371, 14387, 2, 18, 34, 50, 66, 82, 2050, 2066, 2082, 2098, 2114, 2130, 8194, 8210, 8226, 8242, 10242, 10258, 10274, 10290, 12290, 12306, 12322, 12338, 14338, 14354, 14370, 14386, 4097, 4113, 4129, 4145, 4161, 4177, 6145, 6161, 6177, 6193, 6209, 6225, 4098, 4114, 4130, 4146, 4162, 4178, 6146, 6162, 6178, 6194, 6210, 6226, 4099, 4115, 4131, 4147, 4163, 4179, 6147, 6163, 6179, 6195, 6211, 6227, 4100, 4116, 4132, 4148, 4164, 4180, 6148, 6164, 6180, 6196, 6212, 6228, 4101, 4117, 4133, 4149, 4165, 4181, 6149, 6165, 6181, 6197, 6213, 6229, 4102, 4118, 4134, 4150, 4166, 4182, 6150, 6166, 6182, 6198, 6214, 6230, 4103, 4119, 4135, 4151, 4167, 4183, 6151, 6167, 6183, 6199, 6215, 6231, 4104, 4120, 4136, 4152, 4168, 4184, 6152, 6168, 6184, 6200, 6216, 6232, 4105, 4121, 4137, 4153, 4169, 4185, 6153, 6169, 6185, 6201, 6217, 6233, 4106, 4122, 4138, 4154, 4170, 4186, 6154, 6170, 6186, 6202, 6218, 6234, 4107, 4123, 4139, 4155, 4171, 4187, 6155, 6171, 6187, 6203, 6219, 6235, 4108, 4124, 4140, 4156, 4172, 4188, 6156, 6172, 6188, 6204, 6220, 6236, 4109, 4125, 4141, 4157, 4173, 4189, 6157, 6173, 6189, 6205, 6221, 6237, 4110, 4126, 4142, 4158, 4174, 4190, 6158, 6174, 6190, 6206, 6222, 6238, 4111, 4127, 4143, 4159, 4175, 4191, 6159, 6175, 6191, 6207, 6223, 6239, 1, 17, 33, 49, 65, 81, 2049, 2065, 2081, 2097, 2113, 2129, 8193, 8209, 8225, 8241, 10241, 10257, 10273, 10289, 12289, 12305, 12321, 12337, 14337, 14353, 14369, 14385, 4096, 4112, 4128, 4144, 4160, 4176, 6144, 6160, 6176, 6192, 6208, 6224, 0, 16, 32, 48, 64, 80, 2048, 2064, 2080, 2096, 2112, 2128, 8192, 8208, 8224, 8240, 10240, 10256, 10272, 10288, 12288, 12304, 12320, 12336, 14336, 14352, 14368, 14384};
constexpr int N_ATT_ITEMS0 = 1920;
static __device__ const unsigned short ATT_ITEMS0[N_ATT_ITEMS0] = {8207, 8223, 8239, 8255, 10255, 10271, 10287, 10303, 12303, 12319, 12335, 12351, 14351, 14367, 14383, 14399, 8206, 8222, 8238, 8254, 10254, 10270, 10286, 10302, 12302, 12318, 12334, 12350, 14350, 14366, 14382, 14398, 8205, 8221, 8237, 8253, 10253, 10269, 10285, 10301, 12301, 12317, 12333, 12349, 14349, 14365, 14381, 14397, 8204, 8220, 8236, 8252, 10252, 10268, 10284, 10300, 12300, 12316, 12332, 12348, 14348, 14364, 14380, 14396, 8203, 8219, 8235, 8251, 10251, 10267, 10283, 10299, 12299, 12315, 12331, 12347, 14347, 14363, 14379, 14395, 8202, 8218, 8234, 8250, 10250, 10266, 10282, 10298, 12298, 12314, 12330, 12346, 14346, 14362, 14378, 14394, 8201, 8217, 8233, 8249, 10249, 10265, 10281, 10297, 12297, 12313, 12329, 12345, 14345, 14361, 14377, 14393, 8200, 8216, 8232, 8248, 10248, 10264, 10280, 10296, 12296, 12312, 12328, 12344, 14344, 14360, 14376, 14392, 8199, 8215, 8231, 8247, 10247, 10263, 10279, 10295, 12295, 12311, 12327, 12343, 14343, 14359, 14375, 14391, 8198, 8214, 8230, 8246, 10246, 10262, 10278, 10294, 12294, 12310, 12326, 12342, 14342, 14358, 14374, 14390, 4, 20, 36, 52, 68, 84, 2052, 2068, 2084, 2100, 2116, 2132, 5, 21, 37, 53, 69, 85, 2053, 2069, 2085, 2101, 2117, 2133, 6, 22, 38, 54, 70, 86, 2054, 2070, 2086, 2102, 2118, 2134, 7, 23, 39, 55, 71, 87, 2055, 2071, 2087, 2103, 2119, 2135, 8, 24, 40, 56, 72, 88, 2056, 2072, 2088, 2104, 2120, 2136, 9, 25, 41, 57, 73, 89, 2057, 2073, 2089, 2105, 2121, 2137, 10, 26, 42, 58, 74, 90, 2058, 2074, 2090, 2106, 2122, 2138, 11, 27, 43, 59, 75, 91, 2059, 2075, 2091, 2107, 2123, 2139, 45056, 45057, 45058, 45059, 45060, 45061, 45062, 45063, 45064, 45065, 45066, 45067, 45068, 45069, 45070, 45071, 45072, 45073, 45074, 45075, 45076, 45077, 45078, 45079, 45080, 45081, 45082, 45083, 45084, 45085, 45086, 45087, 45088, 45089, 45090, 45091, 45092, 45093, 45094, 45095, 45096, 45097, 45098, 45099, 45100, 45101, 45102, 45103, 45104, 45105, 45106, 45107, 45108, 45109, 45110, 45111, 45112, 45113, 45114, 45115, 45116, 45117, 45118, 45119, 45120, 45121, 45122, 45123, 45124, 45125, 45126, 45127, 45128, 45129, 45130, 45131, 45132, 45133, 45134, 45135, 45136, 45137, 45138, 45139, 45140, 45141, 45142, 45143, 45144, 45145, 45146, 45147, 45148, 45149, 45150, 45151, 45152, 45153, 45154, 45155, 45156, 45157, 45158, 45159, 45160, 45161, 45162, 45163, 45164, 45165, 45166, 45167, 45168, 45169, 45170, 45171, 45172, 45173, 45174, 45175, 45176, 45177, 45178, 45179, 45180, 45181, 45182, 45183, 12, 28, 44, 60, 76, 92, 2060, 2076, 2092, 2108, 2124, 2140, 13, 29, 45, 61, 77, 93, 2061, 2077, 2093, 2109, 2125, 2141, 14, 30, 46, 62, 78, 94, 2062, 2078, 2094, 2110, 2126, 2142, 15, 31, 47, 63, 79, 95, 2063, 2079, 2095, 2111, 2127, 2143, 8197, 8213, 8229, 8245, 10245, 10261, 10277, 10293, 12293, 12309, 12325, 12341, 14341, 14357, 14373, 14389, 3, 19, 35, 51, 67, 83, 2051, 2067, 2083, 2099, 2115, 2131, 8196, 8212, 8228, 8244, 10244, 10260, 10276, 10292, 12292, 12308, 12324, 12340, 14340, 14356, 14372, 14388, 8195, 8211, 8227, 8243, 10243, 10259, 10275, 10291, 12291, 12307, 12323, 12339, 14339, 14355, 14371, 14387, 2, 18, 34, 50, 66, 82, 2050, 2066, 2082, 2098, 2114, 2130, 8194, 8210, 8226, 8242, 10242, 10258, 10274, 10290, 12290, 12306, 12322, 12338, 14338, 14354, 14370, 14386, 4097, 4113, 4129, 4145, 4161, 4177, 6145, 6161, 6177, 6193, 6209, 6225, 4098, 4114, 4130, 4146, 4162, 4178, 6146, 6162, 6178, 6194, 6210, 6226, 4099, 4115, 4131, 4147, 4163, 4179, 6147, 6163, 6179, 6195, 6211, 6227, 4100, 4116, 4132, 4148, 4164, 4180, 6148, 6164, 6180, 6196, 6212, 6228, 4101, 4117, 4133, 4149, 4165, 4181, 6149, 6165, 6181, 6197, 6213, 6229, 4102, 4118, 4134, 4150, 4166, 4182, 6150, 6166, 6182, 6198, 6214, 6230, 4103, 4119, 4135, 4151, 4167, 4183, 6151, 6167, 6183, 6199, 6215, 6231, 4104, 4120, 4136, 4152, 4168, 4184, 6152, 6168, 6184, 6200, 6216, 6232, 4105, 4121, 4137, 4153, 4169, 4185, 6153, 6169, 6185, 6201, 6217, 6233, 4106, 4122, 4138, 4154, 4170, 4186, 6154, 6170, 6186, 6202, 6218, 6234, 4107, 4123, 4139, 4155, 4171, 4187, 6155, 6171, 6187, 6203, 6219, 6235, 4108, 4124, 4140, 4156, 4172, 4188, 6156, 6172, 6188, 6204, 6220, 6236, 4109, 4125, 4141, 4157, 4173, 4189, 6157, 6173, 6189, 6205, 6221, 6237, 4110, 4126, 4142, 4158, 4174, 4190, 6158, 6174, 6190, 6206, 6222, 6238, 4111, 4127, 4143, 4159, 4175, 4191, 6159, 6175, 6191, 6207, 6223, 6239, 49152, 49153, 49154, 49155, 49156, 49157, 49158, 49159, 49160, 49161, 49162, 49163, 49164, 49165, 49166, 49167, 49168, 49169, 49170, 49171, 49172, 49173, 49174, 49175, 49176, 49177, 49178, 49179, 49180, 49181, 49182, 49183, 49184, 49185, 49186, 49187, 49188, 49189, 49190, 49191, 49192, 49193, 49194, 49195, 49196, 49197, 49198, 49199, 49200, 49201, 49202, 49203, 49204, 49205, 49206, 49207, 49208, 49209, 49210, 49211, 49212, 49213, 49214, 49215, 49216, 49217, 49218, 49219, 49220, 49221, 49222, 49223, 49224, 49225, 49226, 49227, 49228, 49229, 49230, 49231, 49232, 49233, 49234, 49235, 49236, 49237, 49238, 49239, 49240, 49241, 49242, 49243, 49244, 49245, 49246, 49247, 49248, 49249, 49250, 49251, 49252, 49253, 49254, 49255, 49256, 49257, 49258, 49259, 49260, 49261, 49262, 49263, 49264, 49265, 49266, 49267, 49268, 49269, 49270, 49271, 49272, 49273, 49274, 49275, 49276, 49277, 49278, 49279, 49280, 49281, 49282, 49283, 49284, 49285, 49286, 49287, 49288, 49289, 49290, 49291, 49292, 49293, 49294, 49295, 49296, 49297, 49298, 49299, 49300, 49301, 49302, 49303, 49304, 49305, 49306, 49307, 49308, 49309, 49310, 49311, 49312, 49313, 49314, 49315, 49316, 49317, 49318, 49319, 49320, 49321, 49322, 49323, 49324, 49325, 49326, 49327, 49328, 49329, 49330, 49331, 49332, 49333, 49334, 49335, 49336, 49337, 49338, 49339, 49340, 49341, 49342, 49343, 49344, 49345, 49346, 49347, 49348, 49349, 49350, 49351, 49352, 49353, 49354, 49355, 49356, 49357, 49358, 49359, 49360, 49361, 49362, 49363, 49364, 49365, 49366, 49367, 49368, 49369, 49370, 49371, 49372, 49373, 49374, 49375, 49376, 49377, 49378, 49379, 49380, 49381, 49382, 49383, 49384, 49385, 49386, 49387, 49388, 49389, 49390, 49391, 49392, 49393, 49394, 49395, 49396, 49397, 49398, 49399, 49400, 49401, 49402, 49403, 49404, 49405, 49406, 49407, 49408, 49409, 49410, 49411, 49412, 49413, 49414, 49415, 49416, 49417, 49418, 49419, 49420, 49421, 49422, 49423, 49424, 49425, 49426, 49427, 49428, 49429, 49430, 49431, 49432, 49433, 49434, 49435, 49436, 49437, 49438, 49439, 49440, 49441, 49442, 49443, 49444, 49445, 49446, 49447, 49448, 49449, 49450, 49451, 49452, 49453, 49454, 49455, 49456, 49457, 49458, 49459, 49460, 49461, 49462, 49463, 49464, 49465, 49466, 49467, 49468, 49469, 49470, 49471, 49472, 49473, 49474, 49475, 49476, 49477, 49478, 49479, 49480, 49481, 49482, 49483, 49484, 49485, 49486, 49487, 49488, 49489, 49490, 49491, 49492, 49493, 49494, 49495, 49496, 49497, 49498, 49499, 49500, 49501, 49502, 49503, 49504, 49505, 49506, 49507, 49508, 49509, 49510, 49511, 49512, 49513, 49514, 49515, 49516, 49517, 49518, 49519, 49520, 49521, 49522, 49523, 49524, 49525, 49526, 49527, 49528, 49529, 49530, 49531, 49532, 49533, 49534, 49535, 49536, 49537, 49538, 49539, 49540, 49541, 49542, 49543, 49544, 49545, 49546, 49547, 49548, 49549, 49550, 49551, 49552, 49553, 49554, 49555, 49556, 49557, 49558, 49559, 49560, 49561, 49562, 49563, 49564, 49565, 49566, 49567, 49568, 49569, 49570, 49571, 49572, 49573, 49574, 49575, 49576, 49577, 49578, 49579, 49580, 49581, 49582, 49583, 49584, 49585, 49586, 49587, 49588, 49589, 49590, 49591, 49592, 49593, 49594, 49595, 49596, 49597, 49598, 49599, 49600, 49601, 49602, 49603, 49604, 49605, 49606, 49607, 49608, 49609, 49610, 49611, 49612, 49613, 49614, 49615, 49616, 49617, 49618, 49619, 49620, 49621, 49622, 49623, 49624, 49625, 49626, 49627, 49628, 49629, 49630, 49631, 49632, 49633, 49634, 49635, 49636, 49637, 49638, 49639, 49640, 49641, 49642, 49643, 49644, 49645, 49646, 49647, 49648, 49649, 49650, 49651, 49652, 49653, 49654, 49655, 49656, 49657, 49658, 49659, 49660, 49661, 49662, 49663, 1, 17, 33, 49, 65, 81, 2049, 2065, 2081, 2097, 2113, 2129, 8193, 8209, 8225, 8241, 10241, 10257, 10273, 10289, 12289, 12305, 12321, 12337, 14337, 14353, 14369, 14385, 40960, 40961, 40962, 40963, 40964, 40965, 40966, 40967, 40968, 40969, 40970, 40971, 40972, 40973, 40974, 40975, 40976, 40977, 40978, 40979, 40980, 40981, 40982, 40983, 40984, 40985, 40986, 40987, 40988, 40989, 40990, 40991, 40992, 40993, 40994, 40995, 40996, 40997, 40998, 40999, 41000, 41001, 41002, 41003, 41004, 41005, 41006, 41007, 41008, 41009, 41010, 41011, 41012, 41013, 41014, 41015, 41016, 41017, 41018, 41019, 41020, 41021, 41022, 41023, 41024, 41025, 41026, 41027, 41028, 41029, 41030, 41031, 41032, 41033, 41034, 41035, 41036, 41037, 41038, 41039, 41040, 41041, 41042, 41043, 41044, 41045, 41046, 41047, 41048, 41049, 41050, 41051, 41052, 41053, 41054, 41055, 41056, 41057, 41058, 41059, 41060, 41061, 41062, 41063, 41064, 41065, 41066, 41067, 41068, 41069, 41070, 41071, 41072, 41073, 41074, 41075, 41076, 41077, 41078, 41079, 41080, 41081, 41082, 41083, 41084, 41085, 41086, 41087, 4096, 4112, 4128, 4144, 4160, 4176, 6144, 6160, 6176, 6192, 6208, 6224, 0, 16, 32, 48, 64, 80, 2048, 2064, 2080, 2096, 2112, 2128, 8192, 8208, 8224, 8240, 10240, 10256, 10272, 10288, 12288, 12304, 12320, 12336, 14336, 14352, 14368, 14384, 32768, 32769, 32770, 32771, 32772, 32773, 32774, 32775, 32776, 32777, 32778, 32779, 32780, 32781, 32782, 32783, 32784, 32785, 32786, 32787, 32788, 32789, 32790, 32791, 32792, 32793, 32794, 32795, 32796, 32797, 32798, 32799, 32800, 32801, 32802, 32803, 32804, 32805, 32806, 32807, 32808, 32809, 32810, 32811, 32812, 32813, 32814, 32815, 32816, 32817, 32818, 32819, 32820, 32821, 32822, 32823, 32824, 32825, 32826, 32827, 32828, 32829, 32830, 32831, 32832, 32833, 32834, 32835, 32836, 32837, 32838, 32839, 32840, 32841, 32842, 32843, 32844, 32845, 32846, 32847, 32848, 32849, 32850, 32851, 32852, 32853, 32854, 32855, 32856, 32857, 32858, 32859, 32860, 32861, 32862, 32863, 32864, 32865, 32866, 32867, 32868, 32869, 32870, 32871, 32872, 32873, 32874, 32875, 32876, 32877, 32878, 32879, 32880, 32881, 32882, 32883, 32884, 32885, 32886, 32887, 32888, 32889, 32890, 32891, 32892, 32893, 32894, 32895, 32896, 32897, 32898, 32899, 32900, 32901, 32902, 32903, 32904, 32905, 32906, 32907, 32908, 32909, 32910, 32911, 32912, 32913, 32914, 32915, 32916, 32917, 32918, 32919, 32920, 32921, 32922, 32923, 32924, 32925, 32926, 32927, 32928, 32929, 32930, 32931, 32932, 32933, 32934, 32935, 32936, 32937, 32938, 32939, 32940, 32941, 32942, 32943, 32944, 32945, 32946, 32947, 32948, 32949, 32950, 32951, 32952, 32953, 32954, 32955, 32956, 32957, 32958, 32959, 32960, 32961, 32962, 32963, 32964, 32965, 32966, 32967, 32968, 32969, 32970, 32971, 32972, 32973, 32974, 32975, 32976, 32977, 32978, 32979, 32980, 32981, 32982, 32983, 32984, 32985, 32986, 32987, 32988, 32989, 32990, 32991, 32992, 32993, 32994, 32995, 32996, 32997, 32998, 32999, 33000, 33001, 33002, 33003, 33004, 33005, 33006, 33007, 33008, 33009, 33010, 33011, 33012, 33013, 33014, 33015, 33016, 33017, 33018, 33019, 33020, 33021, 33022, 33023, 33024, 33025, 33026, 33027, 33028, 33029, 33030, 33031, 33032, 33033, 33034, 33035, 33036, 33037, 33038, 33039, 33040, 33041, 33042, 33043, 33044, 33045, 33046, 33047, 33048, 33049, 33050, 33051, 33052, 33053, 33054, 33055, 33056, 33057, 33058, 33059, 33060, 33061, 33062, 33063, 33064, 33065, 33066, 33067, 33068, 33069, 33070, 33071, 33072, 33073, 33074, 33075, 33076, 33077, 33078, 33079, 33080, 33081, 33082, 33083, 33084, 33085, 33086, 33087, 33088, 33089, 33090, 33091, 33092, 33093, 33094, 33095, 33096, 33097, 33098, 33099, 33100, 33101, 33102, 33103, 33104, 33105, 33106, 33107, 33108, 33109, 33110, 33111, 33112, 33113, 33114, 33115, 33116, 33117, 33118, 33119, 33120, 33121, 33122, 33123, 33124, 33125, 33126, 33127, 33128, 33129, 33130, 33131, 33132, 33133, 33134, 33135, 33136, 33137, 33138, 33139, 33140, 33141, 33142, 33143, 33144, 33145, 33146, 33147, 33148, 33149, 33150, 33151, 36864, 36865, 36866, 36867, 36868, 36869, 36870, 36871, 36872, 36873, 36874, 36875, 36876, 36877, 36878, 36879, 36880, 36881, 36882, 36883, 36884, 36885, 36886, 36887, 36888, 36889, 36890, 36891, 36892, 36893, 36894, 36895, 36896, 36897, 36898, 36899, 36900, 36901, 36902, 36903, 36904, 36905, 36906, 36907, 36908, 36909, 36910, 36911, 36912, 36913, 36914, 36915, 36916, 36917, 36918, 36919, 36920, 36921, 36922, 36923, 36924, 36925, 36926, 36927, 36928, 36929, 36930, 36931, 36932, 36933, 36934, 36935, 36936, 36937, 36938, 36939, 36940, 36941, 36942, 36943, 36944, 36945, 36946, 36947, 36948, 36949, 36950, 36951, 36952, 36953, 36954, 36955, 36956, 36957, 36958, 36959, 36960, 36961, 36962, 36963, 36964, 36965, 36966, 36967, 36968, 36969, 36970, 36971, 36972, 36973, 36974, 36975, 36976, 36977, 36978, 36979, 36980, 36981, 36982, 36983, 36984, 36985, 36986, 36987, 36988, 36989, 36990, 36991};


__global__ void __launch_bounds__(NTHR, 2) fwd_kernel(Args args) {
    extern __shared__ __attribute__((aligned(16))) unsigned char lds_raw[];
    float* lds = (float*)lds_raw;
    const int G = gridDim.x, NGW = G * NWAVES, NGT = G * NTHR;
    const int wave_u_ = __builtin_amdgcn_readfirstlane(threadIdx.x >> 6);
#define PHASE_VARS unsigned z0_ = 0u; asm volatile("" : "+v"(z0_));   \
    int tid = wave_u_ * 64 + (int)__builtin_amdgcn_mbcnt_hi(~0u, __builtin_amdgcn_mbcnt_lo(~0u, z0_)); int bid = blockIdx.x; asm volatile("" : "+s"(bid)); \
    const int lane = tid & 63, wave = tid >> 6, gw = bid * NWAVES + wave, gtid = bid * NTHR + tid; (void)lane; (void)gw; (void)gtid;
    volatile LAS unsigned* MISC = (volatile LAS unsigned*)((LAS unsigned char*)lds_raw + MISC_OFF);
    { const int tid = threadIdx.x;
    unsigned char* ws = args.ws;
    if (tid < 64) MISC[tid] = 0u;
    __syncthreads();
    (void)xcd_barrier_post((unsigned*)(ws + WS_CTL) + CW_BAR, MISC + 8);

    if (tid == 0) {
        volatile LAS unsigned long long* pt = (volatile LAS unsigned long long*)(MISC + 64);
#define PT_SET(i) pt[i] = (unsigned long long)args.in[i]
        PT_SET(0); PT_SET(1); PT_SET(2); PT_SET(3); PT_SET(4); PT_SET(5); PT_SET(6); PT_SET(7); PT_SET(8); PT_SET(9); PT_SET(10); PT_SET(11);
        PT_SET(12); PT_SET(13); PT_SET(14); PT_SET(15); PT_SET(16); PT_SET(17); PT_SET(18); PT_SET(19); PT_SET(20); PT_SET(21); PT_SET(22);
#undef PT_SET
        pt[23] = (unsigned long long)args.out; pt[24] = (unsigned long long)args.ws;
    }
    __syncthreads(); }
#define GRID_BAR() do { XcdBarrier b_; b_.bar = (unsigned*)((unsigned char*)ldp(MISC + 64, 24) + WS_CTL) + CW_BAR; b_.x = xb_xcc_id(); b_.st = MISC + 8; unsigned zb_ = 0u; asm volatile("" : "+v"(zb_)); xcd_barrier(b_, wave_u_ == 0 && __builtin_amdgcn_mbcnt_hi(~0u, __builtin_amdgcn_mbcnt_lo(~0u, zb_)) == 0u); } while (0)
#define IN(i) ldp(MISC + 64, i)
#define WSF(off) ((float*)((unsigned char*)ldp(MISC + 64, 24) + (off)))

    auto cv_win = [&](const int item, const int tid) __attribute__((always_inline)) {
        const int lane = tid & 63; const float* w_in = IN(7); signed char* WT8 = (signed char*)WSF(WS_WINT); float* SW = WSF(WS_SW); LAS unsigned* cm = (LAS unsigned*)((LAS unsigned char*)lds_raw + 140 * 1024);
        const int c4 = tid & 7, rg = tid >> 3; const int l = item / 384, n0 = (item % 384) * 32 + 4 * c4; const int sc0 = win_src_col(n0);
        __syncthreads();
        if (tid < 32) cm[tid] = 0u;
        __syncthreads();
        const float* src = w_in + ((size_t)l * DM + rg * 32) * INW + sc0; float v[32][4]; float mx[4] = {0.f, 0.f, 0.f, 0.f};
#pragma unroll
        for (int j = 0; j < 32; ++j) { const float2 a = ldnt2(src + (size_t)j * INW), b2 = ldnt2(src + (size_t)j * INW + 2); v[j][0] = a.x; v[j][1] = a.y; v[j][2] = b2.x; v[j][3] = b2.y; }
#pragma unroll
        for (int j = 0; j < 32; ++j) {
#pragma unroll
            for (int i = 0; i < 4; ++i) mx[i] = fmaxf(mx[i], fabsf(v[j][i])); }
#pragma unroll
        for (int i = 0; i < 4; ++i) { float m = mx[i]; m = fmaxf(m, SWZ_XOR(m, 8)); m = fmaxf(m, SWZ_XOR(m, 16));
            auto rr = __builtin_amdgcn_permlane32_swap(__float_as_uint(m), __float_as_uint(m), false, false); m = fmaxf(__uint_as_float(rr[0]), __uint_as_float(rr[1]));
            if (lane < 8) __hip_atomic_fetch_max(cm + 4 * c4 + i, __float_as_uint(m), __ATOMIC_RELAXED, __HIP_MEMORY_SCOPE_WORKGROUP); }
        __syncthreads();
#pragma unroll
        for (int i = 0; i < 4; ++i) { const float cmx = fmaxf(__uint_as_float(cm[4 * c4 + i]), 1e-30f), q = 127.f / cmx; unsigned w[8];
#pragma unroll
            for (int m = 0; m < 8; ++m) w[m] = pk_i8x4(v[4 * m][i] * q, v[4 * m + 1][i] * q, v[4 * m + 2][i] * q, v[4 * m + 3][i] * q);
            signed char* dst = WT8 + ((size_t)l * 12288 + n0 + i) * DM + rg * 32;
            *(uint4*)dst = make_uint4(w[0], w[1], w[2], w[3]); *(uint4*)(dst + 16) = make_uint4(w[4], w[5], w[6], w[7]);
            if (rg == 0) SW[(size_t)l * 12288 + n0 + i] = cmx * (1.f / 127.f); }
    };
    auto cv_wq = [&](const int item, const int tid) __attribute__((always_inline)) {
        const int lane = tid & 63; const float* wq = IN(18); signed char* WQ8 = (signed char*)WSF(WS_WQT); float* SWQ = WSF(WS_SWQ); LAS unsigned* cm = (LAS unsigned*)((LAS unsigned char*)lds_raw + 140 * 1024);
        const int c4 = tid & 7, rg = tid >> 3; const int l = item >> 6, n0 = (item & 63) * 32 + 4 * c4;
        __syncthreads();
        if (tid < 32) cm[tid] = 0u;
        __syncthreads();
        const float* src = wq + ((size_t)l * DM + rg * 32) * DM + n0; float v[32][4]; float mx[4] = {0.f, 0.f, 0.f, 0.f};
#pragma unroll
        for (int j = 0; j < 32; ++j) { const float4 a = ldnt4(src + (size_t)j * DM); v[j][0] = a.x; v[j][1] = a.y; v[j][2] = a.z; v[j][3] = a.w; }
#pragma unroll
        for (int j = 0; j < 32; ++j) {
#pragma unroll
            for (int i = 0; i < 4; ++i) mx[i] = fmaxf(mx[i], fabsf(v[j][i])); }
#pragma unroll
        for (int i = 0; i < 4; ++i) { float m = mx[i]; m = fmaxf(m, SWZ_XOR(m, 8)); m = fmaxf(m, SWZ_XOR(m, 16));
            auto rr = __builtin_amdgcn_permlane32_swap(__float_as_uint(m), __float_as_uint(m), false, false); m = fmaxf(__uint_as_float(rr[0]), __uint_as_float(rr[1]));
            if (lane < 8) __hip_atomic_fetch_max(cm + 4 * c4 + i, __float_as_uint(m), __ATOMIC_RELAXED, __HIP_MEMORY_SCOPE_WORKGROUP); }
        __syncthreads();
#pragma unroll
        for (int i = 0; i < 4; ++i) { const float cmx = fmaxf(__uint_as_float(cm[4 * c4 + i]), 1e-30f), q = 127.f / cmx; unsigned w[8];
#pragma unroll
            for (int m = 0; m < 8; ++m) w[m] = pk_i8x4(v[4 * m][i] * q, v[4 * m + 1][i] * q, v[4 * m + 2][i] * q, v[4 * m + 3][i] * q);
            signed char* dst = WQ8 + ((size_t)l * DM + n0 + i) * DM + rg * 32;
            *(uint4*)dst = make_uint4(w[0], w[1], w[2], w[3]); *(uint4*)(dst + 16) = make_uint4(w[4], w[5], w[6], w[7]);
            if (rg == 0) SWQ[(size_t)l * DM + n0 + i] = cmx * (1.f / 127.f); }
    };
    auto cv_tr = [&](const int it, const int tid) __attribute__((always_inline)) {
        const int lane = tid & 63, wave = tid >> 6; float* scr = lds + wave * (64 * 33); const int l = it / 4096; int r = it % 4096;
        bf16_t* wbr = (bf16_t*)WSF(WS_WBRT) + (size_t)l * 3 * DM * 768;
        if (r < 768) { transpose_item<false>(IN(14) + (size_t)l * 768 * DM, DM, wbr, 768, scr, r / 64, r % 64, lane); return; } r -= 768;
        if (r < 768) { transpose_item<false>(IN(15) + (size_t)l * 768 * DM, DM, wbr + (size_t)DM * 768, 768, scr, r / 64, r % 64, lane); return; } r -= 768;
        if (r < 512) { transpose_item<false>(IN(16) + (size_t)l * 512 * DM, DM, wbr + (size_t)2 * DM * 768, 768, scr, r / 64, r % 64, lane); return; } r -= 512;
        transpose_item<false>(IN(17) + (size_t)l * DM * DM, DM, (bf16_t*)WSF(WS_WOT) + (size_t)l * DM * DM, DM, scr, r / 64, r % 64, lane);
    };
    auto cv_u = [&](const int r0, const int r1, const int tid) __attribute__((always_inline)) {
        const int lane = tid & 63; const float* pu = IN(20); signed char* U8 = (signed char*)WSF(WS_UB); float* SU = WSF(WS_SU);
        float4 v[2][8];
#pragma unroll
        for (int h = 0; h < 2; ++h) { const float* src = pu + (size_t)(h ? r1 : r0) * DM;
#pragma unroll
            for (int j = 0; j < 8; ++j) v[h][j] = ldnt4(src + lane * 4 + 256 * j); }
        asm volatile("" ::: "memory");
#pragma unroll
        for (int h = 0; h < 2; ++h) { const int r = h ? r1 : r0; float mx = 0.f;
#pragma unroll
            for (int j = 0; j < 8; ++j) mx = fmaxf(mx, fmaxf(fmaxf(fabsf(v[h][j].x), fabsf(v[h][j].y)), fmaxf(fabsf(v[h][j].z), fabsf(v[h][j].w))));
            mx = fmaxf(wave_max(mx), 1e-30f); const float q = 127.f / mx;
#pragma unroll
            for (int j = 0; j < 8; ++j) *(unsigned*)(U8 + (size_t)r * DM + lane * 4 + 256 * j) = pk_i8x4(v[h][j].x * q, v[h][j].y * q, v[h][j].z * q, v[h][j].w * q);
            if (lane == 0) SU[r] = mx * (1.f / 127.f); }
    };
    auto cv_v = [&](const int item, const int tid) __attribute__((always_inline)) {
        const int lane = tid & 63, wave = tid >> 6; const float* pv = IN(21); float* DV = WSF(WS_DV); unsigned char* VT = (unsigned char*)WSF(WS_VT); LAS unsigned char* T = (LAS unsigned char*)lds_raw;
        const int l = item >> 8, eb = item & 255;
        __syncthreads();
#pragma unroll 2
        for (int i = 0; i < 8; ++i) { const int e = wave * 8 + i; const size_t r = (size_t)l * 16384 + eb * 64 + e; const float* src = pv + r * DM; float4 v[8]; float mx = 0.f;
#pragma unroll
            for (int j = 0; j < 8; ++j) { v[j] = ldnt4(src + lane * 4 + 256 * j); mx = fmaxf(mx, fmaxf(fmaxf(fabsf(v[j].x), fabsf(v[j].y)), fmaxf(fabsf(v[j].z), fabsf(v[j].w)))); }
            mx = fmaxf(wave_max(mx), 1e-30f); const float q = 127.f / mx;
#pragma unroll
            for (int j = 0; j < 8; ++j) *(LAS unsigned*)(T + e * 2048 + lane * 4 + 256 * j) = pk_i8x4(v[j].x * q, v[j].y * q, v[j].z * q, v[j].w * q);
            if (lane == 0) DV[r] = mx * (1.f / 127.f); }
        __syncthreads();
#pragma unroll
        for (int qd = 0; qd < 4; ++qd) { unsigned d[16];
#pragma unroll
            for (int e = 0; e < 16; ++e) d[e] = *(const LAS unsigned*)(T + (qd * 16 + e) * 2048 + tid * 4);
#pragma unroll
            for (int k = 0; k < 4; ++k) { unsigned o[4];
#pragma unroll
                for (int g = 0; g < 4; ++g) o[g] = ((d[4 * g] >> (8 * k)) & 0xffu) | (((d[4 * g + 1] >> (8 * k)) & 0xffu) << 8) | (((d[4 * g + 2] >> (8 * k)) & 0xffu) << 16) | (((d[4 * g + 3] >> (8 * k)) & 0xffu) << 24);
                *(uint4*)(VT + ((size_t)l * DM + tid * 4 + k) * 16384 + eb * 64 + qd * 16) = make_uint4(o[0], o[1], o[2], o[3]); } }
        __syncthreads();
    };

    { PHASE_VARS
    {
        const float* c_in = IN(1); const float* ada_w = IN(3); float* MODP = WSF(WS_MODP);
        float* cond = lds;
        for (int i = tid; i < NB * DM; i += NTHR) { const float c = c_in[i]; cond[i] = c / (1.f + expf(-c)); }
        __syncthreads();
        for (int item = gtid; item < 2 * 16 * (NMOD / 4); item += NGT) {
            const int j4 = item % (NMOD / 4), ch = (item / (NMOD / 4)) % 16, l = item / (16 * (NMOD / 4));
            float4 a0 = {0.f, 0.f, 0.f, 0.f}, a1 = {0.f, 0.f, 0.f, 0.f};
            const float* wp = ada_w + ((size_t)l * DM + ch * 128) * NMOD + j4 * 4;
            for (int k = 0; k < 128; ++k) { const float4 w = ldnt4(wp + (size_t)k * NMOD); const float c0 = cond[ch * 128 + k], c1 = cond[DM + ch * 128 + k];
                a0.x += c0 * w.x; a0.y += c0 * w.y; a0.z += c0 * w.z; a0.w += c0 * w.w; a1.x += c1 * w.x; a1.y += c1 * w.y; a1.z += c1 * w.z; a1.w += c1 * w.w; }
            *(float4*)(MODP + (((size_t)l * 16 + ch) * 2 + 0) * NMOD + j4 * 4) = a0;
            *(float4*)(MODP + (((size_t)l * 16 + ch) * 2 + 1) * NMOD + j4 * 4) = a1;
        }
        __syncthreads();
        for (int item = bid; item < 384; item += G) cv_win(item, tid);
        __syncthreads();
        { const int* pos_in = (const int*)IN(2); float* ROPE = WSF(WS_ROPE);
          for (int i = gtid; i < NT * 32; i += NGT) { const int t = i >> 5, k = i & 31; const float invf = exp2f(-(float)(2 * k) * (1.f / 64.f) * 13.287712379549449f);
              const float ang = (float)pos_in[t] * invf; ROPE[(size_t)i * 2] = cosf(ang); ROPE[(size_t)i * 2 + 1] = sinf(ang); } }
    }
    }
    GRID_BAR();
    { PHASE_VARS
    { const float* ada_b = IN(4); const float* MODP = WSF(WS_MODP); float* MOD = WSF(WS_MOD);
    for (int i = gtid; i < 2 * 2 * NMOD; i += NGT) { const int j = i % NMOD, b = (i / NMOD) % 2, l = i / (2 * NMOD); float s = ada_b[(size_t)l * NMOD + j];
        for (int ch = 0; ch < 16; ++ch) s += MODP[(((size_t)l * 16 + ch) * 2 + b) * NMOD + j];
        MOD[i] = s; } }
    }
    GRID_BAR();

#pragma clang loop unroll(full)
    for (int l = 0; l < DEPTH; ++l) {
        const float lam_init = 0.8f - 0.6f * expf(-0.3f * (float)l);
#define MODL (WSF(WS_MOD) + (size_t)l * 2 * NMOD)
        { PHASE_VARS
        { const float* modl = MODL; const float* norm1_g = IN(5); const void* X = (l == 0) ? (const void*)IN(0) : (const void*)WSF(WS_X); const bool xf32 = (l == 0); signed char* HQ = (signed char*)WSF(WS_HB); float* SH1 = WSF(WS_SH1); float* FL = WSF(WS_FL);
        float* wfl = lds;
        { const float* w_in = IN(7) + (size_t)l * DM * INW;
          float wv[24];
#pragma unroll
          for (int it = 0; it < 24; ++it) { const int i = tid + it * NTHR, k = i / 6, jj = i % 6; wv[it] = w_in[(size_t)k * INW + C_FL + jj]; }
#pragma unroll
          for (int it = 0; it < 24; ++it) { const int i = tid + it * NTHR, k = i / 6, jj = i % 6; wfl[jj * DM + k] = wv[it]; } }
        __syncthreads();
        for (int t = gw; t < NT; t += NGW) {
            const int b = t / SEQ; const float* g = norm1_g + (size_t)l * DM; const float* sh = modl + (size_t)b * NMOD; const float* sc = sh + DM;
            float4 v[8]; float ss = 0.f; int ln = lane; asm volatile("" : "+v"(ln));
#pragma unroll
            for (int j = 0; j < 8; ++j) { v[j] = ldx4(X, xf32, (size_t)t * DM + ln * 4 + 256 * j); ss += v[j].x * v[j].x + v[j].y * v[j].y + v[j].z * v[j].z + v[j].w * v[j].w; }
            const float r = rsqrtf(wave_sum(ss) * (1.f / DM) + RMS_EPS);
            float fl[6] = {0.f, 0.f, 0.f, 0.f, 0.f, 0.f}; float hmx = 0.f;
#pragma unroll
            for (int j = 0; j < 8; ++j) { const int d = ln * 4 + 256 * j; const float4 gg = *(const float4*)(g + d), s1 = *(const float4*)(sc + d), s0 = *(const float4*)(sh + d); float4 o;
                o.x = v[j].x * r * gg.x * (1.f + s1.x) + s0.x; o.y = v[j].y * r * gg.y * (1.f + s1.y) + s0.y; o.z = v[j].z * r * gg.z * (1.f + s1.z) + s0.z; o.w = v[j].w * r * gg.w * (1.f + s1.w) + s0.w;
                v[j] = o; hmx = fmaxf(hmx, fmaxf(fmaxf(fabsf(o.x), fabsf(o.y)), fmaxf(fabsf(o.z), fabsf(o.w))));
#pragma unroll
                for (int jj = 0; jj < 6; ++jj) { const float4 w4 = *(const float4*)(wfl + jj * DM + d); fl[jj] += o.x * w4.x + o.y * w4.y + o.z * w4.z + o.w * w4.w; } }
            hmx = fmaxf(wave_max(hmx), 1e-30f); const float hq = 127.f / hmx;
#pragma unroll
            for (int j = 0; j < 8; ++j) *(unsigned*)(HQ + (size_t)t * DM + ln * 4 + 256 * j) = pk_i8x4(v[j].x * hq, v[j].y * hq, v[j].z * hq, v[j].w * hq);
            if (lane == 0) SH1[t] = hmx * (1.f / 127.f);
#pragma unroll
            for (int jj = 0; jj < 6; ++jj) fl[jj] = wave_sum(fl[jj]);
            if (lane == 0) { *(float4*)(FL + (size_t)t * 8) = (float4){fl[0], fl[1], fl[2], fl[3]}; *(float2*)(FL + (size_t)t * 8 + 4) = (float2){fl[4], fl[5]}; }
        }
        __syncthreads(); }
        }
        GRID_BAR();
        { PHASE_VARS
        { const float* b_forget = IN(8); const float* FL = WSF(WS_FL); float* CUM = WSF(WS_CUM);
        if (bid < 12) {
            const int b = bid / 6, h = bid % 6; float* sc = lds;
            float loc[8]; float run = 0.f; const float bf = b_forget[l * 6 + h];
#pragma unroll
            for (int j = 0; j < 8; ++j) { const int s = tid * 8 + j; const float xl = FL[((size_t)b * SEQ + s) * 8 + h] + bf; run += fminf(xl, 0.f) - __logf(1.f + __expf(-fabsf(xl))); loc[j] = run; }
            sc[tid] = run; __syncthreads();
            for (int o = 1; o < NTHR; o <<= 1) { float v = 0.f; if (tid >= o) v = sc[tid - o]; __syncthreads(); sc[tid] += v; __syncthreads(); }
            const float off = (tid > 0) ? sc[tid - 1] : 0.f;
#pragma unroll
            for (int j = 0; j < 8; ++j) CUM[(size_t)bid * SEQ + tid * 8 + j] = (off + loc[j]) * 1.4426950408889634f;
            __syncthreads();
        } }
        { pg8::Gemm8 g{(const signed char*)WSF(WS_HB), (const signed char*)WSF(WS_WINT) + (size_t)l * 12288 * DM, NT, 12288, DM, DM, DM};
          pg8::StaticOrder S; S.init(NT, 12288, G, bid);
          EpiProj E{(bf16_t*)WSF(WS_ATT), (bf16_t*)WSF(WS_GATES), WSF(WS_ROPE), WSF(WS_SH1), WSF(WS_SW) + (size_t)l * 12288, (unsigned*)WSF(WS_CTL) + 12288 + 32 * l};
          pg8::gemm_phase_i8<EpiProj, pg8::StaticOrder, true, true>(tid, (LAS unsigned char*)lds_raw, g, S, E); }
        }
        GRID_BAR();
        { PHASE_VARS
        { const bf16_t* ATTp = (const bf16_t*)WSF(WS_ATT); const float* CUM = WSF(WS_CUM); bf16_t* O = (bf16_t*)WSF(WS_OB); float* ODF = WSF(WS_ODF);
          unsigned* qctr = (unsigned*)WSF(WS_CTL) + 8192 + 64 * l;
          const unsigned* KINFp = (const unsigned*)WSF(WS_CTL) + 12288 + 32 * l; unsigned char* Gzp = (unsigned char*)WSF(WS_G);
        const unsigned short* qtab = (l == 0) ? ATT_ITEMS0 : ATT_UNITS; const unsigned qlen = (l == 0) ? (unsigned)N_ATT_ITEMS0 : 640u;
        for (;;) {
            if (tid == 0) MISC[16] = __hip_atomic_fetch_add(qctr, 1u, __ATOMIC_RELAXED, __HIP_MEMORY_SCOPE_AGENT);
            __syncthreads();
            const unsigned rank = MISC[16];
            __syncthreads();
            if (rank >= qlen) break;
            const unsigned uu = qtab[rank];
            int tid_u = tid; asm volatile("" : "+v"(tid_u));
            if (l == 0 && (uu & 0x8000u)) {
                const int ty = (uu >> 12) & 7, ix = uu & 0xfff, wave_u = tid_u >> 6;
                if (ty == 0) cv_win(384 + ix, tid_u);
                else if (ty == 1) cv_wq(ix, tid_u);
                else if (ty == 2) { for (int k = 0; k < 8; ++k) cv_tr(ix * 64 + k * 8 + wave_u, tid_u); }
                else if (ty == 3) { for (int k = 0; k < 32; k += 2) cv_u(ix * 256 + k * 8 + wave_u, ix * 256 + (k + 1) * 8 + wave_u, tid_u); }
                else cv_v(ix, tid_u);
                __syncthreads();
                continue; }
            const int mode = (uu >> 12) & 3, b = (uu >> 11) & 1, h = (uu >> 4) & 7, qb = uu & 15;
            const unsigned zid = (mode < 2) ? (unsigned)(mode * 192 + (b * 6 + h) * 16 + qb) : (unsigned)(384 + (mode - 2) * 128 + (b * 4 + h) * 16 + qb);
            if (mode == 0) att::attn_unit<0>(tid_u, (char*)lds_raw, ATTp, CUM, O, ODF, b, h, qb, KINFp, Gzp, zid);
            else if (mode == 1) att::attn_unit<1>(tid_u, (char*)lds_raw, ATTp, nullptr, O, ODF, b, h, qb, KINFp, Gzp, zid);
            else if (mode == 2) att::attn_unit<2>(tid_u, (char*)lds_raw, ATTp, nullptr, O, ODF, b, h, qb, KINFp, Gzp, zid);
            else att::attn_unit<3>(tid_u, (char*)lds_raw, ATTp, nullptr, O, ODF, b, h, qb, KINFp, Gzp, zid);
        } }
        }
        GRID_BAR();
        { PHASE_VARS
        { const float* ODF = WSF(WS_ODF); bf16_t* O = (bf16_t*)WSF(WS_OB); const float* lam_q1 = IN(9); const float* lam_k1 = IN(10); const float* lam_q2 = IN(11); const float* lam_k2 = IN(12); const float* subg = IN(13) + l * 128;
          float lamh[4];
#pragma unroll
          for (int h = 0; h < 4; ++h) { float d1 = 0.f, d2 = 0.f; for (int i = 0; i < 64; ++i) { d1 += lam_q1[(l * 4 + h) * 64 + i] * lam_k1[(l * 4 + h) * 64 + i]; d2 += lam_q2[(l * 4 + h) * 64 + i] * lam_k2[(l * 4 + h) * 64 + i]; }
              lamh[h] = expf(d1) - expf(d2) + lam_init; }
        for (int t = gw; t < NT; t += NGW) {
            const int hq = lane >> 4; const float lam = hq == 0 ? lamh[0] : hq == 1 ? lamh[1] : hq == 2 ? lamh[2] : lamh[3];
            const float4 a0 = *(const float4*)(ODF + (size_t)t * 512 + lane * 8), a1 = *(const float4*)(ODF + (size_t)t * 512 + lane * 8 + 4);
            const float4 b0 = *(const float4*)(ODF + ((size_t)NT + t) * 512 + lane * 8), b1 = *(const float4*)(ODF + ((size_t)NT + t) * 512 + lane * 8 + 4);
            float v[8] = {a0.x - lam * b0.x, a0.y - lam * b0.y, a0.z - lam * b0.z, a0.w - lam * b0.w, a1.x - lam * b1.x, a1.y - lam * b1.y, a1.z - lam * b1.z, a1.w - lam * b1.w}; float ss = 0.f;
#pragma unroll
            for (int i = 0; i < 8; ++i) ss += v[i] * v[i];
            ss += __shfl_xor(ss, 1); ss += __shfl_xor(ss, 2); ss += __shfl_xor(ss, 4); ss += __shfl_xor(ss, 8);
            const float rr = rsqrtf(ss * (1.f / 128.f) + RMS_EPS) * (1.f - lam_init); const int dd = (lane & 15) * 8;
            const float4 g0 = *(const float4*)(subg + dd), g1 = *(const float4*)(subg + dd + 4);
            pg8::u32x4 w; w.x = pg8::cvt_pk_bf16(v[0] * rr * g0.x, v[1] * rr * g0.y); w.y = pg8::cvt_pk_bf16(v[2] * rr * g0.z, v[3] * rr * g0.w); w.z = pg8::cvt_pk_bf16(v[4] * rr * g1.x, v[5] * rr * g1.y); w.w = pg8::cvt_pk_bf16(v[6] * rr * g1.z, v[7] * rr * g1.w);
            *(pg8::u32x4*)(O + (size_t)t * DM + 1536 + lane * 8) = w;
        } }
        }
        GRID_BAR();
        { PHASE_VARS
        { pg8::Gemm g{(const bf16_t*)WSF(WS_OB), (const bf16_t*)WSF(WS_WBRT) + (size_t)l * 3 * DM * 768, NT, DM, 768, DM, 768}; pg8::BranchOrder S; S.init(NT, DM, G, bid);
          EpiBranchCarry E{(bf16_t*)WSF(WS_YB), (const bf16_t*)WSF(WS_GATES)};
          pg8::gemm_phase<EpiBranchCarry, pg8::BranchOrder, true, true>(tid, (LAS unsigned char*)lds_raw, g, S, E); }
        }
        GRID_BAR();
        { PHASE_VARS
        { pg8::Gemm g{(const bf16_t*)WSF(WS_YB), (const bf16_t*)WSF(WS_WOT) + (size_t)l * DM * DM, NT, DM, DM, DM, DM}; pg8::StaticOrder S; S.init(NT, DM, G, bid);
          EpiResidM E{(bf16_t*)WSF(WS_X), MODL + 2 * DM, (l == 0) ? (const void*)IN(0) : (const void*)WSF(WS_X), l == 0};
          pg8::gemm_phase<EpiResidM, pg8::StaticOrder, true, true>(tid, (LAS unsigned char*)lds_raw, g, S, E); }
        }
        GRID_BAR();
        { PHASE_VARS
        { const float* modl = MODL; const float* norm2_g = IN(6); const void* X = WSF(WS_X); signed char* HB8 = (signed char*)WSF(WS_HB8); float* SH = WSF(WS_SH);
        for (int t = gw; t < NT; t += NGW) {
            const int b = t / SEQ; const float* g = norm2_g + (size_t)l * DM; const float* sh = modl + (size_t)b * NMOD + 3 * DM; const float* sc = sh + DM;
            float4 v[8]; float ss = 0.f;
#pragma unroll
            for (int j = 0; j < 8; ++j) { v[j] = ldx4(X, false, (size_t)t * DM + lane * 4 + 256 * j); ss += v[j].x * v[j].x + v[j].y * v[j].y + v[j].z * v[j].z + v[j].w * v[j].w; }
            const float r = rsqrtf(wave_sum(ss) * (1.f / DM) + RMS_EPS);
            float hmx = 0.f;
#pragma unroll
            for (int j = 0; j < 8; ++j) { const int d = lane * 4 + 256 * j; const float4 gg = *(const float4*)(g + d), s1 = *(const float4*)(sc + d), s0 = *(const float4*)(sh + d); float4 o;
                o.x = v[j].x * r * gg.x * (1.f + s1.x) + s0.x; o.y = v[j].y * r * gg.y * (1.f + s1.y) + s0.y; o.z = v[j].z * r * gg.z * (1.f + s1.z) + s0.z; o.w = v[j].w * r * gg.w * (1.f + s1.w) + s0.w;
                v[j] = o; hmx = fmaxf(hmx, fmaxf(fmaxf(fabsf(o.x), fabsf(o.y)), fmaxf(fabsf(o.z), fabsf(o.w)))); }
            hmx = fmaxf(wave_max(hmx), 1e-30f); const float hq = 127.f / hmx;
#pragma unroll
            for (int j = 0; j < 8; ++j) *(unsigned*)(HB8 + (size_t)t * DM + lane * 4 + 256 * j) = pk_i8x4(v[j].x * hq, v[j].y * hq, v[j].z * hq, v[j].w * hq);
            if (lane == 0) SH[t] = hmx * (1.f / 127.f);
        } }
        }
        GRID_BAR();
        { PHASE_VARS
        { pg8::Gemm8 g{(const signed char*)WSF(WS_HB8), (const signed char*)WSF(WS_WQT) + (size_t)l * DM * DM, NT, DM, DM, DM, DM}; pg8::StaticOrder S; S.init(NT, DM, G, bid);
          EpiStoreI8 E{WSF(WS_PQ), DM, WSF(WS_SH), WSF(WS_SWQ) + (size_t)l * DM};
          pg8::gemm_phase_i8<EpiStoreI8, pg8::StaticOrder, true, true>(tid, (LAS unsigned char*)lds_raw, g, S, E); }
        }
        { PHASE_VARS
        asm volatile("s_waitcnt vmcnt(0)" ::: "memory"); __syncthreads();
        {
            pg8::Unit uq; { pg8::StaticOrder S; S.init(NT, DM, G, bid); if (!S.next(0, uq)) { uq.pm = 0; uq.pn = 0; } }
            const float* peer_keys = IN(19); const float* PQ = WSF(WS_PQ); int* EIDX = (int*)WSF(WS_EIDX); float* GATE = WSF(WS_GATE);
            const int hh = uq.pn;
            char* imgs = (char*)lds_raw;
            for (int c = tid; c < 4096; c += NTHR) { const int p = c >> 11, k = (c >> 4) & 127, ch = c & 15;
                const float* src = peer_keys + ((((size_t)l * 8 + hh) * 2 + p) * 128 + k) * 128 + ch * 8; const float4 a = *(const float4*)src, b2 = *(const float4*)(src + 4);
                const float f[8] = {a.x, a.y, a.z, a.w, b2.x, b2.y, b2.z, b2.w}; unsigned hw[4], lw[4];
#pragma unroll
                for (int e = 0; e < 4; ++e) { const unsigned h2 = att::cvtpk(f[2 * e], f[2 * e + 1]); hw[e] = h2; lw[e] = att::cvtpk(f[2 * e] - __uint_as_float(h2 << 16), f[2 * e + 1] - __uint_as_float(h2 & 0xffff0000u)); }
                char* dst = imgs + ((p * 2 + (k >> 6)) * 2) * 16384 + (k & 63) * 256 + ((ch * 16) ^ (((k & 63) & 7) << 4));
                *(att::u32x4*)dst = (att::u32x4){hw[0], hw[1], hw[2], hw[3]}; *(att::u32x4*)(dst + 16384) = (att::u32x4){lw[0], lw[1], lw[2], lw[3]}; }
            __syncthreads();
            const int wid = __builtin_amdgcn_readfirstlane(tid >> 6), r32 = lane & 31, hi = lane >> 5;
            if (bid < (NT / 256) * (DM / 256)) { const int tg = uq.pm * 8 + wid;
                const int t = tg * 32 + r32; const float* q = PQ + (size_t)t * DM + hh * 256;
                unsigned w1[16], w2[16];
                topk::half_top16(q, imgs, r32, hi, w1);
                topk::half_top16(q + 128, imgs + 65536, r32, hi, w2);
                float bv[16]; unsigned bp[16];
                topk::combine_top16(w1, w2, hi, bv, bp);
                const float mx = bv[0]; float es = 0.f; float ge[16];
#pragma unroll
                for (int r = 0; r < 16; ++r) { ge[r] = __expf(bv[r] - mx); es += ge[r]; }
                const float inv = 1.f / es;
                if (hi == 0) { int* ep = EIDX + (size_t)t * PE_E + hh * PE_TOP; float* gp = GATE + (size_t)t * PE_E + hh * PE_TOP;
#pragma unroll
                    for (int r4 = 0; r4 < 4; ++r4) { *(int4*)(ep + 4 * r4) = make_int4((int)bp[4 * r4], (int)bp[4 * r4 + 1], (int)bp[4 * r4 + 2], (int)bp[4 * r4 + 3]);
                        *(float4*)(gp + 4 * r4) = make_float4(ge[4 * r4] * inv, ge[4 * r4 + 1] * inv, ge[4 * r4 + 2] * inv, ge[4 * r4 + 3] * inv); } }
            }
            __syncthreads();
        }
        }
        GRID_BAR();
        { PHASE_VARS
        { int* EIDX = (int*)WSF(WS_EIDX); const float* GATE = WSF(WS_GATE); unsigned char* Sm = (unsigned char*)WSF(WS_G); float* GMg = WSF(WS_GM); float* ACTF = WSF(WS_ACTF); const float* DV = WSF(WS_DV) + (size_t)l * 16384;
        for (int t = gw; t < NT; t += NGW) {
            const int e0 = EIDX[(size_t)t * PE_E + lane], e1 = EIDX[(size_t)t * PE_E + 64 + lane]; const float g0 = GATE[(size_t)t * PE_E + lane], g1 = GATE[(size_t)t * PE_E + 64 + lane];
            float s0 = 0.f, s1 = 0.f; bool f0 = true, f1 = true;
            for (int k = 0; k < 64; ++k) { const int ek = __shfl(e0, k); const float gk = __shfl(g0, k);
                if (ek == e0) { s0 += gk; if (k < lane) f0 = false; } if (ek == e1) { s1 += gk; f1 = false; } }
            for (int k = 0; k < 64; ++k) { const int ek = __shfl(e1, k); const float gk = __shfl(g1, k);
                if (ek == e0) s0 += gk; if (ek == e1) { s1 += gk; if (k < lane) f1 = false; } }
            if (f0) { Sm[gaddr(t, e0)] = (unsigned char)(lane + 1); GMg[(size_t)t * PE_E + lane] = s0 * DV[e0]; } else { EIDX[(size_t)t * PE_E + lane] = -1; ACTF[(size_t)t * PE_E + lane] = 0.f; }
            if (f1) { Sm[gaddr(t, e1)] = (unsigned char)(64 + lane + 1); GMg[(size_t)t * PE_E + 64 + lane] = s1 * DV[e1]; } else { EIDX[(size_t)t * PE_E + 64 + lane] = -1; ACTF[(size_t)t * PE_E + 64 + lane] = 0.f; }
        } }
        }
        GRID_BAR();
        { PHASE_VARS
        { pg8::Gemm8 g{(const signed char*)WSF(WS_HB8), (const signed char*)WSF(WS_UB) + (size_t)l * 16384 * DM, NT, 16384, DM, DM, DM}; pg8::StaticOrder S; S.init(NT, 16384, G, bid);
          EpiPeerHid E{(const unsigned char*)WSF(WS_G), WSF(WS_SH), WSF(WS_SU) + (size_t)l * 16384, WSF(WS_ACTF)};
          pg8::gemm_phase_i8<EpiPeerHid, pg8::StaticOrder, true, true>(tid, (LAS unsigned char*)lds_raw, g, S, E); }
        }
        GRID_BAR();
        { PHASE_VARS
        { const int* EIDX = (const int*)WSF(WS_EIDX); const float* ACTF = WSF(WS_ACTF); const float* GMg = WSF(WS_GM); signed char* A8 = (signed char*)WSF(WS_G); float* SA = WSF(WS_SA);
        for (int t = gw; t < NT; t += NGW) {
            const int e0 = EIDX[(size_t)t * PE_E + lane], e1 = EIDX[(size_t)t * PE_E + 64 + lane];
            const float a0 = (e0 >= 0) ? GMg[(size_t)t * PE_E + lane] * gelu_erf(ACTF[(size_t)t * PE_E + lane]) : 0.f, a1 = (e1 >= 0) ? GMg[(size_t)t * PE_E + 64 + lane] * gelu_erf(ACTF[(size_t)t * PE_E + 64 + lane]) : 0.f;
            const float mx = fmaxf(wave_max(fmaxf(fabsf(a0), fabsf(a1))), 1e-30f), q = 127.f / mx;
            if (e0 >= 0) A8[gaddr(t, e0)] = (signed char)(int)rintf(a0 * q);
            if (e1 >= 0) A8[gaddr(t, e1)] = (signed char)(int)rintf(a1 * q);
            if (lane == 0) SA[t] = mx * (1.f / 127.f);
        } }
        }
        GRID_BAR();
        { PHASE_VARS
        { pg8::Gemm8 g{(const signed char*)WSF(WS_G), (const signed char*)WSF(WS_VT) + (size_t)l * DM * 16384, NT, DM, 16384, 256, 16384}; pg8::StaticOrder S; S.init(NT, DM, G, bid);
          EpiResidI8 E{(bf16_t*)WSF(WS_X), MODL + 5 * DM, WSF(WS_SA)};
          pg8::gemm_phase_i8<EpiResidI8, pg8::StaticOrder, true, true, true>(tid, (LAS unsigned char*)lds_raw, g, S, E); }
        }
        GRID_BAR();
    }
    { PHASE_VARS
    { const void* X = WSF(WS_X); const float* final_g = IN(22); float* outp = (float*)IN(23);
    for (int t = gw; t < NT; t += NGW) {
        float4 v[8]; float ss = 0.f;
#pragma unroll
        for (int j = 0; j < 8; ++j) { v[j] = ldx4(X, false, (size_t)t * DM + lane * 4 + 256 * j); ss += v[j].x * v[j].x + v[j].y * v[j].y + v[j].z * v[j].z + v[j].w * v[j].w; }
        const float r = rsqrtf(wave_sum(ss) * (1.f / DM) + RMS_EPS);
#pragma unroll
        for (int j = 0; j < 8; ++j) { const int d = lane * 4 + 256 * j; const float4 gg = *(const float4*)(final_g + d); float4 o;
            o.x = v[j].x * r * gg.x; o.y = v[j].y * r * gg.y; o.z = v[j].z * r * gg.z; o.w = v[j].w * r * gg.w; *(float4*)(outp + (size_t)t * DM + d) = o; }
    } }
    }
}

extern "C" void kernel_launch(void* const* d_in, const int* in_sizes, int n_in, void* d_out, int out_size, void* d_ws, size_t ws_size, hipStream_t stream) {
    static int grid = 0;
    if (grid == 0) {
        if (n_in != 23 || out_size != NT * DM || ws_size < WS_END) { fprintf(stderr, "kernel_launch: unexpected shapes: n_in %d out %d ws %zu (need %zu)\n", n_in, out_size, ws_size, (size_t)WS_END); grid = -1; return; }
        int dev = 0, cus = 0;
        if (hipGetDevice(&dev) != hipSuccess || hipDeviceGetAttribute(&cus, hipDeviceAttributeMultiprocessorCount, dev) != hipSuccess) { grid = -1; return; }
        if (hipFuncSetAttribute((const void*)fwd_kernel, hipFuncAttributeMaxDynamicSharedMemorySize, LDS_BYTES) != hipSuccess) { fprintf(stderr, "kernel_launch: hipFuncSetAttribute failed\n"); grid = -1; return; }
        int per_cu = 0;
        if (hipOccupancyMaxActiveBlocksPerMultiprocessor(&per_cu, (const void*)fwd_kernel, NTHR, LDS_BYTES) != hipSuccess || per_cu < 1) { fprintf(stderr, "kernel_launch: occupancy query says %d\n", per_cu); (void)hipGetLastError(); grid = -1; return; }
        grid = cus;
        if (grid % 8 != 0) grid -= grid % 8;
    }
    if (grid < 0) return;
    (void)hipMemsetAsync((char*)d_ws + WS_CTL, 0, CTL_ZERO_BYTES, stream);
    Args a{};
    for (int i = 0; i < 23; ++i) a.in[i] = (const float*)d_in[i];
    a.out = (float*)d_out; a.ws = (unsigned char*)d_ws;
    hipLaunchKernelGGL(fwd_kernel, dim3(grid), dim3(NTHR), LDS_BYTES, stream, a);
}
```

```cpp
#include <hip/hip_runtime.h>
#include <cstdio>
#include <cstdint>

#define LAS __attribute__((address_space(3)))
#define GAS __attribute__((address_space(1)))

constexpr int NB = 2, SEQ = 4096, DM = 2048, NT = NB * SEQ, DEPTH = 2;
constexpr int INW = 12294;
constexpr int C_FQ = 0, C_FK = 768, C_FV = 1536, C_SQ = 2304, C_SK = 3072, C_SV = 3840, C_DQ = 4608, C_DK = 5120, C_DV = 5632, C_FL = 6144, C_GF = 6150, C_GS = 8198, C_GD = 10246;
constexpr int NMOD = 6 * DM;
constexpr int PE_H = 8, PE_K = 128, PE_TOP = 16, PE_E = PE_H * PE_TOP;
constexpr float RMS_EPS = 1e-6f;

constexpr size_t MiB = 1u << 20;
constexpr size_t WS_CTL = 0, CTL_ZERO_BYTES = 1 * MiB;
constexpr size_t WS_X = 1 * MiB;
constexpr size_t WS_HB = WS_X + (size_t)NT * DM * 4;
constexpr size_t WS_ATT = WS_HB + (size_t)NT * DM * 2;
constexpr size_t WS_GATES = WS_ATT + (size_t)NT * 6144 * 2;
constexpr size_t WS_Y = WS_GATES + (size_t)NT * 6144 * 2;
constexpr size_t WS_G = WS_Y;
constexpr size_t WS_PQ = WS_G + (size_t)NT * 16384;
constexpr size_t WS_WINT = WS_PQ + (size_t)NT * DM * 4;
constexpr size_t WS_WBRT = WS_WINT + (size_t)2 * 12288 * DM * 2;
constexpr size_t WS_WOT = WS_WBRT + (size_t)2 * 3 * DM * 768 * 2;
constexpr size_t WS_WQT = WS_WOT + (size_t)2 * DM * DM * 2;
constexpr size_t WS_OB = WS_WQT + (size_t)2 * DM * DM * 2;
constexpr size_t WS_YB = WS_OB + (size_t)NT * DM * 2;
constexpr size_t WS_UB = WS_YB + (size_t)NT * DM * 2;
constexpr size_t WS_VT = WS_UB + (size_t)2 * 16384 * DM * 2;
constexpr size_t WS_ROPE = WS_VT + (size_t)2 * 16384 * DM * 2;
constexpr size_t WS_FL = WS_ROPE + (size_t)NT * 64 * 4;
constexpr size_t WS_CUM = WS_FL + (size_t)NT * 8 * 4;
constexpr size_t WS_MODP = WS_CUM + (size_t)12 * SEQ * 4;
constexpr size_t WS_MOD = WS_MODP + (size_t)2 * 16 * 2 * NMOD * 4;
constexpr size_t WS_EIDX = WS_MOD + (size_t)2 * 2 * NMOD * 4;
constexpr size_t WS_GATE = WS_EIDX + (size_t)NT * PE_E * 4;
constexpr size_t WS_HB8 = WS_GATE + (size_t)NT * PE_E * 4;
constexpr size_t WS_SH = WS_HB8 + (size_t)NT * DM;
constexpr size_t WS_SU = WS_SH + (size_t)NT * 4;
constexpr size_t WS_DV = WS_SU + (size_t)2 * 16384 * 4;
constexpr size_t WS_GM = WS_DV + (size_t)2 * 16384 * 4;
constexpr size_t WS_ACTF = WS_GM + (size_t)NT * PE_E * 4;
constexpr size_t WS_SA = WS_ACTF + (size_t)NT * PE_E * 4;
constexpr size_t WS_SW = WS_SA + (size_t)NT * 4;
constexpr size_t WS_SH1 = WS_SW + (size_t)2 * 12288 * 4;
constexpr size_t WS_SWQ = WS_SH1 + (size_t)NT * 4;
constexpr size_t WS_ODF = WS_SWQ + (size_t)2 * DM * 4;
constexpr size_t WS_END = WS_ODF + (size_t)2 * NT * 512 * 4;
static_assert(WS_END <= (size_t)1024 * MiB, "workspace map exceeds the guaranteed 1 GiB");

constexpr int CW_BAR = 4096;
constexpr int NWAVES = 8, NTHR = NWAVES * 64;
constexpr int LDS_BYTES = 147456;
constexpr int MISC_OFF = 144 * 1024 - 1024;

#define XB_TMO      128
#define XB_XCNT(j)  (256  + 64 * (j))
#define XB_XSUB(j)  (1280 + 64 * (j))
#define XB_XGEN(j)  (2304 + 64 * (j))
#define XB_TOP      3328
#define XB_TOPGEN   3392
#define XCD_BAR_WORDS 3456
#define XB_SPIN_CAP (1u << 18)

__device__ __forceinline__ unsigned xb_ld(unsigned* p)              { return __hip_atomic_load(p, __ATOMIC_RELAXED, __HIP_MEMORY_SCOPE_AGENT); }
__device__ __forceinline__ unsigned xb_add(unsigned* p, unsigned v) { return __hip_atomic_fetch_add(p, v, __ATOMIC_RELAXED, __HIP_MEMORY_SCOPE_AGENT); }
__device__ __forceinline__ unsigned xb_xcc_id() { return (unsigned)__builtin_amdgcn_s_getreg((3 << 11) | 20) & 0xFu; }
#define XB_SPIN(cond, bar) do { unsigned _sp = 0; while (cond) { __builtin_amdgcn_s_sleep(1); \
    if ((++_sp & 255u) == 0u) { if (xb_ld(&(bar)[XB_TMO])) break; if (_sp > XB_SPIN_CAP) { atomicAdd(&(bar)[XB_TMO], 1u); break; } } } } while (0)

struct XcdBarrier { unsigned* bar; unsigned x; volatile LAS unsigned* st; };

__device__ __forceinline__ XcdBarrier xcd_barrier_post(unsigned* bar, volatile LAS unsigned* st) {
    XcdBarrier b; b.bar = bar; b.x = xb_xcc_id(); b.st = st;
    if (threadIdx.x == 0) (void)xb_add(&bar[XB_XCNT(b.x)], 1u);
    return b;
}
__device__ __forceinline__ void xcd_barrier_complete(unsigned* bar, unsigned x, unsigned& nloc, unsigned& nx) {
    const unsigned G = gridDim.x * gridDim.y * gridDim.z;
    unsigned sum, cnt, mine, sp = 0u;
    for (;;) {
        sum = 0u; cnt = 0u; mine = 0u;
#pragma unroll
        for (unsigned j = 0; j < 16; ++j) { const unsigned c = xb_ld(&bar[XB_XCNT(j)]); sum += c; cnt += (c > 0u) ? 1u : 0u; mine = (j == x) ? c : mine; }
        if (sum == G) break;
        __builtin_amdgcn_s_sleep(1);
        if ((++sp & 255u) == 0u) { if (xb_ld(&bar[XB_TMO])) break; if (sp > XB_SPIN_CAP) { atomicAdd(&bar[XB_TMO], 1u); break; } }
    }
    nloc = mine > 0u ? mine : 1u; nx = cnt > 0u ? cnt : 1u;
}
__device__ __forceinline__ void xcd_barrier(const XcdBarrier& b, const bool thread0) {
    asm volatile("s_waitcnt vmcnt(0)" ::: "memory");
    __syncthreads();
    if (thread0) {
        unsigned* bar = b.bar;
        __builtin_amdgcn_s_waitcnt(0);
        unsigned nloc = b.st[0], nx = b.st[1];
        if (nloc == 0u) { xcd_barrier_complete(bar, b.x, nloc, nx); b.st[0] = nloc; b.st[1] = nx; }
        const unsigned old = xb_add(&bar[XB_XSUB(b.x)], 1u);
        const unsigned gen = old / nloc;
        if (old + 1u == (gen + 1u) * nloc) {
            __builtin_amdgcn_fence(__ATOMIC_RELEASE, "agent");
            asm volatile("s_waitcnt vmcnt(0)" ::: "memory");
            const unsigned og = xb_add(&bar[XB_TOP], 1u);
            const unsigned tg = og / nx;
            if (og + 1u == (tg + 1u) * nx) xb_add(&bar[XB_TOPGEN], 1u);
            else XB_SPIN(xb_ld(&bar[XB_TOPGEN]) == tg, bar);
            __builtin_amdgcn_fence(__ATOMIC_ACQUIRE, "agent");
            xb_add(&bar[XB_XGEN(b.x)], 1u);
            asm volatile("s_waitcnt vmcnt(0)" ::: "memory");
        } else {
            XB_SPIN(xb_ld(&bar[XB_XGEN(b.x)]) == gen, bar);
            __builtin_amdgcn_fence(__ATOMIC_ACQUIRE, "agent");
            asm volatile("s_waitcnt vmcnt(0)" ::: "memory");
        }
    }
    __syncthreads();
}

#define SWZ_XOR(v, m) __int_as_float(__builtin_amdgcn_ds_swizzle(__float_as_int(v), ((m) << 10) | 0x1f))
__device__ __forceinline__ float wave_sum(float v) {
    v += SWZ_XOR(v, 1); v += SWZ_XOR(v, 2); v += SWZ_XOR(v, 4); v += SWZ_XOR(v, 8); v += SWZ_XOR(v, 16);
    auto rr = __builtin_amdgcn_permlane32_swap(__float_as_uint(v), __float_as_uint(v), false, false); return __uint_as_float(rr[0]) + __uint_as_float(rr[1]);
}
__device__ __forceinline__ float logsig(float x) { return fminf(x, 0.f) - log1pf(expf(-fabsf(x))); }
__device__ __forceinline__ float gelu_erf(float x) { return 0.5f * x * (1.f + erff(x * 0.70710678118654752f)); }

__device__ __forceinline__ const float* ldp(volatile LAS unsigned* tab0, int i) {
    unsigned a = (unsigned)(unsigned long long)tab0; asm volatile("" : "+v"(a));
    volatile LAS unsigned* tab = (volatile LAS unsigned*)(unsigned long long)a;
    unsigned lo = tab[2 * i], hi = tab[2 * i + 1];
    lo = __builtin_amdgcn_readfirstlane(lo); hi = __builtin_amdgcn_readfirstlane(hi);
    return (const float*)(const GAS float*)(((unsigned long long)hi << 32) | lo);
}
typedef float vf4_ __attribute__((ext_vector_type(4)));
typedef float vf2_ __attribute__((ext_vector_type(2)));
__device__ __forceinline__ float4 ldnt4(const float* p) { const vf4_ v = __builtin_nontemporal_load((const vf4_*)p); return make_float4(v[0], v[1], v[2], v[3]); }
__device__ __forceinline__ float2 ldnt2(const float* p) { const vf2_ v = __builtin_nontemporal_load((const vf2_*)p); return make_float2(v[0], v[1]); }
__device__ __forceinline__ float ldnt1(const float* p) { return __builtin_nontemporal_load(p); }
__device__ __forceinline__ float4 ldx4(const void* X, const bool f32, const size_t idx) {
    if (f32) return *(const float4*)((const float*)X + idx);
    const uint2 w = *(const uint2*)((const unsigned short*)X + idx);
    return make_float4(__uint_as_float(w.x << 16), __uint_as_float(w.x & 0xffff0000u), __uint_as_float(w.y << 16), __uint_as_float(w.y & 0xffff0000u));
}
__device__ __forceinline__ size_t gaddr(const int t, const int e) { return ((((size_t)(t >> 8) * 64 + (size_t)(e >> 8)) * 256 + (size_t)(t & 255)) * 256) + (size_t)(e & 255); }
struct Args {
    const float* in[23];
    float* out; unsigned char* ws;
};

namespace pg8 {
#define PG8_LAS __attribute__((address_space(3)))
typedef unsigned short bf16_t;
typedef short bf16x8 __attribute__((ext_vector_type(8)));
typedef float f32x4 __attribute__((ext_vector_type(4)));
typedef unsigned u32x4 __attribute__((ext_vector_type(4)));
constexpr int BM = 256, BK = 64, HALF = 128, HTB = HALF * BK * 2  , STAGE_BYTES = 8 * HTB, NXCD = 8, WGM = 8;

__host__ __device__ __forceinline__ int lds_byte(int r, int c) { const int st = (r >> 4) * 2 + (c >> 5), rr = r & 15, cc = c & 31, ob = rr * 64 + cc * 2; return st * 1024 + (ob ^ (((ob >> 9) & 1) << 5)); }
__host__ __device__ __forceinline__ void stage_rc(int b, int& R, int& C) { const int st = b / 1024, sb = b % 1024, swz = sb ^ (((sb >> 9) & 1) << 5); R = (st >> 1) * 16 + swz / 64; C = (st & 1) * 32 + (swz % 64) / 2; }
__host__ __device__ __forceinline__ int perm32(int rho) { const int n = rho >> 4, i = rho & 15; return 8 * (i >> 2) + 4 * n + (i & 3); }

struct Unit { int pm, pn; };
struct Gemm { const bf16_t* A; const bf16_t* Bt; int M, N, K, lda, ldb; };

struct StaticOrder {
    int nM, nN, nwg, G, c;
    __host__ __device__ __forceinline__ void init(int M, int N, int G_, int c_) { nM = M / BM; nN = N / BM; nwg = nM * nN; G = G_; c = c_; }
    __host__ __device__ __forceinline__ bool next(int i, Unit& u) const {
        const long L = (long)i * G + c; if (L >= nwg) return false;
        int wgid = (int)L; { const int q = nwg / NXCD, r = nwg % NXCD, xcd = wgid % NXCD, off = wgid / NXCD; wgid = (xcd < r ? xcd * (q + 1) : r * (q + 1) + (xcd - r) * q) + off; }
        const int nig = WGM * nN, gid = wgid / nig, fm = gid * WGM, gsz = (nM - fm) < WGM ? (nM - fm) : WGM;
        u.pm = fm + ((wgid % nig) % gsz); u.pn = (wgid % nig) / gsz; return true;
    }
    __device__ __forceinline__ void a_ready(const Unit&) const {}
    __device__ __forceinline__ void done(const Unit&) const {}
    __device__ __forceinline__ size_t a_byte(const Unit& u, size_t tstep) const { return (size_t)u.pm * tstep; }
    __device__ __forceinline__ size_t b_byte(const Unit& u, size_t tstep) const { return (size_t)u.pn * tstep; }
    __device__ __forceinline__ int ktiles(const Unit&, int nt) const { return nt; }
};
struct BranchOrder {
    StaticOrder base;
    __device__ void init(int M, int N, int G_, int c_) { base.init(M, N, G_, c_); }
    __device__ bool next(int i, Unit& u) const { if (i >= 3) return false; if (!base.next(0, u)) return false; u.pn += 8 * i; return true; }
    __device__ __forceinline__ void a_ready(const Unit&) const {}
    __device__ __forceinline__ void done(const Unit&) const {}
    __device__ __forceinline__ size_t a_byte(const Unit& u, size_t tstep) const { return (size_t)u.pm * tstep + (size_t)((u.pn >> 3) * 768) * 2; }
    __device__ __forceinline__ size_t b_byte(const Unit& u, size_t) const { return ((size_t)(u.pn >> 3) * 2048 + (size_t)(u.pn & 7) * 256) * 768 * 2; }
    __device__ __forceinline__ int ktiles(const Unit& u, int) const { return (u.pn >> 3) < 2 ? 12 : 8; }
};

__device__ __forceinline__ unsigned cvt_pk_bf16(float lo, float hi) { unsigned r; asm volatile("v_cvt_pk_bf16_f32 %0, %1, %2" : "=v"(r) : "v"(lo), "v"(hi)); return r; }
typedef float f32x2 __attribute__((ext_vector_type(2)));
__device__ __forceinline__ f32x2 gelu_pk(f32x2 v) {
    const f32x2 av = __builtin_elementwise_abs(v), d = av * 0.2316418882f + 1.0f;
    f32x2 t; t.x = __builtin_amdgcn_rcpf(d.x); t.y = __builtin_amdgcn_rcpf(d.y);
    f32x2 q = t * 0.5307027145f + (-0.7265760135f); q = q * t + 0.7107068705f; q = q * t + (-0.142248368f); q = q * t + 0.127414796f; q = q * t;
    const f32x2 s = (v * v) * (-0.72134752044f);
    f32x2 e; e.x = __builtin_amdgcn_exp2f(s.x); e.y = __builtin_amdgcn_exp2f(s.y);
    const f32x2 m = v * (q * e), r = v - m;
    f32x2 o; o.x = v.x < 0.f ? m.x : r.x; o.y = v.y < 0.f ? m.y : r.y; return o;
}

template <class Epi, class Sched, bool ALIGN_EPI = false, bool SP2 = false>
__device__ __forceinline__ void gemm_phase(const int tid, PG8_LAS unsigned char* lds, const Gemm g, const Sched& S, const Epi& E) {
    const int wid = __builtin_amdgcn_readfirstlane(tid >> 6), lane = tid & 63, wr = wid >> 2, wc = wid & 3, fr = lane & 15, fq = lane >> 4;
    const int K = g.K, ntK = K / BK;
    unsigned voffA[2], voffB[2];
#pragma unroll
    for (int i = 0; i < 2; ++i) { int R, C; stage_rc(tid * 16 + i * 8192, R, C); const int Rb = Epi::PERM ? ((R & ~31) + perm32(R & 31)) : R;
        voffA[i] = (unsigned)(R * g.lda + C) * 2u; voffB[i] = (unsigned)(Rb * g.ldb + C) * 2u; }
    const size_t kstep = (size_t)(BK * 2);
    const size_t hstepA = (size_t)HALF * g.lda * 2, hstepB = (size_t)HALF * g.ldb * 2;
    const size_t tstepA = 2 * hstepA, tstepB = 2 * hstepB;
    const unsigned ldsw = (unsigned)wid * 1024u;
    const int aoff = lds_byte(wr * 64 + fr, fq * 8), boff = lds_byte(wc * 32 + fr, fq * 8);
#define PG8_SA(b, h) (((b) * 2 + (h)) * HTB)
#define PG8_SB(b, h) ((4 + (b) * 2 + (h)) * HTB)
#define PG8_STAGE(bufoff, gbase, voff) do { _Pragma("unroll") for (int _i = 0; _i < 2; ++_i) \
        __builtin_amdgcn_global_load_lds((const unsigned*)((const char*)(gbase) + (voff)[_i]), (PG8_LAS unsigned*)(lds + (bufoff) + ldsw + _i * 8192), 16, 0, 0); } while (0)
#define PG8_LDA(dst, b, h) do { _Pragma("unroll") for (int m = 0; m < 4; ++m) _Pragma("unroll") for (int k = 0; k < 2; ++k) dst[m][k] = *(const PG8_LAS bf16x8*)(lds + PG8_SA(b, h) + aoff + m * 2048 + k * 1024); } while (0)
#define PG8_LDB(dst, b, h) do { _Pragma("unroll") for (int n = 0; n < 2; ++n) _Pragma("unroll") for (int k = 0; k < 2; ++k) dst[n][k] = *(const PG8_LAS bf16x8*)(lds + PG8_SB(b, h) + boff + n * 2048 + k * 1024); } while (0)
#define PG8_MMA(ai, bj, At, Bt) do { __builtin_amdgcn_s_setprio(1); _Pragma("unroll") for (int m = 0; m < 4; ++m) _Pragma("unroll") for (int n = 0; n < 2; ++n) _Pragma("unroll") for (int k = 0; k < 2; ++k) \
        acc[ai][bj][m][n] = __builtin_amdgcn_mfma_f32_16x16x32_bf16(Bt[n][k], At[m][k], acc[ai][bj][m][n], 0, 0, 0); __builtin_amdgcn_s_setprio(0); } while (0)
#define PG8_WAIT_V(n) asm volatile("s_waitcnt vmcnt(" #n ")" ::: "memory")
#define PG8_WAIT_L(n) asm volatile("s_waitcnt lgkmcnt(" #n ")" ::: "memory")
#define PG8_BAR __builtin_amdgcn_s_barrier()
#define PG8_SCHED __builtin_amdgcn_sched_barrier(0)
    Unit cur, nxt; int ui = 0;
    if (!S.next(0, cur)) return;
    f32x4 acc[2][2][4][2];
#pragma unroll
    for (int a = 0; a < 2; ++a)
#pragma unroll
        for (int b = 0; b < 2; ++b)
#pragma unroll
            for (int m = 0; m < 4; ++m)
#pragma unroll
                for (int n = 0; n < 2; ++n) acc[a][b][m][n] = (f32x4){0.f, 0.f, 0.f, 0.f};
    bf16x8 At[4][2], B0[2][2], B1[2][2];
    const char* cA = (const char*)g.A + S.a_byte(cur, tstepA); const char* cB = (const char*)g.Bt + S.b_byte(cur, tstepB);
    S.a_ready(cur);
    if constexpr (SP2) {
        PG8_STAGE(PG8_SB(0, 0), cB, voffB); PG8_STAGE(PG8_SB(0, 1), cB + hstepB, voffB); PG8_STAGE(PG8_SA(0, 0), cA, voffA); PG8_STAGE(PG8_SA(0, 1), cA + hstepA, voffA);
        if (wr == 1) PG8_BAR;
        PG8_WAIT_V(2); PG8_BAR;
        PG8_STAGE(PG8_SB(1, 0), cB + kstep, voffB); PG8_STAGE(PG8_SA(1, 0), cA + kstep, voffA); PG8_STAGE(PG8_SB(1, 1), cB + hstepB + kstep, voffB);
        PG8_WAIT_V(6); PG8_BAR;
    } else {
        PG8_STAGE(PG8_SB(0, 0), cB, voffB); PG8_STAGE(PG8_SA(0, 0), cA, voffA); PG8_STAGE(PG8_SB(0, 1), cB + hstepB, voffB); PG8_STAGE(PG8_SA(0, 1), cA + hstepA, voffA);
        if (wr == 1) PG8_BAR;
        PG8_WAIT_V(4); PG8_BAR;
        PG8_STAGE(PG8_SB(1, 0), cB + kstep, voffB); PG8_STAGE(PG8_SA(1, 0), cA + kstep, voffA); PG8_STAGE(PG8_SB(1, 1), cB + hstepB + kstep, voffB);
        PG8_WAIT_V(6); PG8_BAR;
    }
    for (;;) {
        const bool has_next = S.next(ui + 1, nxt);
        const char* nA = has_next ? (const char*)g.A + S.a_byte(nxt, tstepA) : cA; const char* nB = has_next ? (const char*)g.Bt + S.b_byte(nxt, tstepB) : cB;
        const int nt = S.ktiles(cur, ntK);
        for (int t = 0; t < nt; t += 2) {
            const bool last = (t == nt - 2);
            const char* a1 = cA + (size_t)(t + 1) * kstep;
            const char* a2 = last ? nA : cA + (size_t)(t + 2) * kstep; const char* b2 = last ? nB : cB + (size_t)(t + 2) * kstep;
            const char* a3 = a2 + kstep; const char* b3 = b2 + kstep;
            if (last && has_next) S.a_ready(nxt);
            if constexpr (SP2) {
            PG8_LDB(B0, 0, 0); PG8_LDB(B1, 0, 1); PG8_SCHED; PG8_LDA(At, 0, 0); PG8_STAGE(PG8_SA(1, 1), a1 + hstepA, voffA);
            PG8_WAIT_V(8); PG8_WAIT_L(0); PG8_BAR; PG8_MMA(0, 0, At, B0); PG8_MMA(0, 1, At, B1); PG8_BAR; PG8_SCHED;
            PG8_LDA(At, 0, 1); PG8_STAGE(PG8_SB(0, 0), b2, voffB); PG8_STAGE(PG8_SB(0, 1), b2 + hstepB, voffB); PG8_STAGE(PG8_SA(0, 0), a2, voffA);
            PG8_WAIT_V(8); PG8_WAIT_L(0); PG8_BAR; PG8_MMA(1, 0, At, B0); PG8_MMA(1, 1, At, B1); PG8_BAR; PG8_SCHED;
            PG8_LDB(B0, 1, 0); PG8_LDB(B1, 1, 1); PG8_SCHED; PG8_LDA(At, 1, 0); PG8_STAGE(PG8_SA(0, 1), a2 + hstepA, voffA);
            PG8_WAIT_V(8); PG8_WAIT_L(0); PG8_BAR; PG8_MMA(0, 0, At, B0); PG8_MMA(0, 1, At, B1); PG8_BAR; PG8_SCHED;
            PG8_LDA(At, 1, 1); PG8_STAGE(PG8_SB(1, 0), b3, voffB); PG8_STAGE(PG8_SB(1, 1), b3 + hstepB, voffB); PG8_STAGE(PG8_SA(1, 0), a3, voffA);
            PG8_WAIT_V(8); PG8_WAIT_L(0); PG8_BAR; PG8_MMA(1, 0, At, B0); PG8_MMA(1, 1, At, B1); PG8_BAR; PG8_SCHED;
            } else {
            PG8_LDB(B0, 0, 0); PG8_SCHED; PG8_LDA(At, 0, 0); PG8_STAGE(PG8_SA(1, 1), a1 + hstepA, voffA);
            PG8_WAIT_L(8); PG8_BAR; PG8_WAIT_L(0); PG8_MMA(0, 0, At, B0); PG8_BAR; PG8_SCHED;
            PG8_LDB(B1, 0, 1); PG8_STAGE(PG8_SB(0, 0), b2, voffB);
            PG8_BAR; PG8_WAIT_L(0); PG8_MMA(0, 1, At, B1); PG8_BAR;
            PG8_LDA(At, 0, 1); PG8_STAGE(PG8_SA(0, 0), a2, voffA);
            PG8_BAR; PG8_WAIT_L(0); PG8_MMA(1, 0, At, B0); PG8_BAR; PG8_SCHED;
            PG8_STAGE(PG8_SB(0, 1), b2 + hstepB, voffB);
            PG8_WAIT_V(6); PG8_BAR; PG8_MMA(1, 1, At, B1); PG8_BAR;
            PG8_LDB(B0, 1, 0); PG8_SCHED; PG8_LDA(At, 1, 0); PG8_STAGE(PG8_SA(0, 1), a2 + hstepA, voffA);
            PG8_WAIT_L(8); PG8_BAR; PG8_WAIT_L(0); PG8_MMA(0, 0, At, B0); PG8_BAR; PG8_SCHED;
            PG8_LDB(B1, 1, 1); PG8_STAGE(PG8_SB(1, 0), b3, voffB);
            PG8_BAR; PG8_WAIT_L(0); PG8_MMA(0, 1, At, B1); PG8_BAR;
            PG8_LDA(At, 1, 1); PG8_STAGE(PG8_SA(1, 0), a3, voffA);
            PG8_BAR; PG8_WAIT_L(0); PG8_MMA(1, 0, At, B0); PG8_BAR; PG8_SCHED;
            PG8_STAGE(PG8_SB(1, 1), b3 + hstepB, voffB);
            PG8_WAIT_V(6); PG8_BAR; PG8_MMA(1, 1, At, B1); PG8_BAR;
            }
        }
        if constexpr (ALIGN_EPI) { if (wr == 0) PG8_BAR; }
        if constexpr (!Epi::AFTER_DRAIN) { E(acc, cur, wr, wc, fr, fq); S.done(cur); }
        if (!has_next) break;
        if constexpr (!Epi::CARRY) {
#pragma unroll
        for (int a = 0; a < 2; ++a)
#pragma unroll
            for (int b = 0; b < 2; ++b)
#pragma unroll
                for (int m = 0; m < 4; ++m)
#pragma unroll
                    for (int n = 0; n < 2; ++n) acc[a][b][m][n] = (f32x4){0.f, 0.f, 0.f, 0.f};
        }
        cur = nxt; cA = nA; cB = nB; ++ui;
        if constexpr (ALIGN_EPI) { if (wr == 1) PG8_BAR; }
    }
    PG8_WAIT_V(0);
    if constexpr (!ALIGN_EPI) { if (wr == 0) PG8_BAR; }
    PG8_BAR;
    if constexpr (Epi::AFTER_DRAIN) { E.fused(acc, cur, wr, wc, fr, fq, lds, wid, lane); S.done(cur); }
#undef PG8_SA
#undef PG8_SB
#undef PG8_STAGE
#undef PG8_LDA
#undef PG8_LDB
#undef PG8_MMA
#undef PG8_WAIT_V
#undef PG8_WAIT_L
#undef PG8_BAR
#undef PG8_SCHED
}

typedef int i32x4 __attribute__((ext_vector_type(4)));
struct Gemm8 { const signed char* A; const signed char* Bt; int M, N, K, lda, ldb; };
template <class Epi, class Sched, bool ALIGN_EPI = false, bool SP2 = false, bool A_TILED = false>
__device__ __forceinline__ void gemm_phase_i8(const int tid, PG8_LAS unsigned char* lds, const Gemm8 g, const Sched& S, const Epi& E) {
    const int wid = __builtin_amdgcn_readfirstlane(tid >> 6), lane = tid & 63, wr = wid >> 2, wc = wid & 3, fr = lane & 15, fq = lane >> 4;
    const int K = g.K, nt = K / 128;
    unsigned voffA[2], voffB[2];
#pragma unroll
    for (int i = 0; i < 2; ++i) { int R, C; stage_rc(tid * 16 + i * 8192, R, C); const int Rb = Epi::PERM ? ((R & ~31) + perm32(R & 31)) : R;
        voffA[i] = (unsigned)(R * g.lda + 2 * C); voffB[i] = (unsigned)(Rb * g.ldb + 2 * C); }
    const size_t kstep = (size_t)128;
    const size_t hstepA = (size_t)HALF * g.lda, hstepB = (size_t)HALF * g.ldb;
    const size_t tstepA = A_TILED ? (size_t)(g.K / 256) * 65536 : 2 * hstepA, tstepB = 2 * hstepB;
    const unsigned ldsw = (unsigned)wid * 1024u;
    const int aoff = lds_byte(wr * 64 + fr, fq * 8), boff = lds_byte(wc * 32 + fr, fq * 8);
#define PG8_SA(b, h) (((b) * 2 + (h)) * HTB)
#define PG8_SB(b, h) ((4 + (b) * 2 + (h)) * HTB)
#define PG8_STAGE(bufoff, gbase, voff) do { _Pragma("unroll") for (int _i = 0; _i < 2; ++_i) \
        __builtin_amdgcn_global_load_lds((const unsigned*)((const char*)(gbase) + (voff)[_i]), (PG8_LAS unsigned*)(lds + (bufoff) + ldsw + _i * 8192), 16, 0, 0); } while (0)
#define PG8_LDA(dst, b, h) do { _Pragma("unroll") for (int m = 0; m < 4; ++m) _Pragma("unroll") for (int k = 0; k < 2; ++k) dst[m][k] = *(const PG8_LAS bf16x8*)(lds + PG8_SA(b, h) + aoff + m * 2048 + k * 1024); } while (0)
#define PG8_LDB(dst, b, h) do { _Pragma("unroll") for (int n = 0; n < 2; ++n) _Pragma("unroll") for (int k = 0; k < 2; ++k) dst[n][k] = *(const PG8_LAS bf16x8*)(lds + PG8_SB(b, h) + boff + n * 2048 + k * 1024); } while (0)
#define PG8_MMA(ai, bj, At, Bt) do { __builtin_amdgcn_s_setprio(1); _Pragma("unroll") for (int m = 0; m < 4; ++m) _Pragma("unroll") for (int n = 0; n < 2; ++n) _Pragma("unroll") for (int k = 0; k < 2; ++k) \
        acc[ai][bj][m][n] = __builtin_amdgcn_mfma_i32_16x16x64_i8(__builtin_bit_cast(i32x4, Bt[n][k]), __builtin_bit_cast(i32x4, At[m][k]), acc[ai][bj][m][n], 0, 0, 0); __builtin_amdgcn_s_setprio(0); } while (0)
#define PG8_WAIT_V(n) asm volatile("s_waitcnt vmcnt(" #n ")" ::: "memory")
#define PG8_WAIT_L(n) asm volatile("s_waitcnt lgkmcnt(" #n ")" ::: "memory")
#define PG8_BAR __builtin_amdgcn_s_barrier()
#define PG8_SCHED __builtin_amdgcn_sched_barrier(0)
    Unit cur, nxt; int ui = 0;
    if (!S.next(0, cur)) return;
    i32x4 acc[2][2][4][2];
#pragma unroll
    for (int a = 0; a < 2; ++a)
#pragma unroll
        for (int b = 0; b < 2; ++b)
#pragma unroll
            for (int m = 0; m < 4; ++m)
#pragma unroll
                for (int n = 0; n < 2; ++n) acc[a][b][m][n] = (i32x4){0, 0, 0, 0};
    bf16x8 At[4][2], B0[2][2], B1[2][2];
    const char* cA = (const char*)g.A + (size_t)cur.pm * tstepA; const char* cB = (const char*)g.Bt + (size_t)cur.pn * tstepB;
    S.a_ready(cur);
    if constexpr (SP2) {
        PG8_STAGE(PG8_SB(0, 0), cB, voffB); PG8_STAGE(PG8_SB(0, 1), cB + hstepB, voffB); PG8_STAGE(PG8_SA(0, 0), cA, voffA); PG8_STAGE(PG8_SA(0, 1), cA + hstepA, voffA);
        if (wr == 1) PG8_BAR;
        PG8_WAIT_V(2); PG8_BAR;
        PG8_STAGE(PG8_SB(1, 0), cB + kstep, voffB); PG8_STAGE(PG8_SA(1, 0), cA + kstep, voffA); PG8_STAGE(PG8_SB(1, 1), cB + hstepB + kstep, voffB);
        PG8_WAIT_V(6); PG8_BAR;
    } else {
        PG8_STAGE(PG8_SB(0, 0), cB, voffB); PG8_STAGE(PG8_SA(0, 0), cA, voffA); PG8_STAGE(PG8_SB(0, 1), cB + hstepB, voffB); PG8_STAGE(PG8_SA(0, 1), cA + hstepA, voffA);
        if (wr == 1) PG8_BAR;
        PG8_WAIT_V(4); PG8_BAR;
        PG8_STAGE(PG8_SB(1, 0), cB + kstep, voffB); PG8_STAGE(PG8_SA(1, 0), cA + kstep, voffA); PG8_STAGE(PG8_SB(1, 1), cB + hstepB + kstep, voffB);
        PG8_WAIT_V(6); PG8_BAR;
    }
    for (;;) {
        const bool has_next = S.next(ui + 1, nxt);
        const char* nA = has_next ? (const char*)g.A + (size_t)nxt.pm * tstepA : cA; const char* nB = has_next ? (const char*)g.Bt + (size_t)nxt.pn * tstepB : cB;
        for (int t = 0; t < nt; t += 2) {
            const bool last = (t == nt - 2);
            const char* a1 = A_TILED ? cA + (size_t)(t >> 1) * 65536 + 128 : cA + (size_t)(t + 1) * kstep;
            const char* a2 = last ? nA : (A_TILED ? cA + (size_t)((t >> 1) + 1) * 65536 : cA + (size_t)(t + 2) * kstep); const char* b2 = last ? nB : cB + (size_t)(t + 2) * kstep;
            const char* a3 = a2 + kstep; const char* b3 = b2 + kstep;
            if (last && has_next) S.a_ready(nxt);
            if constexpr (SP2) {
            PG8_LDB(B0, 0, 0); PG8_LDB(B1, 0, 1); PG8_SCHED; PG8_LDA(At, 0, 0); PG8_STAGE(PG8_SA(1, 1), a1 + hstepA, voffA);
            PG8_WAIT_V(8); PG8_WAIT_L(0); PG8_BAR; PG8_MMA(0, 0, At, B0); PG8_MMA(0, 1, At, B1); PG8_BAR; PG8_SCHED;
            PG8_LDA(At, 0, 1); PG8_STAGE(PG8_SB(0, 0), b2, voffB); PG8_STAGE(PG8_SB(0, 1), b2 + hstepB, voffB); PG8_STAGE(PG8_SA(0, 0), a2, voffA);
            PG8_WAIT_V(8); PG8_WAIT_L(0); PG8_BAR; PG8_MMA(1, 0, At, B0); PG8_MMA(1, 1, At, B1); PG8_BAR; PG8_SCHED;
            PG8_LDB(B0, 1, 0); PG8_LDB(B1, 1, 1); PG8_SCHED; PG8_LDA(At, 1, 0); PG8_STAGE(PG8_SA(0, 1), a2 + hstepA, voffA);
            PG8_WAIT_V(8); PG8_WAIT_L(0); PG8_BAR; PG8_MMA(0, 0, At, B0); PG8_MMA(0, 1, At, B1); PG8_BAR; PG8_SCHED;
            PG8_LDA(At, 1, 1); PG8_STAGE(PG8_SB(1, 0), b3, voffB); PG8_STAGE(PG8_SB(1, 1), b3 + hstepB, voffB); PG8_STAGE(PG8_SA(1, 0), a3, voffA);
            PG8_WAIT_V(8); PG8_WAIT_L(0); PG8_BAR; PG8_MMA(1, 0, At, B0); PG8_MMA(1, 1, At, B1); PG8_BAR; PG8_SCHED;
            } else {
            PG8_LDB(B0, 0, 0); PG8_SCHED; PG8_LDA(At, 0, 0); PG8_STAGE(PG8_SA(1, 1), a1 + hstepA, voffA);
            PG8_WAIT_L(8); PG8_BAR; PG8_WAIT_L(0); PG8_MMA(0, 0, At, B0); PG8_BAR; PG8_SCHED;
            PG8_LDB(B1, 0, 1); PG8_STAGE(PG8_SB(0, 0), b2, voffB);
            PG8_BAR; PG8_WAIT_L(0); PG8_MMA(0, 1, At, B1); PG8_BAR;
            PG8_LDA(At, 0, 1); PG8_STAGE(PG8_SA(0, 0), a2, voffA);
            PG8_BAR; PG8_WAIT_L(0); PG8_MMA(1, 0, At, B0); PG8_BAR; PG8_SCHED;
            PG8_STAGE(PG8_SB(0, 1), b2 + hstepB, voffB);
            PG8_WAIT_V(6); PG8_BAR; PG8_MMA(1, 1, At, B1); PG8_BAR;
            PG8_LDB(B0, 1, 0); PG8_SCHED; PG8_LDA(At, 1, 0); PG8_STAGE(PG8_SA(0, 1), a2 + hstepA, voffA);
            PG8_WAIT_L(8); PG8_BAR; PG8_WAIT_L(0); PG8_MMA(0, 0, At, B0); PG8_BAR; PG8_SCHED;
            PG8_LDB(B1, 1, 1); PG8_STAGE(PG8_SB(1, 0), b3, voffB);
            PG8_BAR; PG8_WAIT_L(0); PG8_MMA(0, 1, At, B1); PG8_BAR;
            PG8_LDA(At, 1, 1); PG8_STAGE(PG8_SA(1, 0), a3, voffA);
            PG8_BAR; PG8_WAIT_L(0); PG8_MMA(1, 0, At, B0); PG8_BAR; PG8_SCHED;
            PG8_STAGE(PG8_SB(1, 1), b3 + hstepB, voffB);
            PG8_WAIT_V(6); PG8_BAR; PG8_MMA(1, 1, At, B1); PG8_BAR;
            }
        }
        if constexpr (ALIGN_EPI) { if (wr == 0) PG8_BAR; }
        if constexpr (!Epi::AFTER_DRAIN) { E(acc, cur, wr, wc, fr, fq); S.done(cur); }
        if (!has_next) break;
#pragma unroll
        for (int a = 0; a < 2; ++a)
#pragma unroll
            for (int b = 0; b < 2; ++b)
#pragma unroll
                for (int m = 0; m < 4; ++m)
#pragma unroll
                    for (int n = 0; n < 2; ++n) acc[a][b][m][n] = (i32x4){0, 0, 0, 0};
        cur = nxt; cA = nA; cB = nB; ++ui;
        if constexpr (ALIGN_EPI) { if (wr == 1) PG8_BAR; }
    }
    PG8_WAIT_V(0);
    if constexpr (!ALIGN_EPI) { if (wr == 0) PG8_BAR; }
    PG8_BAR;
    if constexpr (Epi::AFTER_DRAIN) { E.fused(acc, cur, wr, wc, fr, fq, lds, wid, lane); S.done(cur); }
#undef PG8_SA
#undef PG8_SB
#undef PG8_STAGE
#undef PG8_LDA
#undef PG8_LDB
#undef PG8_MMA
#undef PG8_WAIT_V
#undef PG8_WAIT_L
#undef PG8_BAR
#undef PG8_SCHED
}

}

__device__ __forceinline__ unsigned pk_i8x4(float a, float b, float c, float d) {
    const int ia = (int)rintf(a), ib = (int)rintf(b), ic = (int)rintf(c), id = (int)rintf(d);
    return ((unsigned)ia & 0xffu) | (((unsigned)ib & 0xffu) << 8) | (((unsigned)ic & 0xffu) << 16) | (((unsigned)id & 0xffu) << 24); }
__device__ __forceinline__ float wave_max(float v) {
    v = fmaxf(v, SWZ_XOR(v, 1)); v = fmaxf(v, SWZ_XOR(v, 2)); v = fmaxf(v, SWZ_XOR(v, 4)); v = fmaxf(v, SWZ_XOR(v, 8)); v = fmaxf(v, SWZ_XOR(v, 16));
    auto rr = __builtin_amdgcn_permlane32_swap(__float_as_uint(v), __float_as_uint(v), false, false); return fmaxf(__uint_as_float(rr[0]), __uint_as_float(rr[1])); }
typedef unsigned short bf16_t;

struct EpiProj {
    static constexpr bool PERM = true, AFTER_DRAIN = false;
    bf16_t* ATT; bf16_t* GATES; const float* ROPE; const float* SH; const float* SW; unsigned* KINF;
    template <int MODE, bool KT>
    __device__ __forceinline__ void run(const pg8::i32x4 (&acc)[2][2][4][2], const pg8::Unit& u, int wr, int wc, int fr, int fq) const {
        using pg8::f32x4; using pg8::u32x4; using pg8::cvt_pk_bf16;
        const int row0 = u.pm * 256 + wr * 64 + fr, pn = u.pn;
        float mxk[2] = {0.f, 0.f};
        bf16_t* base = (MODE == 2) ? GATES : ATT; const int colt = (MODE == 2) ? (pn - 24) * 256 : pn * 256;
        float shr[2][4]; f32x4 sw[2][2];
#pragma unroll
        for (int ai = 0; ai < 2; ++ai)
#pragma unroll
            for (int m = 0; m < 4; ++m) shr[ai][m] = SH[row0 + ai * 128 + m * 16];
#pragma unroll
        for (int bj = 0; bj < 2; ++bj) { const int ncol = pn * 256 + bj * 128 + wc * 32 + 8 * fq; sw[bj][0] = *(const f32x4*)(SW + ncol); sw[bj][1] = *(const f32x4*)(SW + ncol + 4); }
#pragma unroll
        for (int ai = 0; ai < 2; ++ai)
#pragma unroll
            for (int m = 0; m < 4; ++m) { const int row = row0 + ai * 128 + m * 16;
#pragma unroll
                for (int bj = 0; bj < 2; ++bj) { const int col = colt + bj * 128 + wc * 32 + 8 * fq;
                    const pg8::i32x4 i0 = acc[ai][bj][m][0], i1 = acc[ai][bj][m][1]; const f32x4 w0 = sw[bj][0] * shr[ai][m], w1 = sw[bj][1] * shr[ai][m];
                    f32x4 v0 = {(float)i0[0] * w0[0], (float)i0[1] * w0[1], (float)i0[2] * w0[2], (float)i0[3] * w0[3]}, v1 = {(float)i1[0] * w1[0], (float)i1[1] * w1[1], (float)i1[2] * w1[2], (float)i1[3] * w1[3]};
                    if constexpr (MODE == 1) { const int j = (col & 63) >> 3; const f32x4 cs0 = *(const f32x4*)(ROPE + (size_t)row * 64 + 8 * j), cs1 = *(const f32x4*)(ROPE + (size_t)row * 64 + 8 * j + 4);
                        f32x4 y0, y1;
                        y0[0] = v0[0] * cs0[0] - v1[0] * cs0[1]; y1[0] = v0[0] * cs0[1] + v1[0] * cs0[0];
                        y0[1] = v0[1] * cs0[2] - v1[1] * cs0[3]; y1[1] = v0[1] * cs0[3] + v1[1] * cs0[2];
                        y0[2] = v0[2] * cs1[0] - v1[2] * cs1[1]; y1[2] = v0[2] * cs1[1] + v1[2] * cs1[0];
                        y0[3] = v0[3] * cs1[2] - v1[3] * cs1[3]; y1[3] = v0[3] * cs1[3] + v1[3] * cs1[2];
                        v0 = y0; v1 = y1; }
                    if constexpr (MODE == 2) {
#pragma unroll
                        for (int e = 0; e < 4; ++e) { v0[e] = fminf(1.f + __expf(-v0[e]), 1e12f); v1[e] = fminf(1.f + __expf(-v1[e]), 1e12f); } }
                    if constexpr (KT) mxk[bj] = fmaxf(fmaxf(mxk[bj], fmaxf(fmaxf(fabsf(v0[0]), fabsf(v0[1])), fmaxf(fabsf(v0[2]), fabsf(v0[3])))), fmaxf(fmaxf(fabsf(v1[0]), fabsf(v1[1])), fmaxf(fabsf(v1[2]), fabsf(v1[3]))));
                    u32x4 w; w.x = cvt_pk_bf16(v0[0], v0[1]); w.y = cvt_pk_bf16(v0[2], v0[3]); w.z = cvt_pk_bf16(v1[0], v1[1]); w.w = cvt_pk_bf16(v1[2], v1[3]);
                    *(u32x4*)(base + (size_t)row * 6144 + col) = w; } }
        if constexpr (KT) {
#pragma unroll
            for (int bj = 0; bj < 2; ++bj) { const float mw = wave_max(mxk[bj]); if (fr == 0 && fq == 0) atomicMax(KINF + ((u.pm * 256) / SEQ) * 8 + 2 * (pn - 3) + bj, __float_as_uint(mw)); } }
    }
    __device__ __forceinline__ void operator()(const pg8::i32x4 (&acc)[2][2][4][2], const pg8::Unit& u, int wr, int wc, int fr, int fq) const {
        const int pn = u.pn;
        if (pn >= 24) run<2, false>(acc, u, wr, wc, fr, fq);
        else if (pn >= 18 && pn < 22) run<1, false>(acc, u, wr, wc, fr, fq);
        else if (pn >= 3 && pn < 6) run<0, true>(acc, u, wr, wc, fr, fq);
        else run<0, false>(acc, u, wr, wc, fr, fq);
    }
};

template <int MODE> struct EpiBranch {
    static constexpr bool PERM = false, AFTER_DRAIN = false, CARRY = false;
    float* YP; bf16_t* YB; const bf16_t* GATES; int gcol;
    __device__ __forceinline__ void operator()(const pg8::f32x4 (&acc)[2][2][4][2], const pg8::Unit& u, int wr, int wc, int fr, int fq) const {
        using pg8::f32x4;
        const int row0 = u.pm * 256 + wr * 64 + fr, col0 = u.pn * 256 + wc * 32 + 4 * fq;
#pragma unroll
        for (int ai = 0; ai < 2; ++ai)
#pragma unroll
            for (int m = 0; m < 4; ++m) { const size_t row = row0 + ai * 128 + m * 16;
#pragma unroll
                for (int bj = 0; bj < 2; ++bj)
#pragma unroll
                    for (int n = 0; n < 2; ++n) { const int col = col0 + bj * 128 + n * 16; const uint2 gw2 = *(const uint2*)(GATES + row * 6144 + gcol + col);
                        f32x4 g; g[0] = __uint_as_float(gw2.x << 16); g[1] = __uint_as_float(gw2.x & 0xffff0000u); g[2] = __uint_as_float(gw2.y << 16); g[3] = __uint_as_float(gw2.y & 0xffff0000u);
                        f32x4 v = g * acc[ai][bj][m][n]; float* yp = YP + row * DM + col;
                        if (MODE >= 1) v = v + *(const f32x4*)yp;
                        if (MODE <= 1) *(f32x4*)yp = v;
                        else { uint2 w; w.x = pg8::cvt_pk_bf16(v[0], v[1]); w.y = pg8::cvt_pk_bf16(v[2], v[3]); *(uint2*)(YB + row * DM + col) = w; } } }
    }
};
struct EpiBranchAll {
    static constexpr bool PERM = false, AFTER_DRAIN = false, CARRY = false;
    float* YP; bf16_t* YB; const bf16_t* GATES;
    __device__ __forceinline__ void operator()(const pg8::f32x4 (&acc)[2][2][4][2], const pg8::Unit& u, int wr, int wc, int fr, int fq) const {
        const pg8::Unit v{u.pm, u.pn & 7}; const int br = u.pn >> 3;
        if (br == 0) { EpiBranch<0> e{YP, YB, GATES, 0}; e(acc, v, wr, wc, fr, fq); }
        else if (br == 1) { EpiBranch<1> e{YP, YB, GATES, 2048}; e(acc, v, wr, wc, fr, fq); }
        else { EpiBranch<2> e{YP, YB, GATES, 4096}; e(acc, v, wr, wc, fr, fq); }
    }
};
struct EpiBranchCarry {
    static constexpr bool PERM = false, AFTER_DRAIN = false, CARRY = true;
    bf16_t* YB; const bf16_t* GATES;
    static __device__ __forceinline__ pg8::f32x4 gate4(const uint2 w) { pg8::f32x4 g; g[0] = __uint_as_float(w.x << 16); g[1] = __uint_as_float(w.x & 0xffff0000u); g[2] = __uint_as_float(w.y << 16); g[3] = __uint_as_float(w.y & 0xffff0000u); return g; }
    __device__ __forceinline__ void operator()(pg8::f32x4 (&acc)[2][2][4][2], const pg8::Unit& u, int wr, int wc, int fr, int fq) const {
        using pg8::f32x4;
        const int br = u.pn >> 3, row0 = u.pm * 256 + wr * 64 + fr, col0 = (u.pn & 7) * 256 + wc * 32 + 4 * fq; const bf16_t* ga = GATES + br * 2048;
        if (br < 2) {
#pragma unroll
            for (int ai = 0; ai < 2; ++ai) { uint2 gq[4][2][2], hq[4][2][2];
#pragma unroll
                for (int m = 0; m < 4; ++m) { const size_t row = row0 + ai * 128 + m * 16;
#pragma unroll
                    for (int bj = 0; bj < 2; ++bj)
#pragma unroll
                        for (int n = 0; n < 2; ++n) { const int col = col0 + bj * 128 + n * 16; gq[m][bj][n] = *(const uint2*)(ga + row * 6144 + col); hq[m][bj][n] = *(const uint2*)(ga + row * 6144 + 2048 + col); } }
                asm volatile("" ::: "memory");
#pragma unroll
                for (int m = 0; m < 4; ++m)
#pragma unroll
                    for (int bj = 0; bj < 2; ++bj)
#pragma unroll
                        for (int n = 0; n < 2; ++n) { const f32x4 g = gate4(gq[m][bj][n]), h = gate4(hq[m][bj][n]);
                            f32x4 r; r[0] = h[0] * __builtin_amdgcn_rcpf(g[0]); r[1] = h[1] * __builtin_amdgcn_rcpf(g[1]); r[2] = h[2] * __builtin_amdgcn_rcpf(g[2]); r[3] = h[3] * __builtin_amdgcn_rcpf(g[3]);
                            acc[ai][bj][m][n] = acc[ai][bj][m][n] * r; } }
        } else {
#pragma unroll
            for (int ai = 0; ai < 2; ++ai) { uint2 gq[4][2][2];
#pragma unroll
                for (int m = 0; m < 4; ++m) { const size_t row = row0 + ai * 128 + m * 16;
#pragma unroll
                    for (int bj = 0; bj < 2; ++bj)
#pragma unroll
                        for (int n = 0; n < 2; ++n) gq[m][bj][n] = *(const uint2*)(ga + row * 6144 + col0 + bj * 128 + n * 16); }
                asm volatile("" ::: "memory");
#pragma unroll
                for (int m = 0; m < 4; ++m) { const size_t row = row0 + ai * 128 + m * 16;
#pragma unroll
                    for (int bj = 0; bj < 2; ++bj)
#pragma unroll
                        for (int n = 0; n < 2; ++n) { const int col = col0 + bj * 128 + n * 16; const f32x4 e4 = gate4(gq[m][bj][n]), a4 = acc[ai][bj][m][n]; const f32x4 v = {a4[0] * __builtin_amdgcn_rcpf(e4[0]), a4[1] * __builtin_amdgcn_rcpf(e4[1]), a4[2] * __builtin_amdgcn_rcpf(e4[2]), a4[3] * __builtin_amdgcn_rcpf(e4[3])};
                            uint2 w; w.x = pg8::cvt_pk_bf16(v[0], v[1]); w.y = pg8::cvt_pk_bf16(v[2], v[3]); *(uint2*)(YB + row * DM + col) = w; } } }
        }
    }
};
struct EpiResidM {
    static constexpr bool PERM = false, AFTER_DRAIN = false, CARRY = false;
    bf16_t* X; const float* gt; const void* Xb; bool xb_f32;
    __device__ __forceinline__ void operator()(const pg8::f32x4 (&acc)[2][2][4][2], const pg8::Unit& u, int wr, int wc, int fr, int fq) const {
        using pg8::f32x4;
        const int row0 = u.pm * 256 + wr * 64 + fr, col0 = u.pn * 256 + wc * 32 + 4 * fq; const float* gtb = gt + (size_t)((u.pm * 256) / SEQ) * NMOD;
        f32x4 g4[2][2];
#pragma unroll
        for (int bj = 0; bj < 2; ++bj)
#pragma unroll
            for (int n = 0; n < 2; ++n) g4[bj][n] = *(const f32x4*)(gtb + col0 + bj * 128 + n * 16);
#pragma unroll
        for (int ai = 0; ai < 2; ++ai) { float4 xq[4][2][2];
#pragma unroll
            for (int m = 0; m < 4; ++m) { const size_t row = row0 + ai * 128 + m * 16;
#pragma unroll
                for (int bj = 0; bj < 2; ++bj)
#pragma unroll
                    for (int n = 0; n < 2; ++n) xq[m][bj][n] = ldx4(Xb, xb_f32, row * DM + col0 + bj * 128 + n * 16); }
            asm volatile("" ::: "memory");
#pragma unroll
            for (int m = 0; m < 4; ++m) { const size_t row = row0 + ai * 128 + m * 16;
#pragma unroll
                for (int bj = 0; bj < 2; ++bj)
#pragma unroll
                    for (int n = 0; n < 2; ++n) { const float4 xb = xq[m][bj][n]; const f32x4 g = g4[bj][n], a = acc[ai][bj][m][n];
                        uint2 w; w.x = pg8::cvt_pk_bf16(xb.x + g[0] * a[0], xb.y + g[1] * a[1]); w.y = pg8::cvt_pk_bf16(xb.z + g[2] * a[2], xb.w + g[3] * a[3]);
                        *(uint2*)(X + row * DM + col0 + bj * 128 + n * 16) = w; } } }
    }
};
struct EpiStoreF32 {
    static constexpr bool PERM = false, AFTER_DRAIN = false, CARRY = false;
    float* C; int ldc;
    __device__ __forceinline__ void operator()(const pg8::f32x4 (&acc)[2][2][4][2], const pg8::Unit& u, int wr, int wc, int fr, int fq) const {
        const int row0 = u.pm * 256 + wr * 64 + fr, col0 = u.pn * 256 + wc * 32 + 4 * fq;
#pragma unroll
        for (int ai = 0; ai < 2; ++ai)
#pragma unroll
            for (int m = 0; m < 4; ++m) { const size_t row = row0 + ai * 128 + m * 16;
#pragma unroll
                for (int bj = 0; bj < 2; ++bj)
#pragma unroll
                    for (int n = 0; n < 2; ++n) *(pg8::f32x4*)(C + row * ldc + col0 + bj * 128 + n * 16) = acc[ai][bj][m][n]; }
    }
};

__device__ __forceinline__ int win_src_col(int n) {
    if (n >= 6144) return n + 6;
    if (n >= C_DQ && n < C_DV) { const int p = n & 63, base = n & ~63, j = p >> 3, m = p & 3, hi = (p >> 2) & 1; return base + (hi ? 32 : 0) + 4 * j + m; }
    return n;
}
__device__ __forceinline__ void transpose_item_win8(const float* W, signed char* WT, const unsigned* cmax, float* scr, int kb, int nb, int lane) {
    const int k0 = 64 * kb, n0 = 32 * nb; const int sc = win_src_col(n0 + (lane & 31)); const float q = 127.f / fmaxf(__uint_as_float(cmax[n0 + (lane & 31)]), 1e-30f);
#pragma unroll
    for (int i = 0; i < 32; ++i) { const int kk = 2 * i + (lane >> 5); scr[kk * 33 + (lane & 31)] = W[(size_t)(k0 + kk) * INW + sc] * q; }
    const int c = lane & 7;
#pragma unroll
    for (int j = 0; j < 4; ++j) { const int n = (lane >> 3) + 8 * j; const float* sp = scr + (8 * c) * 33 + n;
        uint2 o; o.x = pk_i8x4(sp[0 * 33], sp[1 * 33], sp[2 * 33], sp[3 * 33]); o.y = pk_i8x4(sp[4 * 33], sp[5 * 33], sp[6 * 33], sp[7 * 33]);
        *(uint2*)(WT + (size_t)(n0 + n) * DM + k0 + 8 * c) = o; }
}
struct EpiPeerHid {
    static constexpr bool PERM = true, AFTER_DRAIN = false;
    const unsigned char* Sm; const float* SH; const float* SU; float* HID;
    __device__ __forceinline__ void operator()(const pg8::i32x4 (&acc)[2][2][4][2], const pg8::Unit& u, int wr, int wc, int fr, int fq) const {
        using pg8::f32x4;
        const int row0 = u.pm * 256 + wr * 64 + fr, col0 = u.pn * 256 + wc * 32 + 8 * fq;
        f32x4 su[2][2];
#pragma unroll
        for (int bj = 0; bj < 2; ++bj) { su[bj][0] = *(const f32x4*)(SU + col0 + bj * 128); su[bj][1] = *(const f32x4*)(SU + col0 + bj * 128 + 4); }
        uint2 w[2][4][2]; float shr[2][4];
#pragma unroll
        for (int ai = 0; ai < 2; ++ai)
#pragma unroll
            for (int m = 0; m < 4; ++m) { const size_t row = row0 + ai * 128 + m * 16; shr[ai][m] = SH[row];
#pragma unroll
                for (int bj = 0; bj < 2; ++bj) w[ai][m][bj] = *(const uint2*)(Sm + (((size_t)u.pm * 64 + u.pn) * 256 + (row & 255)) * 256 + (col0 & 255) + bj * 128); }
#pragma unroll
        for (int ai = 0; ai < 2; ++ai)
#pragma unroll
            for (int m = 0; m < 4; ++m) { const size_t row = row0 + ai * 128 + m * 16;
#pragma unroll
                for (int bj = 0; bj < 2; ++bj) { const uint2 ww = w[ai][m][bj];
                    if ((ww.x | ww.y) != 0u) {
                        const pg8::i32x4 v0 = acc[ai][bj][m][0], v1 = acc[ai][bj][m][1];
                        const int hv[8] = {v0[0], v0[1], v0[2], v0[3], v1[0], v1[1], v1[2], v1[3]};
                        const float sc[8] = {su[bj][0][0], su[bj][0][1], su[bj][0][2], su[bj][0][3], su[bj][1][0], su[bj][1][1], su[bj][1][2], su[bj][1][3]};
#pragma unroll
                        for (int e = 0; e < 8; ++e) { const unsigned sb = ((e < 4 ? ww.x : ww.y) >> (8 * (e & 3))) & 0xffu;
                            if (sb != 0u) HID[row * PE_E + (sb - 1u)] = (float)hv[e] * shr[ai][m] * sc[e]; } } } }
    }
};
struct EpiStoreI8 {
    static constexpr bool PERM = false, AFTER_DRAIN = false;
    float* C; int ldc; const float* SH; const float* SC;
    __device__ __forceinline__ void operator()(const pg8::i32x4 (&acc)[2][2][4][2], const pg8::Unit& u, int wr, int wc, int fr, int fq) const {
        using pg8::f32x4;
        const int row0 = u.pm * 256 + wr * 64 + fr, col0 = u.pn * 256 + wc * 32 + 4 * fq;
        float sh[2][4]; f32x4 sc[2][2];
#pragma unroll
        for (int ai = 0; ai < 2; ++ai)
#pragma unroll
            for (int m = 0; m < 4; ++m) sh[ai][m] = SH[row0 + ai * 128 + m * 16];
#pragma unroll
        for (int bj = 0; bj < 2; ++bj)
#pragma unroll
            for (int n = 0; n < 2; ++n) sc[bj][n] = *(const f32x4*)(SC + col0 + bj * 128 + n * 16);
        asm volatile("" ::: "memory");
#pragma unroll
        for (int ai = 0; ai < 2; ++ai)
#pragma unroll
            for (int m = 0; m < 4; ++m) { const size_t row = row0 + ai * 128 + m * 16;
#pragma unroll
                for (int bj = 0; bj < 2; ++bj)
#pragma unroll
                    for (int n = 0; n < 2; ++n) { const int col = col0 + bj * 128 + n * 16; const pg8::i32x4 a = acc[ai][bj][m][n]; const f32x4 q = sc[bj][n] * sh[ai][m];
                        *(f32x4*)(C + row * ldc + col) = (f32x4){(float)a[0] * q[0], (float)a[1] * q[1], (float)a[2] * q[2], (float)a[3] * q[3]}; } }
    }
};
struct EpiResidI8 {
    static constexpr bool PERM = false, AFTER_DRAIN = false;
    bf16_t* X; const float* gt; const float* SA;
    __device__ __forceinline__ void operator()(const pg8::i32x4 (&acc)[2][2][4][2], const pg8::Unit& u, int wr, int wc, int fr, int fq) const {
        using pg8::f32x4;
        const int row0 = u.pm * 256 + wr * 64 + fr, col0 = u.pn * 256 + wc * 32 + 4 * fq; const float* gtb = gt + (size_t)((u.pm * 256) / SEQ) * NMOD;
        f32x4 g4[2][2];
#pragma unroll
        for (int bj = 0; bj < 2; ++bj)
#pragma unroll
            for (int n = 0; n < 2; ++n) g4[bj][n] = *(const f32x4*)(gtb + col0 + bj * 128 + n * 16);
#pragma unroll
        for (int ai = 0; ai < 2; ++ai) { uint2 xw[4][2][2]; float sa[4];
#pragma unroll
            for (int m = 0; m < 4; ++m) { const size_t row = row0 + ai * 128 + m * 16; sa[m] = SA[row];
#pragma unroll
                for (int bj = 0; bj < 2; ++bj)
#pragma unroll
                    for (int n = 0; n < 2; ++n) xw[m][bj][n] = *(const uint2*)(X + row * DM + col0 + bj * 128 + n * 16); }
            asm volatile("" ::: "memory");
#pragma unroll
            for (int m = 0; m < 4; ++m) { const size_t row = row0 + ai * 128 + m * 16;
#pragma unroll
                for (int bj = 0; bj < 2; ++bj)
#pragma unroll
                    for (int n = 0; n < 2; ++n) { const pg8::i32x4 a = acc[ai][bj][m][n]; const uint2 xq = xw[m][bj][n]; const f32x4 g = g4[bj][n]; const float s_ = sa[m];
                        uint2 w; w.x = pg8::cvt_pk_bf16(__uint_as_float(xq.x << 16) + g[0] * ((float)a[0] * s_), __uint_as_float(xq.x & 0xffff0000u) + g[1] * ((float)a[1] * s_));
                        w.y = pg8::cvt_pk_bf16(__uint_as_float(xq.y << 16) + g[2] * ((float)a[2] * s_), __uint_as_float(xq.y & 0xffff0000u) + g[3] * ((float)a[3] * s_));
                        *(uint2*)(X + row * DM + col0 + bj * 128 + n * 16) = w; } } }
    }
};

template <bool MAPW>
__device__ __forceinline__ void transpose_item(const float* W, int ldw, bf16_t* WT, int K, float* scr, int kb, int nb, int lane) {
    const int k0 = 64 * kb, n0 = 32 * nb; const int sc = MAPW ? win_src_col(n0 + (lane & 31)) : (n0 + (lane & 31));
#pragma unroll
    for (int i = 0; i < 32; ++i) { const int kk = 2 * i + (lane >> 5); scr[kk * 33 + (lane & 31)] = ldnt1(W + (size_t)(k0 + kk) * ldw + sc); }
    const int c = lane & 7;
#pragma unroll
    for (int j = 0; j < 4; ++j) { const int n = (lane >> 3) + 8 * j; const float* sp = scr + (8 * c) * 33 + n;
        pg8::u32x4 o; o.x = pg8::cvt_pk_bf16(sp[0 * 33], sp[1 * 33]); o.y = pg8::cvt_pk_bf16(sp[2 * 33], sp[3 * 33]); o.z = pg8::cvt_pk_bf16(sp[4 * 33], sp[5 * 33]); o.w = pg8::cvt_pk_bf16(sp[6 * 33], sp[7 * 33]);
        *(pg8::u32x4*)(WT + (size_t)(n0 + n) * K + k0 + 8 * c) = o; }
}

namespace att {
typedef short bf16x8 __attribute__((ext_vector_type(8)));
typedef short s16x4 __attribute__((ext_vector_type(4)));
typedef float f32x16 __attribute__((ext_vector_type(16)));
typedef float f32x4 __attribute__((ext_vector_type(4)));
typedef unsigned u32x4 __attribute__((ext_vector_type(4)));
constexpr int SHM_K = 16384, SHM_V = 16384;
constexpr int OFF_V = 0, OFF_K = 2 * SHM_V, OFF_CK = 2 * SHM_V + 2 * SHM_K, OFF_WS = OFF_CK + 512, OFF_Q = OFF_WS + 8 * 64 * 4, LDS_ATT = OFF_Q + 8 * 8 * 1024;
constexpr float LOG2E = 1.4426950408889634f;
#define KSWZ(row, colB) ((row) * 256 + ((colB) ^ (((row) & 7) << 4)))
#define SBAR() __builtin_amdgcn_sched_barrier(0)
__device__ __forceinline__ int v_st(int k, int c) { const int kk = (k & ~0xC) | ((k & 4) << 1) | ((k & 8) >> 1); return ((kk >> 3) * 4 + (c >> 5)) * 512 + ((kk & 7) * 32 + (c & 31)) * 2; }
__device__ __forceinline__ int v_rd_base(int lane) { return ((lane & 3) << 3) | (((lane >> 2) & 3) << 6) | (((lane >> 4) & 1) << 5) | (((lane >> 5) & 1) << 8); }
constexpr int v_rd_off(int d0, int ks, int half) { return d0 * 512 + ks * 4096 + half * 2048; }
__device__ __forceinline__ int crow(int r, int hi) { return (r & 3) + 8 * (r >> 2) + 4 * hi; }
__device__ __forceinline__ unsigned cvtpk(float lo, float hi) { unsigned r; asm volatile("v_cvt_pk_bf16_f32 %0, %1, %2" : "=v"(r) : "v"(lo), "v"(hi)); return r; }
__device__ __forceinline__ float psum2(float v) { auto rr = __builtin_amdgcn_permlane32_swap(__float_as_uint(v), __float_as_uint(v), false, false); return __uint_as_float(rr[0]) + __uint_as_float(rr[1]); }
__device__ __forceinline__ float pmax2(float v) { auto rr = __builtin_amdgcn_permlane32_swap(__float_as_uint(v), __float_as_uint(v), false, false); return fmaxf(__uint_as_float(rr[0]), __uint_as_float(rr[1])); }

template <int KB, int D0, int D1>
__device__ __forceinline__ void qkt(f32x16& p0, f32x16& p1, const char* K_lds, int r32, int hi, const char* qr) {
    p0 = f32x16{}; p1 = f32x16{};
    const char* kb[4];
#pragma unroll
    for (int dd = 0; dd < 4; ++dd) kb[dd] = K_lds + KB * SHM_K + KSWZ(r32, (dd * 16 + hi * 8) * 2);
#pragma unroll
    for (int d0 = D0; d0 < D1; ++d0) { const char* a = kb[d0 & 3] + (d0 >> 2) * 128;
        bf16x8 b0 = *reinterpret_cast<const bf16x8*>(a);
        bf16x8 b1 = *reinterpret_cast<const bf16x8*>(a + 32 * 256);
        const bf16x8 qf = *reinterpret_cast<const bf16x8*>(qr + d0 * 1024);
        p0 = __builtin_amdgcn_mfma_f32_32x32x16_bf16(b0, qf, p0, 0, 0, 0);
        p1 = __builtin_amdgcn_mfma_f32_32x32x16_bf16(b1, qf, p1, 0, 0, 0); }
}
template <int VB>
__device__ __forceinline__ void pv_tile(f32x16* o, int vb0, bf16x8 pa0, bf16x8 pa1, bf16x8 pa2, bf16x8 pa3) {
#define TRRD(dst, off) asm volatile("ds_read_b64_tr_b16 %0, %1 offset:%2" : "=&v"(dst) : "v"(vb0), "i"(off) : "memory")
#define PV_D0(d0) do { s16x4 l0, l1, l2, l3, h0, h1, h2, h3; constexpr int b_ = VB * SHM_V + v_rd_off(d0, 0, 0); \
        TRRD(l0, b_); TRRD(h0, b_ + 2048); TRRD(l1, b_ + 4096); TRRD(h1, b_ + 6144); TRRD(l2, b_ + 8192); TRRD(h2, b_ + 10240); TRRD(l3, b_ + 12288); TRRD(h3, b_ + 14336); \
        asm volatile("s_waitcnt lgkmcnt(0)" ::: "memory"); SBAR(); \
        o[d0] = __builtin_amdgcn_mfma_f32_32x32x16_bf16(pa0, (bf16x8){l0[0], l0[1], l0[2], l0[3], h0[0], h0[1], h0[2], h0[3]}, o[d0], 0, 0, 0); \
        o[d0] = __builtin_amdgcn_mfma_f32_32x32x16_bf16(pa1, (bf16x8){l1[0], l1[1], l1[2], l1[3], h1[0], h1[1], h1[2], h1[3]}, o[d0], 0, 0, 0); \
        o[d0] = __builtin_amdgcn_mfma_f32_32x32x16_bf16(pa2, (bf16x8){l2[0], l2[1], l2[2], l2[3], h2[0], h2[1], h2[2], h2[3]}, o[d0], 0, 0, 0); \
        o[d0] = __builtin_amdgcn_mfma_f32_32x32x16_bf16(pa3, (bf16x8){l3[0], l3[1], l3[2], l3[3], h3[0], h3[1], h3[2], h3[3]}, o[d0], 0, 0, 0); } while (0)
    PV_D0(0); PV_D0(1); PV_D0(2); PV_D0(3);
#undef PV_D0
#undef TRRD
}
__device__ __forceinline__ void pack_p(const f32x16& p0, const f32x16& p1, bf16x8& pa0, bf16x8& pa1, bf16x8& pa2, bf16x8& pa3) {
#define PK4(P, B_, OUT) do { unsigned a0 = cvtpk(P[B_+0], P[B_+1]), a1 = cvtpk(P[B_+2], P[B_+3]); \
        unsigned b0 = cvtpk(P[B_+4], P[B_+5]), b1 = cvtpk(P[B_+6], P[B_+7]); \
        auto r0 = __builtin_amdgcn_permlane32_swap(a0, b0, false, false); auto r1 = __builtin_amdgcn_permlane32_swap(a1, b1, false, false); \
        u32x4 w = {r0[0], r1[0], r0[1], r1[1]}; OUT = *reinterpret_cast<bf16x8*>(&w); } while (0)
    PK4(p0, 0, pa0); PK4(p0, 8, pa1); PK4(p1, 0, pa2); PK4(p1, 8, pa3);
#undef PK4
}
__device__ __forceinline__ void mask_tile(f32x16& p0, f32x16& p1, int dq) {
    const float NEG = -__builtin_inff();
#pragma unroll
    for (int r = 0; r < 16; ++r) { const int c = (r & 3) + 8 * (r >> 2); if (dq - c < 0) p0[r] = NEG; if (dq - c - 32 < 0) p1[r] = NEG; }
}
constexpr float THR2 = 11.5f;
__device__ __forceinline__ float softmax_step(f32x16& p0, f32x16& p1, float& m_reg, float& l_reg) {
    float pmax = p0[0];
#pragma unroll
    for (int r = 1; r < 16; ++r) pmax = fmaxf(pmax, p0[r]);
#pragma unroll
    for (int r = 0; r < 16; ++r) pmax = fmaxf(pmax, p1[r]);
    pmax = pmax2(pmax);
    float alpha = 1.f;
    if (!__all(pmax - m_reg <= THR2)) { const float mn = fmaxf(m_reg, pmax); alpha = __builtin_amdgcn_exp2f(m_reg - mn); m_reg = mn; }
    float ps = 0.f;
#pragma unroll
    for (int r = 0; r < 16; ++r) { p0[r] = __builtin_amdgcn_exp2f(p0[r] - m_reg); ps += p0[r]; }
#pragma unroll
    for (int r = 0; r < 16; ++r) { p1[r] = __builtin_amdgcn_exp2f(p1[r] - m_reg); ps += p1[r]; }
    l_reg = l_reg * alpha + psum2(ps);
    return alpha;
}
__device__ __forceinline__ void rescale_o(f32x16* o, float alpha, float* al_l, int r32, int hi) {
    if (__any(alpha < 1.f)) { if (hi == 0) al_l[r32] = alpha; asm volatile("s_waitcnt lgkmcnt(0)" ::: "memory");
#pragma unroll
        for (int r = 0; r < 16; ++r) { const float a = al_l[crow(r, hi)];
#pragma unroll
            for (int d = 0; d < 4; ++d) o[d][r] *= a; } }
}

template <int MODE, int KB>
__device__ __forceinline__ void tile_compute(const int t, const int q0, const int r32, const int hi, const char* K_lds, const int vb0, const float* ck_l, float* al_l, const char* qr,
                                             f32x16* o, f32x16* o2, float& m1, float& l1, float& m2, float& l2, float& carry, const float cq2) {
    constexpr float C2 = (MODE >= 2 ? 0.125f : 0.08838834764831845f) * LOG2E;
    const int dq = q0 + r32 - t * 64 - 4 * hi;
    bf16x8 pa0, pa1, pa2, pa3; f32x16 p0, p1;
    if constexpr (MODE == 0) {
        qkt<KB, 0, 8>(p0, p1, K_lds, r32, hi, qr);
        const float* ck = ck_l + KB * 64 + 4 * hi;
#pragma unroll
        for (int g = 0; g < 4; ++g) { const f32x4 c0 = *(const f32x4*)(ck + 8 * g), c1 = *(const f32x4*)(ck + 32 + 8 * g);
#pragma unroll
            for (int e = 0; e < 4; ++e) { p0[4 * g + e] = fmaf(p0[4 * g + e], C2, cq2 - c0[e]); p1[4 * g + e] = fmaf(p1[4 * g + e], C2, cq2 - c1[e]); } }
        if (t * 64 + 63 > q0) mask_tile(p0, p1, dq);
        const float alpha = softmax_step(p0, p1, m1, l1);
        pack_p(p0, p1, pa0, pa1, pa2, pa3);
        rescale_o(o, alpha, al_l, r32, hi);
        pv_tile<KB>(o, vb0, pa0, pa1, pa2, pa3);
    } else if constexpr (MODE == 1) {
        qkt<KB, 0, 8>(p0, p1, K_lds, r32, hi, qr);
        const bool nm = (t * 64 + 63 >= q0);
        f32x16 k0, k1; float gs[8];
#pragma unroll
        for (int r = 0; r < 16; ++r) { const int c = (r & 3) + 8 * (r >> 2);
            { const float z2 = p0[r] * C2, sp = fmaxf(z2, 0.f) + __builtin_amdgcn_logf(1.f + __builtin_amdgcn_exp2f(-fabsf(z2))); const bool valid = !nm || (dq - c - 1 >= 0);
              p0[r] = valid ? (z2 - sp) : -__builtin_inff(); k0[r] = valid ? -sp : 0.f; }
            { const float z2 = p1[r] * C2, sp = fmaxf(z2, 0.f) + __builtin_amdgcn_logf(1.f + __builtin_amdgcn_exp2f(-fabsf(z2))); const bool valid = !nm || (dq - c - 33 >= 0);
              p1[r] = valid ? (z2 - sp) : -__builtin_inff(); k1[r] = valid ? -sp : 0.f; } }
#pragma unroll
        for (int g = 0; g < 4; ++g) { gs[g] = (k0[4 * g] + k0[4 * g + 1]) + (k0[4 * g + 2] + k0[4 * g + 3]); gs[4 + g] = (k1[4 * g] + k1[4 * g + 1]) + (k1[4 * g + 2] + k1[4 * g + 3]); }
        float run = carry;
#pragma unroll
        for (int g = 7; g >= 0; --g) {
            const float tot = psum2(gs[g]); float base = run + (hi == 0 ? (tot - gs[g]) : 0.f);
#pragma unroll
            for (int e = 3; e >= 0; --e) { const int r = 4 * (g & 3) + e;
                if (g >= 4) { const float w = __builtin_amdgcn_exp2f(p1[r] + base); base += k1[r]; p1[r] = w; }
                else { const float w = __builtin_amdgcn_exp2f(p0[r] + base); base += k0[r]; p0[r] = w; } }
            run += tot; }
        carry = run;
        pack_p(p0, p1, pa0, pa1, pa2, pa3);
        pv_tile<KB>(o, vb0, pa0, pa1, pa2, pa3);
    } else {
        qkt<KB, (MODE == 2 ? 0 : 4), (MODE == 2 ? 4 : 8)>(p0, p1, K_lds, r32, hi, qr);
#pragma unroll
        for (int r = 0; r < 16; ++r) { p0[r] *= C2; p1[r] *= C2; }
        const float a1 = softmax_step(p0, p1, m1, l1);
        pack_p(p0, p1, pa0, pa1, pa2, pa3);
        rescale_o(o, a1, al_l, r32, hi);
        pv_tile<KB>(o, vb0, pa0, pa1, pa2, pa3);
    }
}

template <int MODE>
__device__ __forceinline__ void attn_unit(const int tid, char* lds, const bf16_t* ATT, const float* CUM2, bf16_t* OB, float* ODF, int b, int h, int qb, const unsigned* KINF, unsigned char* Gz, const unsigned rank) {
    const int wid = __builtin_amdgcn_readfirstlane(tid >> 6), lane = tid & 63, r32 = lane & 31, hi = lane >> 5;
    const int qc = (MODE == 0 ? C_FQ : MODE == 1 ? C_SQ : C_DQ) + h * 128, kc = (MODE == 0 ? C_FK : MODE == 1 ? C_SK : C_DK) + h * 128, vc = (MODE == 0 ? C_FV : MODE == 1 ? C_SV : C_DV) + h * 128;
    const int oc = (MODE == 0 ? 0 : MODE == 1 ? 768 : 1536) + h * 128;
    const size_t rowb = (size_t)b * SEQ;
    const int q0 = qb * 256 + wid * 32;
    const int NT = 4 * qb + 4;
    char* V_lds = lds + OFF_V; char* K_lds = lds + OFF_K; float* ck_l = (float*)(lds + OFF_CK); float* wsl = (float*)(lds + OFF_WS) + wid * 64; float* li_l = wsl; float* al_l = wsl + 32;
    const int vb0 = (int)(uintptr_t)V_lds + v_rd_base(lane);
    int koff, voff;
    { const int row = tid >> 4, cb = (tid & 15) ^ (row & 7); koff = row * 6144 + cb * 8;
      const int sub = tid >> 5, w = tid & 31, kk = (sub >> 2) * 8 + (w >> 2), k = (kk & ~0xC) | ((kk & 4) << 1) | ((kk & 8) >> 1); voff = k * 6144 + (sub & 3) * 32 + (w & 3) * 8; }
    const bf16_t* Kg = ATT + rowb * 6144 + kc; const bf16_t* Vg = ATT + rowb * 6144 + vc;
    const float* cumh = CUM2 + (size_t)(b * 6 + h) * SEQ;
    LAS char* ldsl = (LAS char*)lds;
    char* qr = lds + OFF_Q + wid * 8192 + lane * 16;
    float qa = 0.f;
#pragma unroll
    for (int d0 = 0; d0 < 8; ++d0) { const bf16x8 f = *(const bf16x8*)(ATT + (rowb + q0 + r32) * 6144 + qc + d0 * 16 + hi * 8); *(bf16x8*)(qr + d0 * 1024) = f;
        if (MODE == 0) {
#pragma unroll
            for (int e = 0; e < 8; ++e) qa += fabsf(__uint_as_float(((unsigned)(unsigned short)f[e]) << 16)); } }
    f32x16 o[4] = {}; f32x16 o2[1] = {};
    float m1 = -1e30f, l1 = 0.f, m2 = -1e30f, l2 = 0.f, carry = 0.f, cq2 = 0.f;
    if (MODE == 0) cq2 = cumh[q0 + r32];
    float ub = 0.f; bool deadw = false;
    if (MODE == 0) ub = psum2(qa) * (__uint_as_float(KINF[b * 8 + h]) * 1.01f) * (0.08838834764831845f * LOG2E) + 1.f;
#define TILE(i) ((MODE <= 1) ? (NT - 1 - (i)) : (i))
#define STAGE(t, bf) do { const bf16_t* kp_ = Kg + (size_t)(t) * (64 * 6144) + koff; const bf16_t* vp_ = Vg + (size_t)(t) * (64 * 6144) + voff; \
        __builtin_amdgcn_global_load_lds((const unsigned*)kp_, (LAS unsigned*)(ldsl + OFF_K + (bf) * SHM_K + wid * 1024), 16, 0, 0); \
        __builtin_amdgcn_global_load_lds((const unsigned*)(kp_ + 32 * 6144), (LAS unsigned*)(ldsl + OFF_K + (bf) * SHM_K + 8192 + wid * 1024), 16, 0, 0); \
        __builtin_amdgcn_global_load_lds((const unsigned*)vp_, (LAS unsigned*)(ldsl + OFF_V + (bf) * SHM_V + wid * 1024), 16, 0, 0); \
        __builtin_amdgcn_global_load_lds((const unsigned*)(vp_ + 32 * 6144), (LAS unsigned*)(ldsl + OFF_V + (bf) * SHM_V + 8192 + wid * 1024), 16, 0, 0); \
        if (MODE == 0 && wid == 0) __builtin_amdgcn_global_load_lds((const unsigned*)(cumh + (t) * 64 + lane), (LAS unsigned*)(ldsl + OFF_CK + (bf) * 256), 4, 0, 0); } while (0)
#define ACTIVE(t) ((MODE == 0) ? ((t) * 64 <= q0 + 31) : (MODE == 1) ? ((t) * 64 < q0 + 31) : ((t) * 64 <= q0))
    volatile int* dn_l = (volatile int*)(lds + (MODE == 1 ? OFF_CK : OFF_WS));
    bool stop = false;
    unsigned zz_ = 0u; asm volatile("" : "+v"(zz_)); const u32x4 zv_ = {zz_, zz_, zz_, zz_}; int zk_ = 0;
#define ZST(k) do { const unsigned o_ = (unsigned)(k) * 512u + (unsigned)tid; const size_t g_ = (size_t)rank * 13108u + o_; if (o_ < 13108u && g_ < (size_t)(NB * SEQ) * 1024u) ((u32x4*)Gz)[g_] = zv_; } while (0)
#define BODY(i, KB) do { const int t_ = TILE(i); \
        if (zk_ < 26) { ZST(zk_); ZST(zk_ + 1); zk_ += 2; } \
        if ((i) + 1 < NT) STAGE(TILE((i) + 1), (KB) ^ 1); \
        const bool dead_ = (MODE == 1) ? __all(carry < -130.f) : deadw; \
        if (ACTIVE(t_) && !dead_) { tile_compute<MODE, KB>(t_, q0, r32, hi, K_lds, vb0, ck_l, al_l, qr, o, o2, m1, l1, m2, l2, carry, cq2); \
            if (MODE == 0) deadw = __all(ub + cq2 - ck_l[(KB) * 64] - m1 < -130.f); } \
        if (MODE <= 1 && lane == 0) dn_l[(KB) * 8 + wid] = ((MODE == 0 ? deadw : dead_) || t_ == 0) ? 1 : 0;     \
        asm volatile("s_waitcnt vmcnt(0) lgkmcnt(0)" ::: "memory"); __syncthreads(); \
        if (MODE <= 1) { int a_ = 1; _Pragma("unroll") for (int w_ = 0; w_ < 8; ++w_) a_ &= dn_l[(KB) * 8 + w_]; stop = (a_ != 0); } } while (0)
    STAGE(TILE(0), 0); asm volatile("s_waitcnt vmcnt(0)" ::: "memory"); __syncthreads();
    for (int i = 0; i < NT; i += 2) { BODY(i, 0); if (MODE <= 1 && stop) break; BODY(i + 1, 1); if (MODE <= 1 && stop) break; }
    if (MODE <= 1) __syncthreads();
    for (; zk_ < 26; ++zk_) ZST(zk_);
    if (MODE != 1) { if (hi == 0) li_l[r32] = 1.f / l1; }
    asm volatile("s_waitcnt lgkmcnt(0)" ::: "memory");
    if (MODE != 1) {
#pragma unroll
        for (int r = 0; r < 16; ++r) { const float f1 = li_l[crow(r, hi)];
#pragma unroll
            for (int d = 0; d < 4; ++d) o[d][r] *= f1; }
    }
    if (MODE >= 2) {
        float* Ow = ODF + ((size_t)(MODE - 2) * (NB * SEQ) + rowb + q0) * 512 + h * 128;
#pragma unroll
        for (int r = 0; r < 16; ++r) { const int orow = crow(r, hi);
#pragma unroll
            for (int d = 0; d < 4; ++d) Ow[(size_t)orow * 512 + d * 32 + r32] = o[d][r]; }
    } else {
        bf16_t* Ow = OB + (rowb + q0) * DM + oc;
#pragma unroll
        for (int r = 0; r < 16; ++r) { const int orow = crow(r, hi);
#pragma unroll
            for (int d = 0; d < 4; ++d) { const float v = o[d][r]; const float vn = __shfl_xor(v, 1);
                if ((r32 & 1) == 0) *(unsigned*)(Ow + (size_t)orow * DM + d * 32 + r32) = cvtpk(v, vn); } }
    }
    __syncthreads();
#undef TILE
#undef STAGE
#undef ACTIVE
#undef BODY
#undef ZST
}
#undef KSWZ
#undef SBAR
}

namespace topk {
using att::f32x16; using att::bf16x8;
constexpr int CA[64] = {0, 0, 0, 0, 0, 0, 0, 0, 0, 0, 0, 0, 0, 0, 0, 0, 1, 1, 1, 1, 1, 1, 1, 1, 2, -1, -1, -1, -1, -1, -1, -1, 2, 2, 2, 2, 3, 3, 3, 3, 4, 4, 4, 5, 5, 6, 6, 7, 7, 8, 9, 10, 11, 12, 13, 14, 15, -1, -1, -1, -1, -1, -1, -1};
constexpr int CB[64] = {0, 1, 2, 3, 4, 5, 6, 7, 8, 9, 10, 11, 12, 13, 14, 15, 0, 1, 2, 3, 4, 5, 6, 7, 0, -1, -1, -1, -1, -1, -1, -1, 1, 2, 3, 4, 0, 1, 2, 3, 0, 1, 2, 0, 1, 0, 1, 0, 1, 0, 0, 0, 0, 0, 0, 0, 0, -1, -1, -1, -1, -1, -1, -1};
__device__ __forceinline__ unsigned mono(float f) { const unsigned u = __float_as_uint(f); return u ^ ((unsigned)((int)u >> 31) | 0x80000000u); }
__device__ __forceinline__ float unmono(unsigned k) { return __uint_as_float((k & 0x80000000u) ? (k ^ 0x80000000u) : ~k); }
__device__ __forceinline__ unsigned umax_(unsigned a, unsigned b) { return a > b ? a : b; }
__device__ __forceinline__ unsigned umin_(unsigned a, unsigned b) { return a < b ? a : b; }
__device__ __forceinline__ unsigned partner_u(unsigned v, int hi) { auto rr = __builtin_amdgcn_permlane32_swap(v, v, false, false); return hi ? rr[0] : rr[1]; }

template <int N> __device__ __forceinline__ void sort_blocks16(unsigned (&x)[N]) {
#pragma unroll
    for (int k = 2; k <= 16; k <<= 1)
#pragma unroll
        for (int j = k >> 1; j > 0; j >>= 1)
#pragma unroll
            for (int i = 0; i < N; ++i) { const int l = i ^ j; if (l > i) { const bool desc = ((i & k) == 0); const unsigned a = x[i], b = x[l], mx = umax_(a, b), mn = umin_(a, b); x[i] = desc ? mx : mn; x[l] = desc ? mn : mx; } }
}
template <bool DESC> __device__ __forceinline__ void merge16(unsigned (&x)[16]) {
#pragma unroll
    for (int j = 8; j > 0; j >>= 1)
#pragma unroll
        for (int i = 0; i < 16; ++i) { const int l = i ^ j; if (l > i) { const unsigned a = x[i], b = x[l], mx = umax_(a, b), mn = umin_(a, b); x[i] = DESC ? mx : mn; x[l] = DESC ? mn : mx; } }
}
__device__ __forceinline__ void top16_of_pair(unsigned (&x)[64], unsigned (&w)[16], int hi) {
    sort_blocks16<64>(x);
    unsigned y[16], z[16];
#pragma unroll
    for (int i = 0; i < 16; ++i) { y[i] = umax_(x[i], x[16 + i]); z[i] = umax_(x[32 + i], x[48 + i]); }
    merge16<true>(y); merge16<false>(z);
#pragma unroll
    for (int i = 0; i < 16; ++i) w[i] = umax_(y[i], z[i]);
    merge16<true>(w);
    unsigned pr[16];
#pragma unroll
    for (int i = 0; i < 16; ++i) pr[i] = partner_u(w[i], hi);
#pragma unroll
    for (int i = 0; i < 16; ++i) w[i] = umax_(w[i], pr[15 - i]);
    merge16<true>(w);
}
__device__ __forceinline__ void ce2(float& va, unsigned& pa, float& vb, unsigned& pb, bool desc) {
    const bool sw = desc ? (vb > va) : (va > vb); const float tv = sw ? vb : va, uv = sw ? va : vb; const unsigned tp = sw ? pb : pa, up = sw ? pa : pb; va = tv; pa = tp; vb = uv; pb = up;
}
__device__ __forceinline__ void merge16v(float (&v)[16], unsigned (&p)[16]) {
#pragma unroll
    for (int j = 8; j > 0; j >>= 1)
#pragma unroll
        for (int i = 0; i < 16; ++i) { const int l = i ^ j; if (l > i) ce2(v[i], p[i], v[l], p[l], true); }
}

__device__ __forceinline__ void scores_half(f32x16& pA, f32x16& pB, f32x16& pC, f32x16& pD, const char* imgs, int r32, int hi, const float* qrow) {
    pA = f32x16{}; pB = f32x16{}; pC = f32x16{}; pD = f32x16{};
    int kb[4];
#pragma unroll
    for (int dd = 0; dd < 4; ++dd) kb[dd] = r32 * 256 + (((dd * 16 + hi * 8) * 2) ^ ((r32 & 7) << 4));
    att::f32x4 qa[4], qb[4];
#pragma unroll
    for (int d0 = 0; d0 < 4; ++d0) { qa[d0] = *(const att::f32x4*)(qrow + d0 * 16 + hi * 8); qb[d0] = *(const att::f32x4*)(qrow + d0 * 16 + hi * 8 + 4); }
#pragma unroll
    for (int d0 = 0; d0 < 8; ++d0) { const int a = kb[d0 & 3] + (d0 >> 2) * 128;
        const att::f32x4 fa = d0 < 4 ? qa[d0 & 3] : *(const att::f32x4*)(qrow + d0 * 16 + hi * 8), fb = d0 < 4 ? qb[d0 & 3] : *(const att::f32x4*)(qrow + d0 * 16 + hi * 8 + 4);
        const float f[8] = {fa[0], fa[1], fa[2], fa[3], fb[0], fb[1], fb[2], fb[3]}; unsigned hw[4], lw[4];
#pragma unroll
        for (int e = 0; e < 4; ++e) { const unsigned h2 = att::cvtpk(f[2 * e], f[2 * e + 1]); hw[e] = h2;
            lw[e] = att::cvtpk(f[2 * e] - __uint_as_float(h2 << 16), f[2 * e + 1] - __uint_as_float(h2 & 0xffff0000u)); }
        att::u32x4 hv = {hw[0], hw[1], hw[2], hw[3]}, lv = {lw[0], lw[1], lw[2], lw[3]}; const bf16x8 qh = *reinterpret_cast<bf16x8*>(&hv), ql = *reinterpret_cast<bf16x8*>(&lv);
#pragma unroll
        for (int tl = 0; tl < 2; ++tl) { const char* img_hi = imgs + tl * 32768; const char* img_lo = img_hi + 16384;
            const bf16x8 h0 = *reinterpret_cast<const bf16x8*>(img_hi + a), h1 = *reinterpret_cast<const bf16x8*>(img_hi + a + 32 * 256);
            const bf16x8 l0 = *reinterpret_cast<const bf16x8*>(img_lo + a), l1 = *reinterpret_cast<const bf16x8*>(img_lo + a + 32 * 256);
            f32x16& q0 = tl ? pC : pA; f32x16& q1 = tl ? pD : pB;
            q0 = __builtin_amdgcn_mfma_f32_32x32x16_bf16(h0, qh, q0, 0, 0, 0); q1 = __builtin_amdgcn_mfma_f32_32x32x16_bf16(h1, qh, q1, 0, 0, 0);
            q0 = __builtin_amdgcn_mfma_f32_32x32x16_bf16(l0, qh, q0, 0, 0, 0); q1 = __builtin_amdgcn_mfma_f32_32x32x16_bf16(l1, qh, q1, 0, 0, 0);
            q0 = __builtin_amdgcn_mfma_f32_32x32x16_bf16(h0, ql, q0, 0, 0, 0); q1 = __builtin_amdgcn_mfma_f32_32x32x16_bf16(h1, ql, q1, 0, 0, 0); } }
}
__device__ __forceinline__ void half_top16(const float* qrow, const char* imgs  , int r32, int hi, unsigned (&w)[16]) {
    unsigned x[64]; const unsigned ib = 127u - 4u * (unsigned)hi;
    { f32x16 pA, pB, pC, pD; scores_half(pA, pB, pC, pD, imgs, r32, hi, qrow);
#pragma unroll
      for (int r = 0; r < 16; ++r) { const unsigned c = (unsigned)((r & 3) + 8 * (r >> 2));
          x[r] = (mono(pA[r]) & ~127u) | (ib - c); x[16 + r] = (mono(pB[r]) & ~127u) | (ib - c - 32u);
          x[32 + r] = (mono(pC[r]) & ~127u) | (ib - c - 64u); x[48 + r] = (mono(pD[r]) & ~127u) | (ib - c - 96u); } }
    top16_of_pair(x, w, hi);
}
__device__ __forceinline__ void combine_top16(const unsigned (&w1)[16], const unsigned (&w2)[16], int hi, float (&bv)[16], unsigned (&bp)[16]) {
    float s1[16], s2[16]; unsigned i1[16], i2[16];
#pragma unroll
    for (int i = 0; i < 16; ++i) { s1[i] = unmono(w1[i] & ~127u); s2[i] = unmono(w2[i] & ~127u); i1[i] = 127u - (w1[i] & 127u); i2[i] = 127u - (w2[i] & 127u); }
    float v[32]; unsigned p[32];
#pragma unroll
    for (int k = 0; k < 32; ++k) {
        float v0 = -__builtin_inff(), v1 = -__builtin_inff(); unsigned q0 = 0u, q1 = 0u;
        if (CA[k] >= 0) { v0 = s1[CA[k] < 0 ? 0 : CA[k]] + s2[CB[k] < 0 ? 0 : CB[k]]; q0 = (i1[CA[k] < 0 ? 0 : CA[k]] << 7) | i2[CB[k] < 0 ? 0 : CB[k]]; }
        if (CA[32 + k] >= 0) { v1 = s1[CA[32 + k] < 0 ? 0 : CA[32 + k]] + s2[CB[32 + k] < 0 ? 0 : CB[32 + k]]; q1 = (i1[CA[32 + k] < 0 ? 0 : CA[32 + k]] << 7) | i2[CB[32 + k] < 0 ? 0 : CB[32 + k]]; }
        v[k] = hi ? v1 : v0; p[k] = hi ? q1 : q0; }
#pragma unroll
    for (int kk = 2; kk <= 16; kk <<= 1)
#pragma unroll
        for (int j = kk >> 1; j > 0; j >>= 1)
#pragma unroll
            for (int i = 0; i < 32; ++i) { const int l = i ^ j; if (l > i) ce2(v[i], p[i], v[l], p[l], (i & kk) == 0); }
#pragma unroll
    for (int i = 0; i < 16; ++i) { const bool t = v[16 + i] > v[i]; bv[i] = t ? v[16 + i] : v[i]; bp[i] = t ? p[16 + i] : p[i]; }
    merge16v(bv, bp);
    float pv[16]; unsigned pp[16];
#pragma unroll
    for (int i = 0; i < 16; ++i) { pv[i] = __uint_as_float(partner_u(__float_as_uint(bv[i]), hi)); pp[i] = partner_u(bp[i], hi); }
#pragma unroll
    for (int i = 0; i < 16; ++i) { const bool t = pv[15 - i] > bv[i]; bv[i] = t ? pv[15 - i] : bv[i]; bp[i] = t ? pp[15 - i] : bp[i]; }
    merge16v(bv, bp);
}
}

static __device__ const unsigned short ATT_UNITS[640] = {8207, 8223, 8239, 8255, 10255, 10271, 10287, 10303, 12303, 12319, 12335, 12351, 14351, 14367, 14383, 14399, 8206, 8222, 8238, 8254, 10254, 10270, 10286, 10302, 12302, 12318, 12334, 12350, 14350, 14366, 14382, 14398, 8205, 8221, 8237, 8253, 10253, 10269, 10285, 10301, 12301, 12317, 12333, 12349, 14349, 14365, 14381, 14397, 8204, 8220, 8236, 8252, 10252, 10268, 10284, 10300, 12300, 12316, 12332, 12348, 14348, 14364, 14380, 14396, 8203, 8219, 8235, 8251, 10251, 10267, 10283, 10299, 12299, 12315, 12331, 12347, 14347, 14363, 14379, 14395, 8202, 8218, 8234, 8250, 10250, 10266, 10282, 10298, 12298, 12314, 12330, 12346, 14346, 14362, 14378, 14394, 8201, 8217, 8233, 8249, 10249, 10265, 10281, 10297, 12297, 12313, 12329, 12345, 14345, 14361, 14377, 14393, 8200, 8216, 8232, 8248, 10248, 10264, 10280, 10296, 12296, 12312, 12328, 12344, 14344, 14360, 14376, 14392, 8199, 8215, 8231, 8247, 10247, 10263, 10279, 10295, 12295, 12311, 12327, 12343, 14343, 14359, 14375, 14391, 8198, 8214, 8230, 8246, 10246, 10262, 10278, 10294, 12294, 12310, 12326, 12342, 14342, 14358, 14374, 14390, 4, 20, 36, 52, 68, 84, 2052, 2068, 2084, 2100, 2116, 2132, 5, 21, 37, 53, 69, 85, 2053, 2069, 2085, 2101, 2117, 2133, 6, 22, 38, 54, 70, 86, 2054, 2070, 2086, 2102, 2118, 2134, 7, 23, 39, 55, 71, 87, 2055, 2071, 2087, 2103, 2119, 2135, 8, 24, 40, 56, 72, 88, 2056, 2072, 2088, 2104, 2120, 2136, 9, 25, 41, 57, 73, 89, 2057, 2073, 2089, 2105, 2121, 2137, 10, 26, 42, 58, 74, 90, 2058, 2074, 2090, 2106, 2122, 2138, 11, 27, 43, 59, 75, 91, 2059, 2075, 2091, 2107, 2123, 2139, 12, 28, 44, 60, 76, 92, 2060, 2076, 2092, 2108, 2124, 2140, 13, 29, 45, 61, 77, 93, 2061, 2077, 2093, 2109, 2125, 2141, 14, 30, 46, 62, 78, 94, 2062, 2078, 2094, 2110, 2126, 2142, 15, 31, 47, 63, 79, 95, 2063, 2079, 2095, 2111, 2127, 2143, 8197, 8213, 8229, 8245, 10245, 10261, 10277, 10293, 12293, 12309, 12325, 12341, 14341, 14357, 14373, 14389, 3, 19, 35, 51, 67, 83, 2051, 2067, 2083, 2099, 2115, 2131, 8196, 8212, 8228, 8244, 10244, 10260, 10276, 10292, 12292, 12308, 12324, 12340, 14340, 14356, 14372, 14388, 8195, 8211, 8227, 8243, 10243, 10259, 10275, 10291, 12291, 12307, 12323, 12339, 14339, 14355, 14371, 14387, 2, 18, 34, 50, 66, 82, 2050, 2066, 2082, 2098, 2114, 2130, 8194, 8210, 8226, 8242, 10242, 10258, 10274, 10290, 12290, 12306, 12322, 12338, 14338, 14354, 14370, 14386, 4097, 4113, 4129, 4145, 4161, 4177, 6145, 6161, 6177, 6193, 6209, 6225, 4098, 4114, 4130, 4146, 4162, 4178, 6146, 6162, 6178, 6194, 6210, 6226, 4099, 4115, 4131, 4147, 4163, 4179, 6147, 6163, 6179, 6195, 6211, 6227, 4100, 4116, 4132, 4148, 4164, 4180, 6148, 6164, 6180, 6196, 6212, 6228, 4101, 4117, 4133, 4149, 4165, 4181, 6149, 6165, 6181, 6197, 6213, 6229, 4102, 4118, 4134, 4150, 4166, 4182, 6150, 6166, 6182, 6198, 6214, 6230, 4103, 4119, 4135, 4151, 4167, 4183, 6151, 6167, 6183, 6199, 6215, 6231, 4104, 4120, 4136, 4152, 4168, 4184, 6152, 6168, 6184, 6200, 6216, 6232, 4105, 4121, 4137, 4153, 4169, 4185, 6153, 6169, 6185, 6201, 6217, 6233, 4106, 4122, 4138, 4154, 4170, 4186, 6154, 6170, 6186, 6202, 6218, 6234, 4107, 4123, 4139, 4155, 4171, 4187, 6155, 6171, 6187, 6203, 6219, 6235, 4108, 4124, 4140, 4156, 4172, 4188, 6156, 6172, 6188, 6204, 6220, 6236, 4109, 4125, 4141, 4157, 4173, 4189, 6157, 6173, 6189, 6205, 6221, 6237, 4110, 4126, 4142, 4158, 4174, 4190, 6158, 6174, 6190, 6206, 6222, 6238, 4111, 4127, 4143, 4159, 4175, 4191, 6159, 6175, 6191, 6207, 6223, 6239, 1, 17, 33, 49, 65, 81, 2049, 2065, 2081, 2097, 2113, 2129, 8193, 8209, 8225, 8241, 10241, 10257, 10273, 10289, 12289, 12305, 12321, 12337, 14337, 14353, 14369, 14385, 4096, 4112, 4128, 4144, 4160, 4176, 6144, 6160, 6176, 6192, 6208, 6224, 0, 16, 32, 48, 64, 80, 2048, 2064, 2080, 2096, 2112, 2128, 8192, 8208, 8224, 8240, 10240, 10256, 10272, 10288, 12288, 12304, 12320, 12336, 14336, 14352, 14368, 14384};
constexpr int N_ATT_ITEMS0 = 1920;
static __device__ const unsigned short ATT_ITEMS0[N_ATT_ITEMS0] = {8207, 8223, 8239, 8255, 10255, 10271, 10287, 10303, 12303, 12319, 12335, 12351, 14351, 14367, 14383, 14399, 8206, 8222, 8238, 8254, 10254, 10270, 10286, 10302, 12302, 12318, 12334, 12350, 14350, 14366, 14382, 14398, 8205, 8221, 8237, 8253, 10253, 10269, 10285, 10301, 12301, 12317, 12333, 12349, 14349, 14365, 14381, 14397, 8204, 8220, 8236, 8252, 10252, 10268, 10284, 10300, 12300, 12316, 12332, 12348, 14348, 14364, 14380, 14396, 8203, 8219, 8235, 8251, 10251, 10267, 10283, 10299, 12299, 12315, 12331, 12347, 14347, 14363, 14379, 14395, 8202, 8218, 8234, 8250, 10250, 10266, 10282, 10298, 12298, 12314, 12330, 12346, 14346, 14362, 14378, 14394, 8201, 8217, 8233, 8249, 10249, 10265, 10281, 10297, 12297, 12313, 12329, 12345, 14345, 14361, 14377, 14393, 8200, 8216, 8232, 8248, 10248, 10264, 10280, 10296, 12296, 12312, 12328, 12344, 14344, 14360, 14376, 14392, 8199, 8215, 8231, 8247, 10247, 10263, 10279, 10295, 12295, 12311, 12327, 12343, 14343, 14359, 14375, 14391, 8198, 8214, 8230, 8246, 10246, 10262, 10278, 10294, 12294, 12310, 12326, 12342, 14342, 14358, 14374, 14390, 4, 20, 36, 52, 68, 84, 2052, 2068, 2084, 2100, 2116, 2132, 5, 21, 37, 53, 69, 85, 2053, 2069, 2085, 2101, 2117, 2133, 6, 22, 38, 54, 70, 86, 2054, 2070, 2086, 2102, 2118, 2134, 7, 23, 39, 55, 71, 87, 2055, 2071, 2087, 2103, 2119, 2135, 8, 24, 40, 56, 72, 88, 2056, 2072, 2088, 2104, 2120, 2136, 9, 25, 41, 57, 73, 89, 2057, 2073, 2089, 2105, 2121, 2137, 10, 26, 42, 58, 74, 90, 2058, 2074, 2090, 2106, 2122, 2138, 11, 27, 43, 59, 75, 91, 2059, 2075, 2091, 2107, 2123, 2139, 45056, 45057, 45058, 45059, 45060, 45061, 45062, 45063, 45064, 45065, 45066, 45067, 45068, 45069, 45070, 45071, 45072, 45073, 45074, 45075, 45076, 45077, 45078, 45079, 45080, 45081, 45082, 45083, 45084, 45085, 45086, 45087, 45088, 45089, 45090, 45091, 45092, 45093, 45094, 45095, 45096, 45097, 45098, 45099, 45100, 45101, 45102, 45103, 45104, 45105, 45106, 45107, 45108, 45109, 45110, 45111, 45112, 45113, 45114, 45115, 45116, 45117, 45118, 45119, 45120, 45121, 45122, 45123, 45124, 45125, 45126, 45127, 45128, 45129, 45130, 45131, 45132, 45133, 45134, 45135, 45136, 45137, 45138, 45139, 45140, 45141, 45142, 45143, 45144, 45145, 45146, 45147, 45148, 45149, 45150, 45151, 45152, 45153, 45154, 45155, 45156, 45157, 45158, 45159, 45160, 45161, 45162, 45163, 45164, 45165, 45166, 45167, 45168, 45169, 45170, 45171, 45172, 45173, 45174, 45175, 45176, 45177, 45178, 45179, 45180, 45181, 45182, 45183, 12, 28, 44, 60, 76, 92, 2060, 2076, 2092, 2108, 2124, 2140, 13, 29, 45, 61, 77, 93, 2061, 2077, 2093, 2109, 2125, 2141, 14, 30, 46, 62, 78, 94, 2062, 2078, 2094, 2110, 2126, 2142, 15, 31, 47, 63, 79, 95, 2063, 2079, 2095, 2111, 2127, 2143, 8197, 8213, 8229, 8245, 10245, 10261, 10277, 10293, 12293, 12309, 12325, 12341, 14341, 14357, 14373, 14389, 3, 19, 35, 51, 67, 83, 2051, 2067, 2083, 2099, 2115, 2131, 8196, 8212, 8228, 8244, 10244, 10260, 10276, 10292, 12292, 12308, 12324, 12340, 14340, 14356, 14372, 14388, 8195, 8211, 8227, 8243, 10243, 10259, 10275, 10291, 12291, 12307, 12323, 12339, 14339, 14355, 14371, 14387, 2, 18, 34, 50, 66, 82, 2050, 2066, 2082, 2098, 2114, 2130, 8194, 8210, 8226, 8242, 10242, 10258, 10274, 10290, 12290, 12306, 12322, 12338, 14338, 14354, 14370, 14386, 4097, 4113, 4129, 4145, 4161, 4177, 6145, 6161, 6177, 6193, 6209, 6225, 4098, 4114, 4130, 4146, 4162, 4178, 6146, 6162, 6178, 6194, 6210, 6226, 4099, 4115, 4131, 4147, 4163, 4179, 6147, 6163, 6179, 6195, 6211, 6227, 4100, 4116, 4132, 4148, 4164, 4180, 6148, 6164, 6180, 6196, 6212, 6228, 4101, 4117, 4133, 4149, 4165, 4181, 6149, 6165, 6181, 6197, 6213, 6229, 4102, 4118, 4134, 4150, 4166, 4182, 6150, 6166, 6182, 6198, 6214, 6230, 4103, 4119, 4135, 4151, 4167, 4183, 6151, 6167, 6183, 6199, 6215, 6231, 4104, 4120, 4136, 4152, 4168, 4184, 6152, 6168, 6184, 6200, 6216, 6232, 4105, 4121, 4137, 4153, 4169, 4185, 6153, 6169, 6185, 6201, 6217, 6233, 4106, 4122, 4138, 4154, 4170, 4186, 6154, 6170, 6186, 6202, 6218, 6234, 4107, 4123, 4139, 4155, 4171, 4187, 6155, 6171, 6187, 6203, 6219, 6235, 4108, 4124, 4140, 4156, 4172, 4188, 6156, 6172, 6188, 6204, 6220, 6236, 4109, 4125, 4141, 4157, 4173, 4189, 6157, 6173, 6189, 6205, 6221, 6237, 4110, 4126, 4142, 4158, 4174, 4190, 6158, 6174, 6190, 6206, 6222, 6238, 4111, 4127, 4143, 4159, 4175, 4191, 6159, 6175, 6191, 6207, 6223, 6239, 49152, 49153, 49154, 49155, 49156, 49157, 49158, 49159, 49160, 49161, 49162, 49163, 49164, 49165, 49166, 49167, 49168, 49169, 49170, 49171, 49172, 49173, 49174, 49175, 49176, 49177, 49178, 49179, 49180, 49181, 49182, 49183, 49184, 49185, 49186, 49187, 49188, 49189, 49190, 49191, 49192, 49193, 49194, 49195, 49196, 49197, 49198, 49199, 49200, 49201, 49202, 49203, 49204, 49205, 49206, 49207, 49208, 49209, 49210, 49211, 49212, 49213, 49214, 49215, 49216, 49217, 49218, 49219, 49220, 49221, 49222, 49223, 49224, 49225, 49226, 49227, 49228, 49229, 49230, 49231, 49232, 49233, 49234, 49235, 49236, 49237, 49238, 49239, 49240, 49241, 49242, 49243, 49244, 49245, 49246, 49247, 49248, 49249, 49250, 49251, 49252, 49253, 49254, 49255, 49256, 49257, 49258, 49259, 49260, 49261, 49262, 49263, 49264, 49265, 49266, 49267, 49268, 49269, 49270, 49271, 49272, 49273, 49274, 49275, 49276, 49277, 49278, 49279, 49280, 49281, 49282, 49283, 49284, 49285, 49286, 49287, 49288, 49289, 49290, 49291, 49292, 49293, 49294, 49295, 49296, 49297, 49298, 49299, 49300, 49301, 49302, 49303, 49304, 49305, 49306, 49307, 49308, 49309, 49310, 49311, 49312, 49313, 49314, 49315, 49316, 49317, 49318, 49319, 49320, 49321, 49322, 49323, 49324, 49325, 49326, 49327, 49328, 49329, 49330, 49331, 49332, 49333, 49334, 49335, 49336, 49337, 49338, 49339, 49340, 49341, 49342, 49343, 49344, 49345, 49346, 49347, 49348, 49349, 49350, 49351, 49352, 49353, 49354, 49355, 49356, 49357, 49358, 49359, 49360, 49361, 49362, 49363, 49364, 49365, 49366, 49367, 49368, 49369, 49370, 49371, 49372, 49373, 49374, 49375, 49376, 49377, 49378, 49379, 49380, 49381, 49382, 49383, 49384, 49385, 49386, 49387, 49388, 49389, 49390, 49391, 49392, 49393, 49394, 49395, 49396, 49397, 49398, 49399, 49400, 49401, 49402, 49403, 49404, 49405, 49406, 49407, 49408, 49409, 49410, 49411, 49412, 49413, 49414, 49415, 49416, 49417, 49418, 49419, 49420, 49421, 49422, 49423, 49424, 49425, 49426, 49427, 49428, 49429, 49430, 49431, 49432, 49433, 49434, 49435, 49436, 49437, 49438, 49439, 49440, 49441, 49442, 49443, 49444, 49445, 49446, 49447, 49448, 49449, 49450, 49451, 49452, 49453, 49454, 49455, 49456, 49457, 49458, 49459, 49460, 49461, 49462, 49463, 49464, 49465, 49466, 49467, 49468, 49469, 49470, 49471, 49472, 49473, 49474, 49475, 49476, 49477, 49478, 49479, 49480, 49481, 49482, 49483, 49484, 49485, 49486, 49487, 49488, 49489, 49490, 49491, 49492, 49493, 49494, 49495, 49496, 49497, 49498, 49499, 49500, 49501, 49502, 49503, 49504, 49505, 49506, 49507, 49508, 49509, 49510, 49511, 49512, 49513, 49514, 49515, 49516, 49517, 49518, 49519, 49520, 49521, 49522, 49523, 49524, 49525, 49526, 49527, 49528, 49529, 49530, 49531, 49532, 49533, 49534, 49535, 49536, 49537, 49538, 49539, 49540, 49541, 49542, 49543, 49544, 49545, 49546, 49547, 49548, 49549, 49550, 49551, 49552, 49553, 49554, 49555, 49556, 49557, 49558, 49559, 49560, 49561, 49562, 49563, 49564, 49565, 49566, 49567, 49568, 49569, 49570, 49571, 49572, 49573, 49574, 49575, 49576, 49577, 49578, 49579, 49580, 49581, 49582, 49583, 49584, 49585, 49586, 49587, 49588, 49589, 49590, 49591, 49592, 49593, 49594, 49595, 49596, 49597, 49598, 49599, 49600, 49601, 49602, 49603, 49604, 49605, 49606, 49607, 49608, 49609, 49610, 49611, 49612, 49613, 49614, 49615, 49616, 49617, 49618, 49619, 49620, 49621, 49622, 49623, 49624, 49625, 49626, 49627, 49628, 49629, 49630, 49631, 49632, 49633, 49634, 49635, 49636, 49637, 49638, 49639, 49640, 49641, 49642, 49643, 49644, 49645, 49646, 49647, 49648, 49649, 49650, 49651, 49652, 49653, 49654, 49655, 49656, 49657, 49658, 49659, 49660, 49661, 49662, 49663, 1, 17, 33, 49, 65, 81, 2049, 2065, 2081, 2097, 2113, 2129, 8193, 8209, 8225, 8241, 10241, 10257, 10273, 10289, 12289, 12305, 12321, 12337, 14337, 14353, 14369, 14385, 40960, 40961, 40962, 40963, 40964, 40965, 40966, 40967, 40968, 40969, 40970, 40971, 40972, 40973, 40974, 40975, 40976, 40977, 40978, 40979, 40980, 40981, 40982, 40983, 40984, 40985, 40986, 40987, 40988, 40989, 40990, 40991, 40992, 40993, 40994, 40995, 40996, 40997, 40998, 40999, 41000, 41001, 41002, 41003, 41004, 41005, 41006, 41007, 41008, 41009, 41010, 41011, 41012, 41013, 41014, 41015, 41016, 41017, 41018, 41019, 41020, 41021, 41022, 41023, 41024, 41025, 41026, 41027, 41028, 41029, 41030, 41031, 41032, 41033, 41034, 41035, 41036, 41037, 41038, 41039, 41040, 41041, 41042, 41043, 41044, 41045, 41046, 41047, 41048, 41049, 41050, 41051, 41052, 41053, 41054, 41055, 41056, 41057, 41058, 41059, 41060, 41061, 41062, 41063, 41064, 41065, 41066, 41067, 41068, 41069, 41070, 41071, 41072, 41073, 41074, 41075, 41076, 41077, 41078, 41079, 41080, 41081, 41082, 41083, 41084, 41085, 41086, 41087, 4096, 4112, 4128, 4144, 4160, 4176, 6144, 6160, 6176, 6192, 6208, 6224, 0, 16, 32, 48, 64, 80, 2048, 2064, 2080, 2096, 2112, 2128, 8192, 8208, 8224, 8240, 10240, 10256, 10272, 10288, 12288, 12304, 12320, 12336, 14336, 14352, 14368, 14384, 32768, 32769, 32770, 32771, 32772, 32773, 32774, 32775, 32776, 32777, 32778, 32779, 32780, 32781, 32782, 32783, 32784, 32785, 32786, 32787, 32788, 32789, 32790, 32791, 32792, 32793, 32794, 32795, 32796, 32797, 32798, 32799, 32800, 32801, 32802, 32803, 32804, 32805, 32806, 32807, 32808, 32809, 32810, 32811, 32812, 32813, 32814, 32815, 32816, 32817, 32818, 32819, 32820, 32821, 32822, 32823, 32824, 32825, 32826, 32827, 32828, 32829, 32830, 32831, 32832, 32833, 32834, 32835, 32836, 32837, 32838, 32839, 32840, 32841, 32842, 32843, 32844, 32845, 32846, 32847, 32848, 32849, 32850, 32851, 32852, 32853, 32854, 32855, 32856, 32857, 32858, 32859, 32860, 32861, 32862, 32863, 32864, 32865, 32866, 32867, 32868, 32869, 32870, 32871, 32872, 32873, 32874, 32875, 32876, 32877, 32878, 32879, 32880, 32881, 32882, 32883, 32884, 32885, 32886, 32887, 32888, 32889, 32890, 32891, 32892, 32893, 32894, 32895, 32896, 32897, 32898, 32899, 32900, 32901, 32902, 32903, 32904, 32905, 32906, 32907, 32908, 32909, 32910, 32911, 32912, 32913, 32914, 32915, 32916, 32917, 32918, 32919, 32920, 32921, 32922, 32923, 32924, 32925, 32926, 32927, 32928, 32929, 32930, 32931, 32932, 32933, 32934, 32935, 32936, 32937, 32938, 32939, 32940, 32941, 32942, 32943, 32944, 32945, 32946, 32947, 32948, 32949, 32950, 32951, 32952, 32953, 32954, 32955, 32956, 32957, 32958, 32959, 32960, 32961, 32962, 32963, 32964, 32965, 32966, 32967, 32968, 32969, 32970, 32971, 32972, 32973, 32974, 32975, 32976, 32977, 32978, 32979, 32980, 32981, 32982, 32983, 32984, 32985, 32986, 32987, 32988, 32989, 32990, 32991, 32992, 32993, 32994, 32995, 32996, 32997, 32998, 32999, 33000, 33001, 33002, 33003, 33004, 33005, 33006, 33007, 33008, 33009, 33010, 33011, 33012, 33013, 33014, 33015, 33016, 33017, 33018, 33019, 33020, 33021, 33022, 33023, 33024, 33025, 33026, 33027, 33028, 33029, 33030, 33031, 33032, 33033, 33034, 33035, 33036, 33037, 33038, 33039, 33040, 33041, 33042, 33043, 33044, 33045, 33046, 33047, 33048, 33049, 33050, 33051, 33052, 33053, 33054, 33055, 33056, 33057, 33058, 33059, 33060, 33061, 33062, 33063, 33064, 33065, 33066, 33067, 33068, 33069, 33070, 33071, 33072, 33073, 33074, 33075, 33076, 33077, 33078, 33079, 33080, 33081, 33082, 33083, 33084, 33085, 33086, 33087, 33088, 33089, 33090, 33091, 33092, 33093, 33094, 33095, 33096, 33097, 33098, 33099, 33100, 33101, 33102, 33103, 33104, 33105, 33106, 33107, 33108, 33109, 33110, 33111, 33112, 33113, 33114, 33115, 33116, 33117, 33118, 33119, 33120, 33121, 33122, 33123, 33124, 33125, 33126, 33127, 33128, 33129, 33130, 33131, 33132, 33133, 33134, 33135, 33136, 33137, 33138, 33139, 33140, 33141, 33142, 33143, 33144, 33145, 33146, 33147, 33148, 33149, 33150, 33151, 36864, 36865, 36866, 36867, 36868, 36869, 36870, 36871, 36872, 36873, 36874, 36875, 36876, 36877, 36878, 36879, 36880, 36881, 36882, 36883, 36884, 36885, 36886, 36887, 36888, 36889, 36890, 36891, 36892, 36893, 36894, 36895, 36896, 36897, 36898, 36899, 36900, 36901, 36902, 36903, 36904, 36905, 36906, 36907, 36908, 36909, 36910, 36911, 36912, 36913, 36914, 36915, 36916, 36917, 36918, 36919, 36920, 36921, 36922, 36923, 36924, 36925, 36926, 36927, 36928, 36929, 36930, 36931, 36932, 36933, 36934, 36935, 36936, 36937, 36938, 36939, 36940, 36941, 36942, 36943, 36944, 36945, 36946, 36947, 36948, 36949, 36950, 36951, 36952, 36953, 36954, 36955, 36956, 36957, 36958, 36959, 36960, 36961, 36962, 36963, 36964, 36965, 36966, 36967, 36968, 36969, 36970, 36971, 36972, 36973, 36974, 36975, 36976, 36977, 36978, 36979, 36980, 36981, 36982, 36983, 36984, 36985, 36986, 36987, 36988, 36989, 36990, 36991};


__global__ void __launch_bounds__(NTHR, 2) fwd_kernel(Args args) {
    extern __shared__ __attribute__((aligned(16))) unsigned char lds_raw[];
    float* lds = (float*)lds_raw;
    const int G = gridDim.x, NGW = G * NWAVES, NGT = G * NTHR;
    const int wave_u_ = __builtin_amdgcn_readfirstlane(threadIdx.x >> 6);
#define PHASE_VARS unsigned z0_ = 0u; asm volatile("" : "+v"(z0_));   \
    int tid = wave_u_ * 64 + (int)__builtin_amdgcn_mbcnt_hi(~0u, __builtin_amdgcn_mbcnt_lo(~0u, z0_)); int bid = blockIdx.x; asm volatile("" : "+s"(bid)); \
    const int lane = tid & 63, wave = tid >> 6, gw = bid * NWAVES + wave, gtid = bid * NTHR + tid; (void)lane; (void)gw; (void)gtid;
    volatile LAS unsigned* MISC = (volatile LAS unsigned*)((LAS unsigned char*)lds_raw + MISC_OFF);
    { const int tid = threadIdx.x;
    unsigned char* ws = args.ws;
    if (tid < 64) MISC[tid] = 0u;
    __syncthreads();
    (void)xcd_barrier_post((unsigned*)(ws + WS_CTL) + CW_BAR, MISC + 8);

    if (tid == 0) {
        volatile LAS unsigned long long* pt = (volatile LAS unsigned long long*)(MISC + 64);
#define PT_SET(i) pt[i] = (unsigned long long)args.in[i]
        PT_SET(0); PT_SET(1); PT_SET(2); PT_SET(3); PT_SET(4); PT_SET(5); PT_SET(6); PT_SET(7); PT_SET(8); PT_SET(9); PT_SET(10); PT_SET(11);
        PT_SET(12); PT_SET(13); PT_SET(14); PT_SET(15); PT_SET(16); PT_SET(17); PT_SET(18); PT_SET(19); PT_SET(20); PT_SET(21); PT_SET(22);
#undef PT_SET
        pt[23] = (unsigned long long)args.out; pt[24] = (unsigned long long)args.ws;
    }
    __syncthreads(); }
#define GRID_BAR() do { XcdBarrier b_; b_.bar = (unsigned*)((unsigned char*)ldp(MISC + 64, 24) + WS_CTL) + CW_BAR; b_.x = xb_xcc_id(); b_.st = MISC + 8; unsigned zb_ = 0u; asm volatile("" : "+v"(zb_)); xcd_barrier(b_, wave_u_ == 0 && __builtin_amdgcn_mbcnt_hi(~0u, __builtin_amdgcn_mbcnt_lo(~0u, zb_)) == 0u); } while (0)
#define IN(i) ldp(MISC + 64, i)
#define WSF(off) ((float*)((unsigned char*)ldp(MISC + 64, 24) + (off)))

    auto cv_win = [&](const int item, const int tid) __attribute__((always_inline)) {
        const int lane = tid & 63; const float* w_in = IN(7); signed char* WT8 = (signed char*)WSF(WS_WINT); float* SW = WSF(WS_SW); LAS unsigned* cm = (LAS unsigned*)((LAS unsigned char*)lds_raw + 140 * 1024);
        const int c4 = tid & 7, rg = tid >> 3; const int l = item / 384, n0 = (item % 384) * 32 + 4 * c4; const int sc0 = win_src_col(n0);
        __syncthreads();
        if (tid < 32) cm[tid] = 0u;
        __syncthreads();
        const float* src = w_in + ((size_t)l * DM + rg * 32) * INW + sc0; float v[32][4]; float mx[4] = {0.f, 0.f, 0.f, 0.f};
#pragma unroll
        for (int j = 0; j < 32; ++j) { const float2 a = ldnt2(src + (size_t)j * INW), b2 = ldnt2(src + (size_t)j * INW + 2); v[j][0] = a.x; v[j][1] = a.y; v[j][2] = b2.x; v[j][3] = b2.y; }
#pragma unroll
        for (int j = 0; j < 32; ++j) {
#pragma unroll
            for (int i = 0; i < 4; ++i) mx[i] = fmaxf(mx[i], fabsf(v[j][i])); }
#pragma unroll
        for (int i = 0; i < 4; ++i) { float m = mx[i]; m = fmaxf(m, SWZ_XOR(m, 8)); m = fmaxf(m, SWZ_XOR(m, 16));
            auto rr = __builtin_amdgcn_permlane32_swap(__float_as_uint(m), __float_as_uint(m), false, false); m = fmaxf(__uint_as_float(rr[0]), __uint_as_float(rr[1]));
            if (lane < 8) __hip_atomic_fetch_max(cm + 4 * c4 + i, __float_as_uint(m), __ATOMIC_RELAXED, __HIP_MEMORY_SCOPE_WORKGROUP); }
        __syncthreads();
#pragma unroll
        for (int i = 0; i < 4; ++i) { const float cmx = fmaxf(__uint_as_float(cm[4 * c4 + i]), 1e-30f), q = 127.f / cmx; unsigned w[8];
#pragma unroll
            for (int m = 0; m < 8; ++m) w[m] = pk_i8x4(v[4 * m][i] * q, v[4 * m + 1][i] * q, v[4 * m + 2][i] * q, v[4 * m + 3][i] * q);
            signed char* dst = WT8 + ((size_t)l * 12288 + n0 + i) * DM + rg * 32;
            *(uint4*)dst = make_uint4(w[0], w[1], w[2], w[3]); *(uint4*)(dst + 16) = make_uint4(w[4], w[5], w[6], w[7]);
            if (rg == 0) SW[(size_t)l * 12288 + n0 + i] = cmx * (1.f / 127.f); }
    };
    auto cv_wq = [&](const int item, const int tid) __attribute__((always_inline)) {
        const int lane = tid & 63; const float* wq = IN(18); signed char* WQ8 = (signed char*)WSF(WS_WQT); float* SWQ = WSF(WS_SWQ); LAS unsigned* cm = (LAS unsigned*)((LAS unsigned char*)lds_raw + 140 * 1024);
        const int c4 = tid & 7, rg = tid >> 3; const int l = item >> 6, n0 = (item & 63) * 32 + 4 * c4;
        __syncthreads();
        if (tid < 32) cm[tid] = 0u;
        __syncthreads();
        const float* src = wq + ((size_t)l * DM + rg * 32) * DM + n0; float v[32][4]; float mx[4] = {0.f, 0.f, 0.f, 0.f};
#pragma unroll
        for (int j = 0; j < 32; ++j) { const float4 a = ldnt4(src + (size_t)j * DM); v[j][0] = a.x; v[j][1] = a.y; v[j][2] = a.z; v[j][3] = a.w; }
#pragma unroll
        for (int j = 0; j < 32; ++j) {
#pragma unroll
            for (int i = 0; i < 4; ++i) mx[i] = fmaxf(mx[i], fabsf(v[j][i])); }
#pragma unroll
        for (int i = 0; i < 4; ++i) { float m = mx[i]; m = fmaxf(m, SWZ_XOR(m, 8)); m = fmaxf(m, SWZ_XOR(m, 16));
            auto rr = __builtin_amdgcn_permlane32_swap(__float_as_uint(m), __float_as_uint(m), false, false); m = fmaxf(__uint_as_float(rr[0]), __uint_as_float(rr[1]));
            if (lane < 8) __hip_atomic_fetch_max(cm + 4 * c4 + i, __float_as_uint(m), __ATOMIC_RELAXED, __HIP_MEMORY_SCOPE_WORKGROUP); }
        __syncthreads();
#pragma unroll
        for (int i = 0; i < 4; ++i) { const float cmx = fmaxf(__uint_as_float(cm[4 * c4 + i]), 1e-30f), q = 127.f / cmx; unsigned w[8];
#pragma unroll
            for (int m = 0; m < 8; ++m) w[m] = pk_i8x4(v[4 * m][i] * q, v[4 * m + 1][i] * q, v[4 * m + 2][i] * q, v[4 * m + 3][i] * q);
            signed char* dst = WQ8 + ((size_t)l * DM + n0 + i) * DM + rg * 32;
            *(uint4*)dst = make_uint4(w[0], w[1], w[2], w[3]); *(uint4*)(dst + 16) = make_uint4(w[4], w[5], w[6], w[7]);
            if (rg == 0) SWQ[(size_t)l * DM + n0 + i] = cmx * (1.f / 127.f); }
    };
    auto cv_tr = [&](const int it, const int tid) __attribute__((always_inline)) {
        const int lane = tid & 63, wave = tid >> 6; float* scr = lds + wave * (64 * 33); const int l = it / 4096; int r = it % 4096;
        bf16_t* wbr = (bf16_t*)WSF(WS_WBRT) + (size_t)l * 3 * DM * 768;
        if (r < 768) { transpose_item<false>(IN(14) + (size_t)l * 768 * DM, DM, wbr, 768, scr, r / 64, r % 64, lane); return; } r -= 768;
        if (r < 768) { transpose_item<false>(IN(15) + (size_t)l * 768 * DM, DM, wbr + (size_t)DM * 768, 768, scr, r / 64, r % 64, lane); return; } r -= 768;
        if (r < 512) { transpose_item<false>(IN(16) + (size_t)l * 512 * DM, DM, wbr + (size_t)2 * DM * 768, 768, scr, r / 64, r % 64, lane); return; } r -= 512;
        transpose_item<false>(IN(17) + (size_t)l * DM * DM, DM, (bf16_t*)WSF(WS_WOT) + (size_t)l * DM * DM, DM, scr, r / 64, r % 64, lane);
    };
    auto cv_u = [&](const int r, const int tid) __attribute__((always_inline)) {
        const int lane = tid & 63; const float* pu = IN(20); signed char* U8 = (signed char*)WSF(WS_UB); float* SU = WSF(WS_SU);
        const float* src = pu + (size_t)r * DM; float4 v[8]; float mx = 0.f;
#pragma unroll
        for (int j = 0; j < 8; ++j) { v[j] = ldnt4(src + lane * 4 + 256 * j); mx = fmaxf(mx, fmaxf(fmaxf(fabsf(v[j].x), fabsf(v[j].y)), fmaxf(fabsf(v[j].z), fabsf(v[j].w)))); }
        mx = fmaxf(wave_max(mx), 1e-30f); const float q = 127.f / mx;
#pragma unroll
        for (int j = 0; j < 8; ++j) *(unsigned*)(U8 + (size_t)r * DM + lane * 4 + 256 * j) = pk_i8x4(v[j].x * q, v[j].y * q, v[j].z * q, v[j].w * q);
        if (lane == 0) SU[r] = mx * (1.f / 127.f);
    };
    auto cv_v = [&](const int item, const int tid) __attribute__((always_inline)) {
        const int lane = tid & 63, wave = tid >> 6; const float* pv = IN(21); float* DV = WSF(WS_DV); unsigned char* VT = (unsigned char*)WSF(WS_VT); LAS unsigned char* T = (LAS unsigned char*)lds_raw;
        const int l = item >> 8, eb = item & 255;
        __syncthreads();
#pragma unroll 2
        for (int i = 0; i < 8; ++i) { const int e = wave * 8 + i; const size_t r = (size_t)l * 16384 + eb * 64 + e; const float* src = pv + r * DM; float4 v[8]; float mx = 0.f;
#pragma unroll
            for (int j = 0; j < 8; ++j) { v[j] = ldnt4(src + lane * 4 + 256 * j); mx = fmaxf(mx, fmaxf(fmaxf(fabsf(v[j].x), fabsf(v[j].y)), fmaxf(fabsf(v[j].z), fabsf(v[j].w)))); }
            mx = fmaxf(wave_max(mx), 1e-30f); const float q = 127.f / mx;
#pragma unroll
            for (int j = 0; j < 8; ++j) *(LAS unsigned*)(T + e * 2048 + lane * 4 + 256 * j) = pk_i8x4(v[j].x * q, v[j].y * q, v[j].z * q, v[j].w * q);
            if (lane == 0) DV[r] = mx * (1.f / 127.f); }
        __syncthreads();
#pragma unroll
        for (int qd = 0; qd < 4; ++qd) { unsigned d[16];
#pragma unroll
            for (int e = 0; e < 16; ++e) d[e] = *(const LAS unsigned*)(T + (qd * 16 + e) * 2048 + tid * 4);
#pragma unroll
            for (int k = 0; k < 4; ++k) { unsigned o[4];
#pragma unroll
                for (int g = 0; g < 4; ++g) o[g] = ((d[4 * g] >> (8 * k)) & 0xffu) | (((d[4 * g + 1] >> (8 * k)) & 0xffu) << 8) | (((d[4 * g + 2] >> (8 * k)) & 0xffu) << 16) | (((d[4 * g + 3] >> (8 * k)) & 0xffu) << 24);
                *(uint4*)(VT + ((size_t)l * DM + tid * 4 + k) * 16384 + eb * 64 + qd * 16) = make_uint4(o[0], o[1], o[2], o[3]); } }
        __syncthreads();
    };

    { PHASE_VARS
    {
        const float* c_in = IN(1); const float* ada_w = IN(3); float* MODP = WSF(WS_MODP);
        float* cond = lds;
        for (int i = tid; i < NB * DM; i += NTHR) { const float c = c_in[i]; cond[i] = c / (1.f + expf(-c)); }
        __syncthreads();
        for (int item = gtid; item < 2 * 16 * (NMOD / 4); item += NGT) {
            const int j4 = item % (NMOD / 4), ch = (item / (NMOD / 4)) % 16, l = item / (16 * (NMOD / 4));
            float4 a0 = {0.f, 0.f, 0.f, 0.f}, a1 = {0.f, 0.f, 0.f, 0.f};
            const float* wp = ada_w + ((size_t)l * DM + ch * 128) * NMOD + j4 * 4;
            for (int k = 0; k < 128; ++k) { const float4 w = ldnt4(wp + (size_t)k * NMOD); const float c0 = cond[ch * 128 + k], c1 = cond[DM + ch * 128 + k];
                a0.x += c0 * w.x; a0.y += c0 * w.y; a0.z += c0 * w.z; a0.w += c0 * w.w; a1.x += c1 * w.x; a1.y += c1 * w.y; a1.z += c1 * w.z; a1.w += c1 * w.w; }
            *(float4*)(MODP + (((size_t)l * 16 + ch) * 2 + 0) * NMOD + j4 * 4) = a0;
            *(float4*)(MODP + (((size_t)l * 16 + ch) * 2 + 1) * NMOD + j4 * 4) = a1;
        }
        __syncthreads();
        for (int item = bid; item < 384; item += G) cv_win(item, tid);
        __syncthreads();
        { const int* pos_in = (const int*)IN(2); float* ROPE = WSF(WS_ROPE);
          for (int i = gtid; i < NT * 32; i += NGT) { const int t = i >> 5, k = i & 31; const float invf = exp2f(-(float)(2 * k) * (1.f / 64.f) * 13.287712379549449f);
              const float ang = (float)pos_in[t] * invf; ROPE[(size_t)i * 2] = cosf(ang); ROPE[(size_t)i * 2 + 1] = sinf(ang); } }
    }
    }
    GRID_BAR();
    { PHASE_VARS
    { const float* ada_b = IN(4); const float* MODP = WSF(WS_MODP); float* MOD = WSF(WS_MOD);
    for (int i = gtid; i < 2 * 2 * NMOD; i += NGT) { const int j = i % NMOD, b = (i / NMOD) % 2, l = i / (2 * NMOD); float s = ada_b[(size_t)l * NMOD + j];
        for (int ch = 0; ch < 16; ++ch) s += MODP[(((size_t)l * 16 + ch) * 2 + b) * NMOD + j];
        MOD[i] = s; } }
    }
    GRID_BAR();

#pragma clang loop unroll(full)
    for (int l = 0; l < DEPTH; ++l) {
        const float lam_init = 0.8f - 0.6f * expf(-0.3f * (float)l);
#define MODL (WSF(WS_MOD) + (size_t)l * 2 * NMOD)
        { PHASE_VARS
        { const float* modl = MODL; const float* norm1_g = IN(5); const void* X = (l == 0) ? (const void*)IN(0) : (const void*)WSF(WS_X); const bool xf32 = (l == 0); signed char* HQ = (signed char*)WSF(WS_HB); float* SH1 = WSF(WS_SH1); float* FL = WSF(WS_FL);
        float* wfl = lds;
        { const float* w_in = IN(7) + (size_t)l * DM * INW;
          float wv[24];
#pragma unroll
          for (int it = 0; it < 24; ++it) { const int i = tid + it * NTHR, k = i / 6, jj = i % 6; wv[it] = w_in[(size_t)k * INW + C_FL + jj]; }
#pragma unroll
          for (int it = 0; it < 24; ++it) { const int i = tid + it * NTHR, k = i / 6, jj = i % 6; wfl[jj * DM + k] = wv[it]; } }
        __syncthreads();
        for (int t = gw; t < NT; t += NGW) {
            const int b = t / SEQ; const float* g = norm1_g + (size_t)l * DM; const float* sh = modl + (size_t)b * NMOD; const float* sc = sh + DM;
            float4 v[8]; float ss = 0.f; int ln = lane; asm volatile("" : "+v"(ln));
#pragma unroll
            for (int j = 0; j < 8; ++j) { v[j] = ldx4(X, xf32, (size_t)t * DM + ln * 4 + 256 * j); ss += v[j].x * v[j].x + v[j].y * v[j].y + v[j].z * v[j].z + v[j].w * v[j].w; }
            const float r = rsqrtf(wave_sum(ss) * (1.f / DM) + RMS_EPS);
            float fl[6] = {0.f, 0.f, 0.f, 0.f, 0.f, 0.f}; float hmx = 0.f;
#pragma unroll
            for (int j = 0; j < 8; ++j) { const int d = ln * 4 + 256 * j; const float4 gg = *(const float4*)(g + d), s1 = *(const float4*)(sc + d), s0 = *(const float4*)(sh + d); float4 o;
                o.x = v[j].x * r * gg.x * (1.f + s1.x) + s0.x; o.y = v[j].y * r * gg.y * (1.f + s1.y) + s0.y; o.z = v[j].z * r * gg.z * (1.f + s1.z) + s0.z; o.w = v[j].w * r * gg.w * (1.f + s1.w) + s0.w;
                v[j] = o; hmx = fmaxf(hmx, fmaxf(fmaxf(fabsf(o.x), fabsf(o.y)), fmaxf(fabsf(o.z), fabsf(o.w))));
#pragma unroll
                for (int jj = 0; jj < 6; ++jj) { const float4 w4 = *(const float4*)(wfl + jj * DM + d); fl[jj] += o.x * w4.x + o.y * w4.y + o.z * w4.z + o.w * w4.w; } }
            hmx = fmaxf(wave_max(hmx), 1e-30f); const float hq = 127.f / hmx;
#pragma unroll
            for (int j = 0; j < 8; ++j) *(unsigned*)(HQ + (size_t)t * DM + ln * 4 + 256 * j) = pk_i8x4(v[j].x * hq, v[j].y * hq, v[j].z * hq, v[j].w * hq);
            if (lane == 0) SH1[t] = hmx * (1.f / 127.f);
#pragma unroll
            for (int jj = 0; jj < 6; ++jj) fl[jj] = wave_sum(fl[jj]);
            if (lane == 0) { *(float4*)(FL + (size_t)t * 8) = (float4){fl[0], fl[1], fl[2], fl[3]}; *(float2*)(FL + (size_t)t * 8 + 4) = (float2){fl[4], fl[5]}; }
        }
        __syncthreads(); }
        }
        GRID_BAR();
        { PHASE_VARS
        { const float* b_forget = IN(8); const float* FL = WSF(WS_FL); float* CUM = WSF(WS_CUM);
        if (bid < 12) {
            const int b = bid / 6, h = bid % 6; float* sc = lds;
            float loc[8]; float run = 0.f; const float bf = b_forget[l * 6 + h];
#pragma unroll
            for (int j = 0; j < 8; ++j) { const int s = tid * 8 + j; const float xl = FL[((size_t)b * SEQ + s) * 8 + h] + bf; run += fminf(xl, 0.f) - __logf(1.f + __expf(-fabsf(xl))); loc[j] = run; }
            sc[tid] = run; __syncthreads();
            for (int o = 1; o < NTHR; o <<= 1) { float v = 0.f; if (tid >= o) v = sc[tid - o]; __syncthreads(); sc[tid] += v; __syncthreads(); }
            const float off = (tid > 0) ? sc[tid - 1] : 0.f;
#pragma unroll
            for (int j = 0; j < 8; ++j) CUM[(size_t)bid * SEQ + tid * 8 + j] = (off + loc[j]) * 1.4426950408889634f;
            __syncthreads();
        } }
        { pg8::Gemm8 g{(const signed char*)WSF(WS_HB), (const signed char*)WSF(WS_WINT) + (size_t)l * 12288 * DM, NT, 12288, DM, DM, DM};
          pg8::StaticOrder S; S.init(NT, 12288, G, bid);
          EpiProj E{(bf16_t*)WSF(WS_ATT), (bf16_t*)WSF(WS_GATES), WSF(WS_ROPE), WSF(WS_SH1), WSF(WS_SW) + (size_t)l * 12288, (unsigned*)WSF(WS_CTL) + 12288 + 32 * l};
          pg8::gemm_phase_i8<EpiProj, pg8::StaticOrder, true, true>(tid, (LAS unsigned char*)lds_raw, g, S, E); }
        }
        GRID_BAR();
        { PHASE_VARS
        { const bf16_t* ATTp = (const bf16_t*)WSF(WS_ATT); const float* CUM = WSF(WS_CUM); bf16_t* O = (bf16_t*)WSF(WS_OB); float* ODF = WSF(WS_ODF);
          unsigned* qctr = (unsigned*)WSF(WS_CTL) + 8192 + 64 * l;
          const unsigned* KINFp = (const unsigned*)WSF(WS_CTL) + 12288 + 32 * l; unsigned char* Gzp = (unsigned char*)WSF(WS_G);
        const unsigned short* qtab = (l == 0) ? ATT_ITEMS0 : ATT_UNITS; const unsigned qlen = (l == 0) ? (unsigned)N_ATT_ITEMS0 : 640u;
        for (;;) {
            if (tid == 0) MISC[16] = __hip_atomic_fetch_add(qctr, 1u, __ATOMIC_RELAXED, __HIP_MEMORY_SCOPE_AGENT);
            __syncthreads();
            const unsigned rank = MISC[16];
            __syncthreads();
            if (rank >= qlen) break;
            const unsigned uu = qtab[rank];
            int tid_u = tid; asm volatile("" : "+v"(tid_u));
            if (l == 0 && (uu & 0x8000u)) {
                const int ty = (uu >> 12) & 7, ix = uu & 0xfff, wave_u = tid_u >> 6;
                if (ty == 0) cv_win(384 + ix, tid_u);
                else if (ty == 1) cv_wq(ix, tid_u);
                else if (ty == 2) { for (int k = 0; k < 8; ++k) cv_tr(ix * 64 + k * 8 + wave_u, tid_u); }
                else if (ty == 3) { for (int k = 0; k < 32; ++k) cv_u(ix * 256 + k * 8 + wave_u, tid_u); }
                else cv_v(ix, tid_u);
                __syncthreads();
                continue; }
            const int mode = (uu >> 12) & 3, b = (uu >> 11) & 1, h = (uu >> 4) & 7, qb = uu & 15;
            const unsigned zid = (mode < 2) ? (unsigned)(mode * 192 + (b * 6 + h) * 16 + qb) : (unsigned)(384 + (mode - 2) * 128 + (b * 4 + h) * 16 + qb);
            if (mode == 0) att::attn_unit<0>(tid_u, (char*)lds_raw, ATTp, CUM, O, ODF, b, h, qb, KINFp, Gzp, zid);
            else if (mode == 1) att::attn_unit<1>(tid_u, (char*)lds_raw, ATTp, nullptr, O, ODF, b, h, qb, KINFp, Gzp, zid);
            else if (mode == 2) att::attn_unit<2>(tid_u, (char*)lds_raw, ATTp, nullptr, O, ODF, b, h, qb, KINFp, Gzp, zid);
            else att::attn_unit<3>(tid_u, (char*)lds_raw, ATTp, nullptr, O, ODF, b, h, qb, KINFp, Gzp, zid);
        } }
        }
        GRID_BAR();
        { PHASE_VARS
        { const float* ODF = WSF(WS_ODF); bf16_t* O = (bf16_t*)WSF(WS_OB); const float* lam_q1 = IN(9); const float* lam_k1 = IN(10); const float* lam_q2 = IN(11); const float* lam_k2 = IN(12); const float* subg = IN(13) + l * 128;
          float lamh[4];
#pragma unroll
          for (int h = 0; h < 4; ++h) { float d1 = 0.f, d2 = 0.f; for (int i = 0; i < 64; ++i) { d1 += lam_q1[(l * 4 + h) * 64 + i] * lam_k1[(l * 4 + h) * 64 + i]; d2 += lam_q2[(l * 4 + h) * 64 + i] * lam_k2[(l * 4 + h) * 64 + i]; }
              lamh[h] = expf(d1) - expf(d2) + lam_init; }
        for (int t = gw; t < NT; t += NGW) {
            const int hq = lane >> 4; const float lam = hq == 0 ? lamh[0] : hq == 1 ? lamh[1] : hq == 2 ? lamh[2] : lamh[3];
            const float4 a0 = *(const float4*)(ODF + (size_t)t * 512 + lane * 8), a1 = *(const float4*)(ODF + (size_t)t * 512 + lane * 8 + 4);
            const float4 b0 = *(const float4*)(ODF + ((size_t)NT + t) * 512 + lane * 8), b1 = *(const float4*)(ODF + ((size_t)NT + t) * 512 + lane * 8 + 4);
            float v[8] = {a0.x - lam * b0.x, a0.y - lam * b0.y, a0.z - lam * b0.z, a0.w - lam * b0.w, a1.x - lam * b1.x, a1.y - lam * b1.y, a1.z - lam * b1.z, a1.w - lam * b1.w}; float ss = 0.f;
#pragma unroll
            for (int i = 0; i < 8; ++i) ss += v[i] * v[i];
            ss += __shfl_xor(ss, 1); ss += __shfl_xor(ss, 2); ss += __shfl_xor(ss, 4); ss += __shfl_xor(ss, 8);
            const float rr = rsqrtf(ss * (1.f / 128.f) + RMS_EPS) * (1.f - lam_init); const int dd = (lane & 15) * 8;
            const float4 g0 = *(const float4*)(subg + dd), g1 = *(const float4*)(subg + dd + 4);
            pg8::u32x4 w; w.x = pg8::cvt_pk_bf16(v[0] * rr * g0.x, v[1] * rr * g0.y); w.y = pg8::cvt_pk_bf16(v[2] * rr * g0.z, v[3] * rr * g0.w); w.z = pg8::cvt_pk_bf16(v[4] * rr * g1.x, v[5] * rr * g1.y); w.w = pg8::cvt_pk_bf16(v[6] * rr * g1.z, v[7] * rr * g1.w);
            *(pg8::u32x4*)(O + (size_t)t * DM + 1536 + lane * 8) = w;
        } }
        }
        GRID_BAR();
        { PHASE_VARS
        { pg8::Gemm g{(const bf16_t*)WSF(WS_OB), (const bf16_t*)WSF(WS_WBRT) + (size_t)l * 3 * DM * 768, NT, DM, 768, DM, 768}; pg8::BranchOrder S; S.init(NT, DM, G, bid);
          EpiBranchCarry E{(bf16_t*)WSF(WS_YB), (const bf16_t*)WSF(WS_GATES)};
          pg8::gemm_phase<EpiBranchCarry, pg8::BranchOrder, true, true>(tid, (LAS unsigned char*)lds_raw, g, S, E); }
        }
        GRID_BAR();
        { PHASE_VARS
        { pg8::Gemm g{(const bf16_t*)WSF(WS_YB), (const bf16_t*)WSF(WS_WOT) + (size_t)l * DM * DM, NT, DM, DM, DM, DM}; pg8::StaticOrder S; S.init(NT, DM, G, bid);
          EpiResidM E{(bf16_t*)WSF(WS_X), MODL + 2 * DM, (l == 0) ? (const void*)IN(0) : (const void*)WSF(WS_X), l == 0};
          pg8::gemm_phase<EpiResidM, pg8::StaticOrder, true, true>(tid, (LAS unsigned char*)lds_raw, g, S, E); }
        }
        GRID_BAR();
        { PHASE_VARS
        { const float* modl = MODL; const float* norm2_g = IN(6); const void* X = WSF(WS_X); signed char* HB8 = (signed char*)WSF(WS_HB8); float* SH = WSF(WS_SH);
        for (int t = gw; t < NT; t += NGW) {
            const int b = t / SEQ; const float* g = norm2_g + (size_t)l * DM; const float* sh = modl + (size_t)b * NMOD + 3 * DM; const float* sc = sh + DM;
            float4 v[8]; float ss = 0.f;
#pragma unroll
            for (int j = 0; j < 8; ++j) { v[j] = ldx4(X, false, (size_t)t * DM + lane * 4 + 256 * j); ss += v[j].x * v[j].x + v[j].y * v[j].y + v[j].z * v[j].z + v[j].w * v[j].w; }
            const float r = rsqrtf(wave_sum(ss) * (1.f / DM) + RMS_EPS);
            float hmx = 0.f;
#pragma unroll
            for (int j = 0; j < 8; ++j) { const int d = lane * 4 + 256 * j; const float4 gg = *(const float4*)(g + d), s1 = *(const float4*)(sc + d), s0 = *(const float4*)(sh + d); float4 o;
                o.x = v[j].x * r * gg.x * (1.f + s1.x) + s0.x; o.y = v[j].y * r * gg.y * (1.f + s1.y) + s0.y; o.z = v[j].z * r * gg.z * (1.f + s1.z) + s0.z; o.w = v[j].w * r * gg.w * (1.f + s1.w) + s0.w;
                v[j] = o; hmx = fmaxf(hmx, fmaxf(fmaxf(fabsf(o.x), fabsf(o.y)), fmaxf(fabsf(o.z), fabsf(o.w)))); }
            hmx = fmaxf(wave_max(hmx), 1e-30f); const float hq = 127.f / hmx;
#pragma unroll
            for (int j = 0; j < 8; ++j) *(unsigned*)(HB8 + (size_t)t * DM + lane * 4 + 256 * j) = pk_i8x4(v[j].x * hq, v[j].y * hq, v[j].z * hq, v[j].w * hq);
            if (lane == 0) SH[t] = hmx * (1.f / 127.f);
        } }
        }
        GRID_BAR();
        { PHASE_VARS
        { pg8::Gemm8 g{(const signed char*)WSF(WS_HB8), (const signed char*)WSF(WS_WQT) + (size_t)l * DM * DM, NT, DM, DM, DM, DM}; pg8::StaticOrder S; S.init(NT, DM, G, bid);
          EpiStoreI8 E{WSF(WS_PQ), DM, WSF(WS_SH), WSF(WS_SWQ) + (size_t)l * DM};
          pg8::gemm_phase_i8<EpiStoreI8, pg8::StaticOrder, true, true>(tid, (LAS unsigned char*)lds_raw, g, S, E); }
        }
        { PHASE_VARS
        asm volatile("s_waitcnt vmcnt(0)" ::: "memory"); __syncthreads();
        {
            pg8::Unit uq; { pg8::StaticOrder S; S.init(NT, DM, G, bid); if (!S.next(0, uq)) { uq.pm = 0; uq.pn = 0; } }
            const float* peer_keys = IN(19); const float* PQ = WSF(WS_PQ); int* EIDX = (int*)WSF(WS_EIDX); float* GATE = WSF(WS_GATE);
            const int hh = uq.pn;
            char* imgs = (char*)lds_raw;
            { float4 ka[8], kb2[8];
#pragma unroll
              for (int it = 0; it < 8; ++it) { const int c = tid + it * NTHR, p = c >> 11, k = (c >> 4) & 127, ch = c & 15;
                  const float* src = peer_keys + ((((size_t)l * 8 + hh) * 2 + p) * 128 + k) * 128 + ch * 8; ka[it] = *(const float4*)src; kb2[it] = *(const float4*)(src + 4); }
#pragma unroll
              for (int it = 0; it < 8; ++it) { const int c = tid + it * NTHR, p = c >> 11, k = (c >> 4) & 127, ch = c & 15; const float4 a = ka[it], b2 = kb2[it];
                const float f[8] = {a.x, a.y, a.z, a.w, b2.x, b2.y, b2.z, b2.w}; unsigned hw[4], lw[4];
#pragma unroll
                for (int e = 0; e < 4; ++e) { const unsigned h2 = att::cvtpk(f[2 * e], f[2 * e + 1]); hw[e] = h2; lw[e] = att::cvtpk(f[2 * e] - __uint_as_float(h2 << 16), f[2 * e + 1] - __uint_as_float(h2 & 0xffff0000u)); }
                char* dst = imgs + ((p * 2 + (k >> 6)) * 2) * 16384 + (k & 63) * 256 + ((ch * 16) ^ (((k & 63) & 7) << 4));
                *(att::u32x4*)dst = (att::u32x4){hw[0], hw[1], hw[2], hw[3]}; *(att::u32x4*)(dst + 16384) = (att::u32x4){lw[0], lw[1], lw[2], lw[3]}; } }
            __syncthreads();
            const int wid = __builtin_amdgcn_readfirstlane(tid >> 6), r32 = lane & 31, hi = lane >> 5;
            if (bid < (NT / 256) * (DM / 256)) { const int tg = uq.pm * 8 + wid;
                const int t = tg * 32 + r32; const float* q = PQ + (size_t)t * DM + hh * 256;
                unsigned w1[16], w2[16];
                topk::half_top16(q, imgs, r32, hi, w1);
                topk::half_top16(q + 128, imgs + 65536, r32, hi, w2);
                float bv[16]; unsigned bp[16];
                topk::combine_top16(w1, w2, hi, bv, bp);
                const float mx = bv[0]; float es = 0.f; float ge[16];
#pragma unroll
                for (int r = 0; r < 16; ++r) { ge[r] = __expf(bv[r] - mx); es += ge[r]; }
                const float inv = 1.f / es;
                if (hi == 0) { int* ep = EIDX + (size_t)t * PE_E + hh * PE_TOP; float* gp = GATE + (size_t)t * PE_E + hh * PE_TOP;
#pragma unroll
                    for (int r4 = 0; r4 < 4; ++r4) { *(int4*)(ep + 4 * r4) = make_int4((int)bp[4 * r4], (int)bp[4 * r4 + 1], (int)bp[4 * r4 + 2], (int)bp[4 * r4 + 3]);
                        *(float4*)(gp + 4 * r4) = make_float4(ge[4 * r4] * inv, ge[4 * r4 + 1] * inv, ge[4 * r4 + 2] * inv, ge[4 * r4 + 3] * inv); } }
            }
            __syncthreads();
        }
        }
        GRID_BAR();
        { PHASE_VARS
        { int* EIDX = (int*)WSF(WS_EIDX); const float* GATE = WSF(WS_GATE); unsigned char* Sm = (unsigned char*)WSF(WS_G); float* GMg = WSF(WS_GM); float* ACTF = WSF(WS_ACTF); const float* DV = WSF(WS_DV) + (size_t)l * 16384;
        for (int t = gw; t < NT; t += NGW) {
            const int e0 = EIDX[(size_t)t * PE_E + lane], e1 = EIDX[(size_t)t * PE_E + 64 + lane]; const float g0 = GATE[(size_t)t * PE_E + lane], g1 = GATE[(size_t)t * PE_E + 64 + lane];
            float s0 = 0.f, s1 = 0.f; bool f0 = true, f1 = true;
            for (int k = 0; k < 64; ++k) { const int ek = __shfl(e0, k); const float gk = __shfl(g0, k);
                if (ek == e0) { s0 += gk; if (k < lane) f0 = false; } if (ek == e1) { s1 += gk; f1 = false; } }
            for (int k = 0; k < 64; ++k) { const int ek = __shfl(e1, k); const float gk = __shfl(g1, k);
                if (ek == e0) s0 += gk; if (ek == e1) { s1 += gk; if (k < lane) f1 = false; } }
            if (f0) { Sm[gaddr(t, e0)] = (unsigned char)(lane + 1); GMg[(size_t)t * PE_E + lane] = s0 * DV[e0]; } else { EIDX[(size_t)t * PE_E + lane] = -1; ACTF[(size_t)t * PE_E + lane] = 0.f; }
            if (f1) { Sm[gaddr(t, e1)] = (unsigned char)(64 + lane + 1); GMg[(size_t)t * PE_E + 64 + lane] = s1 * DV[e1]; } else { EIDX[(size_t)t * PE_E + 64 + lane] = -1; ACTF[(size_t)t * PE_E + 64 + lane] = 0.f; }
        } }
        }
        GRID_BAR();
        { PHASE_VARS
        { pg8::Gemm8 g{(const signed char*)WSF(WS_HB8), (const signed char*)WSF(WS_UB) + (size_t)l * 16384 * DM, NT, 16384, DM, DM, DM}; pg8::StaticOrder S; S.init(NT, 16384, G, bid);
          EpiPeerHid E{(const unsigned char*)WSF(WS_G), WSF(WS_SH), WSF(WS_SU) + (size_t)l * 16384, WSF(WS_ACTF)};
          pg8::gemm_phase_i8<EpiPeerHid, pg8::StaticOrder, true, true>(tid, (LAS unsigned char*)lds_raw, g, S, E); }
        }
        GRID_BAR();
        { PHASE_VARS
        { const int* EIDX = (const int*)WSF(WS_EIDX); const float* ACTF = WSF(WS_ACTF); const float* GMg = WSF(WS_GM); signed char* A8 = (signed char*)WSF(WS_G); float* SA = WSF(WS_SA);
        for (int t = gw; t < NT; t += NGW) {
            const int e0 = EIDX[(size_t)t * PE_E + lane], e1 = EIDX[(size_t)t * PE_E + 64 + lane];
            const float a0 = (e0 >= 0) ? GMg[(size_t)t * PE_E + lane] * gelu_erf(ACTF[(size_t)t * PE_E + lane]) : 0.f, a1 = (e1 >= 0) ? GMg[(size_t)t * PE_E + 64 + lane] * gelu_erf(ACTF[(size_t)t * PE_E + 64 + lane]) : 0.f;
            const float mx = fmaxf(wave_max(fmaxf(fabsf(a0), fabsf(a1))), 1e-30f), q = 127.f / mx;
            if (e0 >= 0) A8[gaddr(t, e0)] = (signed char)(int)rintf(a0 * q);
            if (e1 >= 0) A8[gaddr(t, e1)] = (signed char)(int)rintf(a1 * q);
            if (lane == 0) SA[t] = mx * (1.f / 127.f);
        } }
        }
        GRID_BAR();
        { PHASE_VARS
        { pg8::Gemm8 g{(const signed char*)WSF(WS_G), (const signed char*)WSF(WS_VT) + (size_t)l * DM * 16384, NT, DM, 16384, 256, 16384}; pg8::StaticOrder S; S.init(NT, DM, G, bid);
          EpiResidI8 E{(bf16_t*)WSF(WS_X), MODL + 5 * DM, WSF(WS_SA)};
          pg8::gemm_phase_i8<EpiResidI8, pg8::StaticOrder, true, true, true>(tid, (LAS unsigned char*)lds_raw, g, S, E); }
        }
        GRID_BAR();
    }
    { PHASE_VARS
    { const void* X = WSF(WS_X); const float* final_g = IN(22); float* outp = (float*)IN(23);
    for (int t = gw; t < NT; t += NGW) {
        float4 v[8]; float ss = 0.f;
#pragma unroll
        for (int j = 0; j < 8; ++j) { v[j] = ldx4(X, false, (size_t)t * DM + lane * 4 + 256 * j); ss += v[j].x * v[j].x + v[j].y * v[j].y + v[j].z * v[j].z + v[j].w * v[j].w; }
        const float r = rsqrtf(wave_sum(ss) * (1.f / DM) + RMS_EPS);
#pragma unroll
        for (int j = 0; j < 8; ++j) { const int d = lane * 4 + 256 * j; const float4 gg = *(const float4*)(final_g + d); float4 o;
            o.x = v[j].x * r * gg.x; o.y = v[j].y * r * gg.y; o.z = v[j].z * r * gg.z; o.w = v[j].w * r * gg.w; *(float4*)(outp + (size_t)t * DM + d) = o; }
    } }
    }
}

extern "C" void kernel_launch(void* const* d_in, const int* in_sizes, int n_in, void* d_out, int out_size, void* d_ws, size_t ws_size, hipStream_t stream) {
    static int grid = 0;
    if (grid == 0) {
        if (n_in != 23 || out_size != NT * DM || ws_size < WS_END) { fprintf(stderr, "kernel_launch: unexpected shapes: n_in %d out %d ws %zu (need %zu)\n", n_in, out_size, ws_size, (size_t)WS_END); grid = -1; return; }
        int dev = 0, cus = 0;
        if (hipGetDevice(&dev) != hipSuccess || hipDeviceGetAttribute(&cus, hipDeviceAttributeMultiprocessorCount, dev) != hipSuccess) { grid = -1; return; }
        if (hipFuncSetAttribute((const void*)fwd_kernel, hipFuncAttributeMaxDynamicSharedMemorySize, LDS_BYTES) != hipSuccess) { fprintf(stderr, "kernel_launch: hipFuncSetAttribute failed\n"); grid = -1; return; }
        int per_cu = 0;
        if (hipOccupancyMaxActiveBlocksPerMultiprocessor(&per_cu, (const void*)fwd_kernel, NTHR, LDS_BYTES) != hipSuccess || per_cu < 1) { fprintf(stderr, "kernel_launch: occupancy query says %d\n", per_cu); (void)hipGetLastError(); grid = -1; return; }
        grid = cus;
        if (grid % 8 != 0) grid -= grid % 8;
    }
    if (grid < 0) return;
    (void)hipMemsetAsync((char*)d_ws + WS_CTL, 0, CTL_ZERO_BYTES, stream);
    Args a{};
    for (int i = 0; i < 23; ++i) a.in[i] = (const float*)d_in[i];
    a.out = (float*)d_out; a.ws = (unsigned char*)d_ws;
    hipLaunchKernelGGL(fwd_kernel, dim3(grid), dim3(NTHR), LDS_BYTES, stream, a);
}
```

```cpp
#include <hip/hip_runtime.h>
#include <cstdio>
#include <cstdint>

#define LAS __attribute__((address_space(3)))
#define GAS __attribute__((address_space(1)))

constexpr int NB = 2, SEQ = 4096, DM = 2048, NT = NB * SEQ, DEPTH = 2;
constexpr int INW = 12294;
constexpr int C_FQ = 0, C_FK = 768, C_FV = 1536, C_SQ = 2304, C_SK = 3072, C_SV = 3840, C_DQ = 4608, C_DK = 5120, C_DV = 5632, C_FL = 6144, C_GF = 6150, C_GS = 8198, C_GD = 10246;
constexpr int NMOD = 6 * DM;
constexpr int PE_H = 8, PE_K = 128, PE_TOP = 16, PE_E = PE_H * PE_TOP;
constexpr float RMS_EPS = 1e-6f;

constexpr size_t MiB = 1u << 20;
constexpr size_t WS_CTL = 0, CTL_ZERO_BYTES = 1 * MiB;
constexpr size_t WS_X = 1 * MiB;
constexpr size_t WS_HB = WS_X + (size_t)NT * DM * 4;
constexpr size_t WS_ATT = WS_HB + (size_t)NT * DM * 2;
constexpr size_t WS_GATES = WS_ATT + (size_t)NT * 6144 * 2;
constexpr size_t WS_Y = WS_GATES + (size_t)NT * 6144 * 2;
constexpr size_t WS_G = WS_Y;
constexpr size_t WS_PQ = WS_G + (size_t)NT * 16384;
constexpr size_t WS_WINT = WS_PQ + (size_t)NT * DM * 4;
constexpr size_t WS_WBRT = WS_WINT + (size_t)2 * 12288 * DM * 2;
constexpr size_t WS_WOT = WS_WBRT + (size_t)2 * 3 * DM * 768 * 2;
constexpr size_t WS_WQT = WS_WOT + (size_t)2 * DM * DM * 2;
constexpr size_t WS_OB = WS_WQT + (size_t)2 * DM * DM * 2;
constexpr size_t WS_YB = WS_OB + (size_t)NT * DM * 2;
constexpr size_t WS_UB = WS_YB + (size_t)NT * DM * 2;
constexpr size_t WS_VT = WS_UB + (size_t)2 * 16384 * DM * 2;
constexpr size_t WS_ROPE = WS_VT + (size_t)2 * 16384 * DM * 2;
constexpr size_t WS_FL = WS_ROPE + (size_t)NT * 64 * 4;
constexpr size_t WS_CUM = WS_FL + (size_t)NT * 8 * 4;
constexpr size_t WS_MODP = WS_CUM + (size_t)12 * SEQ * 4;
constexpr size_t WS_MOD = WS_MODP + (size_t)2 * 16 * 2 * NMOD * 4;
constexpr size_t WS_EIDX = WS_MOD + (size_t)2 * 2 * NMOD * 4;
constexpr size_t WS_GATE = WS_EIDX + (size_t)NT * PE_E * 4;
constexpr size_t WS_HB8 = WS_GATE + (size_t)NT * PE_E * 4;
constexpr size_t WS_SH = WS_HB8 + (size_t)NT * DM;
constexpr size_t WS_SU = WS_SH + (size_t)NT * 4;
constexpr size_t WS_DV = WS_SU + (size_t)2 * 16384 * 4;
constexpr size_t WS_GM = WS_DV + (size_t)2 * 16384 * 4;
constexpr size_t WS_ACTF = WS_GM + (size_t)NT * PE_E * 4;
constexpr size_t WS_SA = WS_ACTF + (size_t)NT * PE_E * 4;
constexpr size_t WS_SW = WS_SA + (size_t)NT * 4;
constexpr size_t WS_SH1 = WS_SW + (size_t)2 * 12288 * 4;
constexpr size_t WS_SWQ = WS_SH1 + (size_t)NT * 4;
constexpr size_t WS_ODF = WS_SWQ + (size_t)2 * DM * 4;
constexpr size_t WS_END = WS_ODF + (size_t)2 * NT * 512 * 4;
static_assert(WS_END <= (size_t)1024 * MiB, "workspace map exceeds the guaranteed 1 GiB");

constexpr int CW_BAR = 4096;
constexpr int NWAVES = 8, NTHR = NWAVES * 64;
constexpr int LDS_BYTES = 147456;
constexpr int MISC_OFF = 144 * 1024 - 1024;

#define XB_TMO      128
#define XB_XCNT(j)  (256  + 64 * (j))
#define XB_XSUB(j)  (1280 + 64 * (j))
#define XB_XGEN(j)  (2304 + 64 * (j))
#define XB_TOP      3328
#define XB_TOPGEN   3392
#define XCD_BAR_WORDS 3456
#define XB_SPIN_CAP (1u << 18)

__device__ __forceinline__ unsigned xb_ld(unsigned* p)              { return __hip_atomic_load(p, __ATOMIC_RELAXED, __HIP_MEMORY_SCOPE_AGENT); }
__device__ __forceinline__ unsigned xb_add(unsigned* p, unsigned v) { return __hip_atomic_fetch_add(p, v, __ATOMIC_RELAXED, __HIP_MEMORY_SCOPE_AGENT); }
__device__ __forceinline__ unsigned xb_xcc_id() { return (unsigned)__builtin_amdgcn_s_getreg((3 << 11) | 20) & 0xFu; }
#define XB_SPIN(cond, bar) do { unsigned _sp = 0; while (cond) { __builtin_amdgcn_s_sleep(1); \
    if ((++_sp & 255u) == 0u) { if (xb_ld(&(bar)[XB_TMO])) break; if (_sp > XB_SPIN_CAP) { atomicAdd(&(bar)[XB_TMO], 1u); break; } } } } while (0)

struct XcdBarrier { unsigned* bar; unsigned x; volatile LAS unsigned* st; };

__device__ __forceinline__ XcdBarrier xcd_barrier_post(unsigned* bar, volatile LAS unsigned* st) {
    XcdBarrier b; b.bar = bar; b.x = xb_xcc_id(); b.st = st;
    if (threadIdx.x == 0) (void)xb_add(&bar[XB_XCNT(b.x)], 1u);
    return b;
}
__device__ __forceinline__ void xcd_barrier_complete(unsigned* bar, unsigned x, unsigned& nloc, unsigned& nx) {
    const unsigned G = gridDim.x * gridDim.y * gridDim.z;
    unsigned sum, cnt, mine, sp = 0u;
    for (;;) {
        sum = 0u; cnt = 0u; mine = 0u;
#pragma unroll
        for (unsigned j = 0; j < 16; ++j) { const unsigned c = xb_ld(&bar[XB_XCNT(j)]); sum += c; cnt += (c > 0u) ? 1u : 0u; mine = (j == x) ? c : mine; }
        if (sum == G) break;
        __builtin_amdgcn_s_sleep(1);
        if ((++sp & 255u) == 0u) { if (xb_ld(&bar[XB_TMO])) break; if (sp > XB_SPIN_CAP) { atomicAdd(&bar[XB_TMO], 1u); break; } }
    }
    nloc = mine > 0u ? mine : 1u; nx = cnt > 0u ? cnt : 1u;
}
__device__ __forceinline__ void xcd_barrier(const XcdBarrier& b, const bool thread0) {
    asm volatile("s_waitcnt vmcnt(0)" ::: "memory");
    __syncthreads();
    if (thread0) {
        unsigned* bar = b.bar;
        __builtin_amdgcn_s_waitcnt(0);
        unsigned nloc = b.st[0], nx = b.st[1];
        if (nloc == 0u) { xcd_barrier_complete(bar, b.x, nloc, nx); b.st[0] = nloc; b.st[1] = nx; }
        const unsigned old = xb_add(&bar[XB_XSUB(b.x)], 1u);
        const unsigned gen = old / nloc;
        if (old + 1u == (gen + 1u) * nloc) {
            __builtin_amdgcn_fence(__ATOMIC_RELEASE, "agent");
            asm volatile("s_waitcnt vmcnt(0)" ::: "memory");
            const unsigned og = xb_add(&bar[XB_TOP], 1u);
            const unsigned tg = og / nx;
            if (og + 1u == (tg + 1u) * nx) xb_add(&bar[XB_TOPGEN], 1u);
            else XB_SPIN(xb_ld(&bar[XB_TOPGEN]) == tg, bar);
            __builtin_amdgcn_fence(__ATOMIC_ACQUIRE, "agent");
            xb_add(&bar[XB_XGEN(b.x)], 1u);
            asm volatile("s_waitcnt vmcnt(0)" ::: "memory");
        } else {
            XB_SPIN(xb_ld(&bar[XB_XGEN(b.x)]) == gen, bar);
            __builtin_amdgcn_fence(__ATOMIC_ACQUIRE, "agent");
            asm volatile("s_waitcnt vmcnt(0)" ::: "memory");
        }
    }
    __syncthreads();
}

#define SWZ_XOR(v, m) __int_as_float(__builtin_amdgcn_ds_swizzle(__float_as_int(v), ((m) << 10) | 0x1f))
__device__ __forceinline__ float wave_sum(float v) {
    v += SWZ_XOR(v, 1); v += SWZ_XOR(v, 2); v += SWZ_XOR(v, 4); v += SWZ_XOR(v, 8); v += SWZ_XOR(v, 16);
    auto rr = __builtin_amdgcn_permlane32_swap(__float_as_uint(v), __float_as_uint(v), false, false); return __uint_as_float(rr[0]) + __uint_as_float(rr[1]);
}
__device__ __forceinline__ float logsig(float x) { return fminf(x, 0.f) - log1pf(expf(-fabsf(x))); }
__device__ __forceinline__ float gelu_erf(float x) { return 0.5f * x * (1.f + erff(x * 0.70710678118654752f)); }

__device__ __forceinline__ const float* ldp(volatile LAS unsigned* tab0, int i) {
    unsigned a = (unsigned)(unsigned long long)tab0; asm volatile("" : "+v"(a));
    volatile LAS unsigned* tab = (volatile LAS unsigned*)(unsigned long long)a;
    unsigned lo = tab[2 * i], hi = tab[2 * i + 1];
    lo = __builtin_amdgcn_readfirstlane(lo); hi = __builtin_amdgcn_readfirstlane(hi);
    return (const float*)(const GAS float*)(((unsigned long long)hi << 32) | lo);
}
typedef float vf4_ __attribute__((ext_vector_type(4)));
typedef float vf2_ __attribute__((ext_vector_type(2)));
__device__ __forceinline__ float4 ldnt4(const float* p) { const vf4_ v = __builtin_nontemporal_load((const vf4_*)p); return make_float4(v[0], v[1], v[2], v[3]); }
__device__ __forceinline__ float2 ldnt2(const float* p) { const vf2_ v = __builtin_nontemporal_load((const vf2_*)p); return make_float2(v[0], v[1]); }
__device__ __forceinline__ float ldnt1(const float* p) { return __builtin_nontemporal_load(p); }
__device__ __forceinline__ float4 ldx4(const void* X, const bool f32, const size_t idx) {
    if (f32) return *(const float4*)((const float*)X + idx);
    const uint2 w = *(const uint2*)((const unsigned short*)X + idx);
    return make_float4(__uint_as_float(w.x << 16), __uint_as_float(w.x & 0xffff0000u), __uint_as_float(w.y << 16), __uint_as_float(w.y & 0xffff0000u));
}
__device__ __forceinline__ size_t gaddr(const int t, const int e) { return ((((size_t)(t >> 8) * 64 + (size_t)(e >> 8)) * 256 + (size_t)(t & 255)) * 256) + (size_t)(e & 255); }
struct Args {
    const float* in[23];
    float* out; unsigned char* ws;
};

namespace pg8 {
#define PG8_LAS __attribute__((address_space(3)))
typedef unsigned short bf16_t;
typedef short bf16x8 __attribute__((ext_vector_type(8)));
typedef float f32x4 __attribute__((ext_vector_type(4)));
typedef unsigned u32x4 __attribute__((ext_vector_type(4)));
constexpr int BM = 256, BK = 64, HALF = 128, HTB = HALF * BK * 2  , STAGE_BYTES = 8 * HTB, NXCD = 8, WGM = 8;

__host__ __device__ __forceinline__ int lds_byte(int r, int c) { const int st = (r >> 4) * 2 + (c >> 5), rr = r & 15, cc = c & 31, ob = rr * 64 + cc * 2; return st * 1024 + (ob ^ (((ob >> 9) & 1) << 5)); }
__host__ __device__ __forceinline__ void stage_rc(int b, int& R, int& C) { const int st = b / 1024, sb = b % 1024, swz = sb ^ (((sb >> 9) & 1) << 5); R = (st >> 1) * 16 + swz / 64; C = (st & 1) * 32 + (swz % 64) / 2; }
__host__ __device__ __forceinline__ int perm32(int rho) { const int n = rho >> 4, i = rho & 15; return 8 * (i >> 2) + 4 * n + (i & 3); }

struct Unit { int pm, pn; };
struct Gemm { const bf16_t* A; const bf16_t* Bt; int M, N, K, lda, ldb; };

struct StaticOrder {
    int nM, nN, nwg, G, c;
    __host__ __device__ __forceinline__ void init(int M, int N, int G_, int c_) { nM = M / BM; nN = N / BM; nwg = nM * nN; G = G_; c = c_; }
    __host__ __device__ __forceinline__ bool next(int i, Unit& u) const {
        const long L = (long)i * G + c; if (L >= nwg) return false;
        int wgid = (int)L; { const int q = nwg / NXCD, r = nwg % NXCD, xcd = wgid % NXCD, off = wgid / NXCD; wgid = (xcd < r ? xcd * (q + 1) : r * (q + 1) + (xcd - r) * q) + off; }
        const int nig = WGM * nN, gid = wgid / nig, fm = gid * WGM, gsz = (nM - fm) < WGM ? (nM - fm) : WGM;
        u.pm = fm + ((wgid % nig) % gsz); u.pn = (wgid % nig) / gsz; return true;
    }
    __device__ __forceinline__ void a_ready(const Unit&) const {}
    __device__ __forceinline__ void done(const Unit&) const {}
    __device__ __forceinline__ size_t a_byte(const Unit& u, size_t tstep) const { return (size_t)u.pm * tstep; }
    __device__ __forceinline__ size_t b_byte(const Unit& u, size_t tstep) const { return (size_t)u.pn * tstep; }
    __device__ __forceinline__ int ktiles(const Unit&, int nt) const { return nt; }
};
struct BranchOrder {
    StaticOrder base;
    __device__ void init(int M, int N, int G_, int c_) { base.init(M, N, G_, c_); }
    __device__ bool next(int i, Unit& u) const { if (i >= 3) return false; if (!base.next(0, u)) return false; u.pn += 8 * i; return true; }
    __device__ __forceinline__ void a_ready(const Unit&) const {}
    __device__ __forceinline__ void done(const Unit&) const {}
    __device__ __forceinline__ size_t a_byte(const Unit& u, size_t tstep) const { return (size_t)u.pm * tstep + (size_t)((u.pn >> 3) * 768) * 2; }
    __device__ __forceinline__ size_t b_byte(const Unit& u, size_t) const { return ((size_t)(u.pn >> 3) * 2048 + (size_t)(u.pn & 7) * 256) * 768 * 2; }
    __device__ __forceinline__ int ktiles(const Unit& u, int) const { return (u.pn >> 3) < 2 ? 12 : 8; }
};

__device__ __forceinline__ unsigned cvt_pk_bf16(float lo, float hi) { unsigned r; asm volatile("v_cvt_pk_bf16_f32 %0, %1, %2" : "=v"(r) : "v"(lo), "v"(hi)); return r; }
typedef float f32x2 __attribute__((ext_vector_type(2)));
__device__ __forceinline__ f32x2 gelu_pk(f32x2 v) {
    const f32x2 av = __builtin_elementwise_abs(v), d = av * 0.2316418882f + 1.0f;
    f32x2 t; t.x = __builtin_amdgcn_rcpf(d.x); t.y = __builtin_amdgcn_rcpf(d.y);
    f32x2 q = t * 0.5307027145f + (-0.7265760135f); q = q * t + 0.7107068705f; q = q * t + (-0.142248368f); q = q * t + 0.127414796f; q = q * t;
    const f32x2 s = (v * v) * (-0.72134752044f);
    f32x2 e; e.x = __builtin_amdgcn_exp2f(s.x); e.y = __builtin_amdgcn_exp2f(s.y);
    const f32x2 m = v * (q * e), r = v - m;
    f32x2 o; o.x = v.x < 0.f ? m.x : r.x; o.y = v.y < 0.f ? m.y : r.y; return o;
}

template <class Epi, class Sched, bool ALIGN_EPI = false, bool SP2 = false>
__device__ __forceinline__ void gemm_phase(const int tid, PG8_LAS unsigned char* lds, const Gemm g, const Sched& S, const Epi& E) {
    const int wid = __builtin_amdgcn_readfirstlane(tid >> 6), lane = tid & 63, wr = wid >> 2, wc = wid & 3, fr = lane & 15, fq = lane >> 4;
    const int K = g.K, ntK = K / BK;
    unsigned voffA[2], voffB[2];
#pragma unroll
    for (int i = 0; i < 2; ++i) { int R, C; stage_rc(tid * 16 + i * 8192, R, C); const int Rb = Epi::PERM ? ((R & ~31) + perm32(R & 31)) : R;
        voffA[i] = (unsigned)(R * g.lda + C) * 2u; voffB[i] = (unsigned)(Rb * g.ldb + C) * 2u; }
    const size_t kstep = (size_t)(BK * 2);
    const size_t hstepA = (size_t)HALF * g.lda * 2, hstepB = (size_t)HALF * g.ldb * 2;
    const size_t tstepA = 2 * hstepA, tstepB = 2 * hstepB;
    const unsigned ldsw = (unsigned)wid * 1024u;
    const int aoff = lds_byte(wr * 64 + fr, fq * 8), boff = lds_byte(wc * 32 + fr, fq * 8);
#define PG8_SA(b, h) (((b) * 2 + (h)) * HTB)
#define PG8_SB(b, h) ((4 + (b) * 2 + (h)) * HTB)
#define PG8_STAGE(bufoff, gbase, voff) do { _Pragma("unroll") for (int _i = 0; _i < 2; ++_i) \
        __builtin_amdgcn_global_load_lds((const unsigned*)((const char*)(gbase) + (voff)[_i]), (PG8_LAS unsigned*)(lds + (bufoff) + ldsw + _i * 8192), 16, 0, 0); } while (0)
#define PG8_LDA(dst, b, h) do { _Pragma("unroll") for (int m = 0; m < 4; ++m) _Pragma("unroll") for (int k = 0; k < 2; ++k) dst[m][k] = *(const PG8_LAS bf16x8*)(lds + PG8_SA(b, h) + aoff + m * 2048 + k * 1024); } while (0)
#define PG8_LDB(dst, b, h) do { _Pragma("unroll") for (int n = 0; n < 2; ++n) _Pragma("unroll") for (int k = 0; k < 2; ++k) dst[n][k] = *(const PG8_LAS bf16x8*)(lds + PG8_SB(b, h) + boff + n * 2048 + k * 1024); } while (0)
#define PG8_MMA(ai, bj, At, Bt) do { __builtin_amdgcn_s_setprio(1); _Pragma("unroll") for (int m = 0; m < 4; ++m) _Pragma("unroll") for (int n = 0; n < 2; ++n) _Pragma("unroll") for (int k = 0; k < 2; ++k) \
        acc[ai][bj][m][n] = __builtin_amdgcn_mfma_f32_16x16x32_bf16(Bt[n][k], At[m][k], acc[ai][bj][m][n], 0, 0, 0); __builtin_amdgcn_s_setprio(0); } while (0)
#define PG8_WAIT_V(n) asm volatile("s_waitcnt vmcnt(" #n ")" ::: "memory")
#define PG8_WAIT_L(n) asm volatile("s_waitcnt lgkmcnt(" #n ")" ::: "memory")
#define PG8_BAR __builtin_amdgcn_s_barrier()
#define PG8_SCHED __builtin_amdgcn_sched_barrier(0)
    Unit cur, nxt; int ui = 0;
    if (!S.next(0, cur)) return;
    f32x4 acc[2][2][4][2];
#pragma unroll
    for (int a = 0; a < 2; ++a)
#pragma unroll
        for (int b = 0; b < 2; ++b)
#pragma unroll
            for (int m = 0; m < 4; ++m)
#pragma unroll
                for (int n = 0; n < 2; ++n) acc[a][b][m][n] = (f32x4){0.f, 0.f, 0.f, 0.f};
    bf16x8 At[4][2], B0[2][2], B1[2][2];
    const char* cA = (const char*)g.A + S.a_byte(cur, tstepA); const char* cB = (const char*)g.Bt + S.b_byte(cur, tstepB);
    S.a_ready(cur);
    if constexpr (SP2) {
        PG8_STAGE(PG8_SB(0, 0), cB, voffB); PG8_STAGE(PG8_SB(0, 1), cB + hstepB, voffB); PG8_STAGE(PG8_SA(0, 0), cA, voffA); PG8_STAGE(PG8_SA(0, 1), cA + hstepA, voffA);
        if (wr == 1) PG8_BAR;
        PG8_WAIT_V(2); PG8_BAR;
        PG8_STAGE(PG8_SB(1, 0), cB + kstep, voffB); PG8_STAGE(PG8_SA(1, 0), cA + kstep, voffA); PG8_STAGE(PG8_SB(1, 1), cB + hstepB + kstep, voffB);
        PG8_WAIT_V(6); PG8_BAR;
    } else {
        PG8_STAGE(PG8_SB(0, 0), cB, voffB); PG8_STAGE(PG8_SA(0, 0), cA, voffA); PG8_STAGE(PG8_SB(0, 1), cB + hstepB, voffB); PG8_STAGE(PG8_SA(0, 1), cA + hstepA, voffA);
        if (wr == 1) PG8_BAR;
        PG8_WAIT_V(4); PG8_BAR;
        PG8_STAGE(PG8_SB(1, 0), cB + kstep, voffB); PG8_STAGE(PG8_SA(1, 0), cA + kstep, voffA); PG8_STAGE(PG8_SB(1, 1), cB + hstepB + kstep, voffB);
        PG8_WAIT_V(6); PG8_BAR;
    }
    for (;;) {
        const bool has_next = S.next(ui + 1, nxt);
        const char* nA = has_next ? (const char*)g.A + S.a_byte(nxt, tstepA) : cA; const char* nB = has_next ? (const char*)g.Bt + S.b_byte(nxt, tstepB) : cB;
        const int nt = S.ktiles(cur, ntK);
        for (int t = 0; t < nt; t += 2) {
            const bool last = (t == nt - 2);
            const char* a1 = cA + (size_t)(t + 1) * kstep;
            const char* a2 = last ? nA : cA + (size_t)(t + 2) * kstep; const char* b2 = last ? nB : cB + (size_t)(t + 2) * kstep;
            const char* a3 = a2 + kstep; const char* b3 = b2 + kstep;
            if (last && has_next) S.a_ready(nxt);
            if constexpr (SP2) {
            PG8_LDB(B0, 0, 0); PG8_LDB(B1, 0, 1); PG8_SCHED; PG8_LDA(At, 0, 0); PG8_STAGE(PG8_SA(1, 1), a1 + hstepA, voffA);
            PG8_WAIT_V(8); PG8_WAIT_L(0); PG8_BAR; PG8_MMA(0, 0, At, B0); PG8_MMA(0, 1, At, B1); PG8_BAR; PG8_SCHED;
            PG8_LDA(At, 0, 1); PG8_STAGE(PG8_SB(0, 0), b2, voffB); PG8_STAGE(PG8_SB(0, 1), b2 + hstepB, voffB); PG8_STAGE(PG8_SA(0, 0), a2, voffA);
            PG8_WAIT_V(8); PG8_WAIT_L(0); PG8_BAR; PG8_MMA(1, 0, At, B0); PG8_MMA(1, 1, At, B1); PG8_BAR; PG8_SCHED;
            PG8_LDB(B0, 1, 0); PG8_LDB(B1, 1, 1); PG8_SCHED; PG8_LDA(At, 1, 0); PG8_STAGE(PG8_SA(0, 1), a2 + hstepA, voffA);
            PG8_WAIT_V(8); PG8_WAIT_L(0); PG8_BAR; PG8_MMA(0, 0, At, B0); PG8_MMA(0, 1, At, B1); PG8_BAR; PG8_SCHED;
            PG8_LDA(At, 1, 1); PG8_STAGE(PG8_SB(1, 0), b3, voffB); PG8_STAGE(PG8_SB(1, 1), b3 + hstepB, voffB); PG8_STAGE(PG8_SA(1, 0), a3, voffA);
            PG8_WAIT_V(8); PG8_WAIT_L(0); PG8_BAR; PG8_MMA(1, 0, At, B0); PG8_MMA(1, 1, At, B1); PG8_BAR; PG8_SCHED;
            } else {
            PG8_LDB(B0, 0, 0); PG8_SCHED; PG8_LDA(At, 0, 0); PG8_STAGE(PG8_SA(1, 1), a1 + hstepA, voffA);
            PG8_WAIT_L(8); PG8_BAR; PG8_WAIT_L(0); PG8_MMA(0, 0, At, B0); PG8_BAR; PG8_SCHED;
            PG8_LDB(B1, 0, 1); PG8_STAGE(PG8_SB(0, 0), b2, voffB);
            PG8_BAR; PG8_WAIT_L(0); PG8_MMA(0, 1, At, B1); PG8_BAR;
            PG8_LDA(At, 0, 1); PG8_STAGE(PG8_SA(0, 0), a2, voffA);
            PG8_BAR; PG8_WAIT_L(0); PG8_MMA(1, 0, At, B0); PG8_BAR; PG8_SCHED;
            PG8_STAGE(PG8_SB(0, 1), b2 + hstepB, voffB);
            PG8_WAIT_V(6); PG8_BAR; PG8_MMA(1, 1, At, B1); PG8_BAR;
            PG8_LDB(B0, 1, 0); PG8_SCHED; PG8_LDA(At, 1, 0); PG8_STAGE(PG8_SA(0, 1), a2 + hstepA, voffA);
            PG8_WAIT_L(8); PG8_BAR; PG8_WAIT_L(0); PG8_MMA(0, 0, At, B0); PG8_BAR; PG8_SCHED;
            PG8_LDB(B1, 1, 1); PG8_STAGE(PG8_SB(1, 0), b3, voffB);
            PG8_BAR; PG8_WAIT_L(0); PG8_MMA(0, 1, At, B1); PG8_BAR;
            PG8_LDA(At, 1, 1); PG8_STAGE(PG8_SA(1, 0), a3, voffA);
            PG8_BAR; PG8_WAIT_L(0); PG8_MMA(1, 0, At, B0); PG8_BAR; PG8_SCHED;
            PG8_STAGE(PG8_SB(1, 1), b3 + hstepB, voffB);
            PG8_WAIT_V(6); PG8_BAR; PG8_MMA(1, 1, At, B1); PG8_BAR;
            }
        }
        if constexpr (ALIGN_EPI) { if (wr == 0) PG8_BAR; }
        if constexpr (!Epi::AFTER_DRAIN) { E(acc, cur, wr, wc, fr, fq); S.done(cur); }
        if (!has_next) break;
        if constexpr (!Epi::CARRY) {
#pragma unroll
        for (int a = 0; a < 2; ++a)
#pragma unroll
            for (int b = 0; b < 2; ++b)
#pragma unroll
                for (int m = 0; m < 4; ++m)
#pragma unroll
                    for (int n = 0; n < 2; ++n) acc[a][b][m][n] = (f32x4){0.f, 0.f, 0.f, 0.f};
        }
        cur = nxt; cA = nA; cB = nB; ++ui;
        if constexpr (ALIGN_EPI) { if (wr == 1) PG8_BAR; }
    }
    PG8_WAIT_V(0);
    if constexpr (!ALIGN_EPI) { if (wr == 0) PG8_BAR; }
    PG8_BAR;
    if constexpr (Epi::AFTER_DRAIN) { E.fused(acc, cur, wr, wc, fr, fq, lds, wid, lane); S.done(cur); }
#undef PG8_SA
#undef PG8_SB
#undef PG8_STAGE
#undef PG8_LDA
#undef PG8_LDB
#undef PG8_MMA
#undef PG8_WAIT_V
#undef PG8_WAIT_L
#undef PG8_BAR
#undef PG8_SCHED
}

typedef int i32x4 __attribute__((ext_vector_type(4)));
struct Gemm8 { const signed char* A; const signed char* Bt; int M, N, K, lda, ldb; };
template <class Epi, class Sched, bool ALIGN_EPI = false, bool SP2 = false, bool A_TILED = false>
__device__ __forceinline__ void gemm_phase_i8(const int tid, PG8_LAS unsigned char* lds, const Gemm8 g, const Sched& S, const Epi& E) {
    const int wid = __builtin_amdgcn_readfirstlane(tid >> 6), lane = tid & 63, wr = wid >> 2, wc = wid & 3, fr = lane & 15, fq = lane >> 4;
    const int K = g.K, nt = K / 128;
    unsigned voffA[2], voffB[2];
#pragma unroll
    for (int i = 0; i < 2; ++i) { int R, C; stage_rc(tid * 16 + i * 8192, R, C); const int Rb = Epi::PERM ? ((R & ~31) + perm32(R & 31)) : R;
        voffA[i] = (unsigned)(R * g.lda + 2 * C); voffB[i] = (unsigned)(Rb * g.ldb + 2 * C); }
    const size_t kstep = (size_t)128;
    const size_t hstepA = (size_t)HALF * g.lda, hstepB = (size_t)HALF * g.ldb;
    const size_t tstepA = A_TILED ? (size_t)(g.K / 256) * 65536 : 2 * hstepA, tstepB = 2 * hstepB;
    const unsigned ldsw = (unsigned)wid * 1024u;
    const int aoff = lds_byte(wr * 64 + fr, fq * 8), boff = lds_byte(wc * 32 + fr, fq * 8);
#define PG8_SA(b, h) (((b) * 2 + (h)) * HTB)
#define PG8_SB(b, h) ((4 + (b) * 2 + (h)) * HTB)
#define PG8_STAGE(bufoff, gbase, voff) do { _Pragma("unroll") for (int _i = 0; _i < 2; ++_i) \
        __builtin_amdgcn_global_load_lds((const unsigned*)((const char*)(gbase) + (voff)[_i]), (PG8_LAS unsigned*)(lds + (bufoff) + ldsw + _i * 8192), 16, 0, 0); } while (0)
#define PG8_LDA(dst, b, h) do { _Pragma("unroll") for (int m = 0; m < 4; ++m) _Pragma("unroll") for (int k = 0; k < 2; ++k) dst[m][k] = *(const PG8_LAS bf16x8*)(lds + PG8_SA(b, h) + aoff + m * 2048 + k * 1024); } while (0)
#define PG8_LDB(dst, b, h) do { _Pragma("unroll") for (int n = 0; n < 2; ++n) _Pragma("unroll") for (int k = 0; k < 2; ++k) dst[n][k] = *(const PG8_LAS bf16x8*)(lds + PG8_SB(b, h) + boff + n * 2048 + k * 1024); } while (0)
#define PG8_MMA(ai, bj, At, Bt) do { __builtin_amdgcn_s_setprio(1); _Pragma("unroll") for (int m = 0; m < 4; ++m) _Pragma("unroll") for (int n = 0; n < 2; ++n) _Pragma("unroll") for (int k = 0; k < 2; ++k) \
        acc[ai][bj][m][n] = __builtin_amdgcn_mfma_i32_16x16x64_i8(__builtin_bit_cast(i32x4, Bt[n][k]), __builtin_bit_cast(i32x4, At[m][k]), acc[ai][bj][m][n], 0, 0, 0); __builtin_amdgcn_s_setprio(0); } while (0)
#define PG8_WAIT_V(n) asm volatile("s_waitcnt vmcnt(" #n ")" ::: "memory")
#define PG8_WAIT_L(n) asm volatile("s_waitcnt lgkmcnt(" #n ")" ::: "memory")
#define PG8_BAR __builtin_amdgcn_s_barrier()
#define PG8_SCHED __builtin_amdgcn_sched_barrier(0)
    Unit cur, nxt; int ui = 0;
    if (!S.next(0, cur)) return;
    i32x4 acc[2][2][4][2];
#pragma unroll
    for (int a = 0; a < 2; ++a)
#pragma unroll
        for (int b = 0; b < 2; ++b)
#pragma unroll
            for (int m = 0; m < 4; ++m)
#pragma unroll
                for (int n = 0; n < 2; ++n) acc[a][b][m][n] = (i32x4){0, 0, 0, 0};
    bf16x8 At[4][2], B0[2][2], B1[2][2];
    const char* cA = (const char*)g.A + (size_t)cur.pm * tstepA; const char* cB = (const char*)g.Bt + (size_t)cur.pn * tstepB;
    S.a_ready(cur);
    if constexpr (SP2) {
        PG8_STAGE(PG8_SB(0, 0), cB, voffB); PG8_STAGE(PG8_SB(0, 1), cB + hstepB, voffB); PG8_STAGE(PG8_SA(0, 0), cA, voffA); PG8_STAGE(PG8_SA(0, 1), cA + hstepA, voffA);
        if (wr == 1) PG8_BAR;
        PG8_WAIT_V(2); PG8_BAR;
        PG8_STAGE(PG8_SB(1, 0), cB + kstep, voffB); PG8_STAGE(PG8_SA(1, 0), cA + kstep, voffA); PG8_STAGE(PG8_SB(1, 1), cB + hstepB + kstep, voffB);
        PG8_WAIT_V(6); PG8_BAR;
    } else {
        PG8_STAGE(PG8_SB(0, 0), cB, voffB); PG8_STAGE(PG8_SA(0, 0), cA, voffA); PG8_STAGE(PG8_SB(0, 1), cB + hstepB, voffB); PG8_STAGE(PG8_SA(0, 1), cA + hstepA, voffA);
        if (wr == 1) PG8_BAR;
        PG8_WAIT_V(4); PG8_BAR;
        PG8_STAGE(PG8_SB(1, 0), cB + kstep, voffB); PG8_STAGE(PG8_SA(1, 0), cA + kstep, voffA); PG8_STAGE(PG8_SB(1, 1), cB + hstepB + kstep, voffB);
        PG8_WAIT_V(6); PG8_BAR;
    }
    for (;;) {
        const bool has_next = S.next(ui + 1, nxt);
        const char* nA = has_next ? (const char*)g.A + (size_t)nxt.pm * tstepA : cA; const char* nB = has_next ? (const char*)g.Bt + (size_t)nxt.pn * tstepB : cB;
        for (int t = 0; t < nt; t += 2) {
            const bool last = (t == nt - 2);
            const char* a1 = A_TILED ? cA + (size_t)(t >> 1) * 65536 + 128 : cA + (size_t)(t + 1) * kstep;
            const char* a2 = last ? nA : (A_TILED ? cA + (size_t)((t >> 1) + 1) * 65536 : cA + (size_t)(t + 2) * kstep); const char* b2 = last ? nB : cB + (size_t)(t + 2) * kstep;
            const char* a3 = a2 + kstep; const char* b3 = b2 + kstep;
            if (last && has_next) S.a_ready(nxt);
            if constexpr (SP2) {
            PG8_LDB(B0, 0, 0); PG8_LDB(B1, 0, 1); PG8_SCHED; PG8_LDA(At, 0, 0); PG8_STAGE(PG8_SA(1, 1), a1 + hstepA, voffA);
            PG8_WAIT_V(8); PG8_WAIT_L(0); PG8_BAR; PG8_MMA(0, 0, At, B0); PG8_MMA(0, 1, At, B1); PG8_BAR; PG8_SCHED;
            PG8_LDA(At, 0, 1); PG8_STAGE(PG8_SB(0, 0), b2, voffB); PG8_STAGE(PG8_SB(0, 1), b2 + hstepB, voffB); PG8_STAGE(PG8_SA(0, 0), a2, voffA);
            PG8_WAIT_V(8); PG8_WAIT_L(0); PG8_BAR; PG8_MMA(1, 0, At, B0); PG8_MMA(1, 1, At, B1); PG8_BAR; PG8_SCHED;
            PG8_LDB(B0, 1, 0); PG8_LDB(B1, 1, 1); PG8_SCHED; PG8_LDA(At, 1, 0); PG8_STAGE(PG8_SA(0, 1), a2 + hstepA, voffA);
            PG8_WAIT_V(8); PG8_WAIT_L(0); PG8_BAR; PG8_MMA(0, 0, At, B0); PG8_MMA(0, 1, At, B1); PG8_BAR; PG8_SCHED;
            PG8_LDA(At, 1, 1); PG8_STAGE(PG8_SB(1, 0), b3, voffB); PG8_STAGE(PG8_SB(1, 1), b3 + hstepB, voffB); PG8_STAGE(PG8_SA(1, 0), a3, voffA);
            PG8_WAIT_V(8); PG8_WAIT_L(0); PG8_BAR; PG8_MMA(1, 0, At, B0); PG8_MMA(1, 1, At, B1); PG8_BAR; PG8_SCHED;
            } else {
            PG8_LDB(B0, 0, 0); PG8_SCHED; PG8_LDA(At, 0, 0); PG8_STAGE(PG8_SA(1, 1), a1 + hstepA, voffA);
            PG8_WAIT_L(8); PG8_BAR; PG8_WAIT_L(0); PG8_MMA(0, 0, At, B0); PG8_BAR; PG8_SCHED;
            PG8_LDB(B1, 0, 1); PG8_STAGE(PG8_SB(0, 0), b2, voffB);
            PG8_BAR; PG8_WAIT_L(0); PG8_MMA(0, 1, At, B1); PG8_BAR;
            PG8_LDA(At, 0, 1); PG8_STAGE(PG8_SA(0, 0), a2, voffA);
            PG8_BAR; PG8_WAIT_L(0); PG8_MMA(1, 0, At, B0); PG8_BAR; PG8_SCHED;
            PG8_STAGE(PG8_SB(0, 1), b2 + hstepB, voffB);
            PG8_WAIT_V(6); PG8_BAR; PG8_MMA(1, 1, At, B1); PG8_BAR;
            PG8_LDB(B0, 1, 0); PG8_SCHED; PG8_LDA(At, 1, 0); PG8_STAGE(PG8_SA(0, 1), a2 + hstepA, voffA);
            PG8_WAIT_L(8); PG8_BAR; PG8_WAIT_L(0); PG8_MMA(0, 0, At, B0); PG8_BAR; PG8_SCHED;
            PG8_LDB(B1, 1, 1); PG8_STAGE(PG8_SB(1, 0), b3, voffB);
            PG8_BAR; PG8_WAIT_L(0); PG8_MMA(0, 1, At, B1); PG8_BAR;
            PG8_LDA(At, 1, 1); PG8_STAGE(PG8_SA(1, 0), a3, voffA);
            PG8_BAR; PG8_WAIT_L(0); PG8_MMA(1, 0, At, B0); PG8_BAR; PG8_SCHED;
            PG8_STAGE(PG8_SB(1, 1), b3 + hstepB, voffB);
            PG8_WAIT_V(6); PG8_BAR; PG8_MMA(1, 1, At, B1); PG8_BAR;
            }
        }
        if constexpr (ALIGN_EPI) { if (wr == 0) PG8_BAR; }
        if constexpr (!Epi::AFTER_DRAIN) { E(acc, cur, wr, wc, fr, fq); S.done(cur); }
        if (!has_next) break;
#pragma unroll
        for (int a = 0; a < 2; ++a)
#pragma unroll
            for (int b = 0; b < 2; ++b)
#pragma unroll
                for (int m = 0; m < 4; ++m)
#pragma unroll
                    for (int n = 0; n < 2; ++n) acc[a][b][m][n] = (i32x4){0, 0, 0, 0};
        cur = nxt; cA = nA; cB = nB; ++ui;
        if constexpr (ALIGN_EPI) { if (wr == 1) PG8_BAR; }
    }
    PG8_WAIT_V(0);
    if constexpr (!ALIGN_EPI) { if (wr == 0) PG8_BAR; }
    PG8_BAR;
    if constexpr (Epi::AFTER_DRAIN) { E.fused(acc, cur, wr, wc, fr, fq, lds, wid, lane); S.done(cur); }
#undef PG8_SA
#undef PG8_SB
#undef PG8_STAGE
#undef PG8_LDA
#undef PG8_LDB
#undef PG8_MMA
#undef PG8_WAIT_V
#undef PG8_WAIT_L
#undef PG8_BAR
#undef PG8_SCHED
}

}

__device__ __forceinline__ unsigned pk_i8x4(float a, float b, float c, float d) {
    const int ia = (int)rintf(a), ib = (int)rintf(b), ic = (int)rintf(c), id = (int)rintf(d);
    return ((unsigned)ia & 0xffu) | (((unsigned)ib & 0xffu) << 8) | (((unsigned)ic & 0xffu) << 16) | (((unsigned)id & 0xffu) << 24); }
__device__ __forceinline__ float wave_max(float v) {
    v = fmaxf(v, SWZ_XOR(v, 1)); v = fmaxf(v, SWZ_XOR(v, 2)); v = fmaxf(v, SWZ_XOR(v, 4)); v = fmaxf(v, SWZ_XOR(v, 8)); v = fmaxf(v, SWZ_XOR(v, 16));
    auto rr = __builtin_amdgcn_permlane32_swap(__float_as_uint(v), __float_as_uint(v), false, false); return fmaxf(__uint_as_float(rr[0]), __uint_as_float(rr[1])); }
typedef unsigned short bf16_t;

struct EpiProj {
    static constexpr bool PERM = true, AFTER_DRAIN = false;
    bf16_t* ATT; bf16_t* GATES; const float* ROPE; const float* SH; const float* SW; unsigned* KINF;
    template <int MODE, bool KT>
    __device__ __forceinline__ void run(const pg8::i32x4 (&acc)[2][2][4][2], const pg8::Unit& u, int wr, int wc, int fr, int fq) const {
        using pg8::f32x4; using pg8::u32x4; using pg8::cvt_pk_bf16;
        const int row0 = u.pm * 256 + wr * 64 + fr, pn = u.pn;
        float mxk[2] = {0.f, 0.f};
        bf16_t* base = (MODE == 2) ? GATES : ATT; const int colt = (MODE == 2) ? (pn - 24) * 256 : pn * 256;
        float shr[2][4]; f32x4 sw[2][2];
#pragma unroll
        for (int ai = 0; ai < 2; ++ai)
#pragma unroll
            for (int m = 0; m < 4; ++m) shr[ai][m] = SH[row0 + ai * 128 + m * 16];
#pragma unroll
        for (int bj = 0; bj < 2; ++bj) { const int ncol = pn * 256 + bj * 128 + wc * 32 + 8 * fq; sw[bj][0] = *(const f32x4*)(SW + ncol); sw[bj][1] = *(const f32x4*)(SW + ncol + 4); }
#pragma unroll
        for (int ai = 0; ai < 2; ++ai)
#pragma unroll
            for (int m = 0; m < 4; ++m) { const int row = row0 + ai * 128 + m * 16;
#pragma unroll
                for (int bj = 0; bj < 2; ++bj) { const int col = colt + bj * 128 + wc * 32 + 8 * fq;
                    const pg8::i32x4 i0 = acc[ai][bj][m][0], i1 = acc[ai][bj][m][1]; const f32x4 w0 = sw[bj][0] * shr[ai][m], w1 = sw[bj][1] * shr[ai][m];
                    f32x4 v0 = {(float)i0[0] * w0[0], (float)i0[1] * w0[1], (float)i0[2] * w0[2], (float)i0[3] * w0[3]}, v1 = {(float)i1[0] * w1[0], (float)i1[1] * w1[1], (float)i1[2] * w1[2], (float)i1[3] * w1[3]};
                    if constexpr (MODE == 1) { const int j = (col & 63) >> 3; const f32x4 cs0 = *(const f32x4*)(ROPE + (size_t)row * 64 + 8 * j), cs1 = *(const f32x4*)(ROPE + (size_t)row * 64 + 8 * j + 4);
                        f32x4 y0, y1;
                        y0[0] = v0[0] * cs0[0] - v1[0] * cs0[1]; y1[0] = v0[0] * cs0[1] + v1[0] * cs0[0];
                        y0[1] = v0[1] * cs0[2] - v1[1] * cs0[3]; y1[1] = v0[1] * cs0[3] + v1[1] * cs0[2];
                        y0[2] = v0[2] * cs1[0] - v1[2] * cs1[1]; y1[2] = v0[2] * cs1[1] + v1[2] * cs1[0];
                        y0[3] = v0[3] * cs1[2] - v1[3] * cs1[3]; y1[3] = v0[3] * cs1[3] + v1[3] * cs1[2];
                        v0 = y0; v1 = y1; }
                    if constexpr (MODE == 2) {
#pragma unroll
                        for (int e = 0; e < 4; ++e) { v0[e] = fminf(1.f + __expf(-v0[e]), 1e12f); v1[e] = fminf(1.f + __expf(-v1[e]), 1e12f); } }
                    if constexpr (KT) mxk[bj] = fmaxf(fmaxf(mxk[bj], fmaxf(fmaxf(fabsf(v0[0]), fabsf(v0[1])), fmaxf(fabsf(v0[2]), fabsf(v0[3])))), fmaxf(fmaxf(fabsf(v1[0]), fabsf(v1[1])), fmaxf(fabsf(v1[2]), fabsf(v1[3]))));
                    u32x4 w; w.x = cvt_pk_bf16(v0[0], v0[1]); w.y = cvt_pk_bf16(v0[2], v0[3]); w.z = cvt_pk_bf16(v1[0], v1[1]); w.w = cvt_pk_bf16(v1[2], v1[3]);
                    *(u32x4*)(base + (size_t)row * 6144 + col) = w; } }
        if constexpr (KT) {
#pragma unroll
            for (int bj = 0; bj < 2; ++bj) { const float mw = wave_max(mxk[bj]); if (fr == 0 && fq == 0) atomicMax(KINF + ((u.pm * 256) / SEQ) * 8 + 2 * (pn - 3) + bj, __float_as_uint(mw)); } }
    }
    __device__ __forceinline__ void operator()(const pg8::i32x4 (&acc)[2][2][4][2], const pg8::Unit& u, int wr, int wc, int fr, int fq) const {
        const int pn = u.pn;
        if (pn >= 24) run<2, false>(acc, u, wr, wc, fr, fq);
        else if (pn >= 18 && pn < 22) run<1, false>(acc, u, wr, wc, fr, fq);
        else if (pn >= 3 && pn < 6) run<0, true>(acc, u, wr, wc, fr, fq);
        else run<0, false>(acc, u, wr, wc, fr, fq);
    }
};

template <int MODE> struct EpiBranch {
    static constexpr bool PERM = false, AFTER_DRAIN = false, CARRY = false;
    float* YP; bf16_t* YB; const bf16_t* GATES; int gcol;
    __device__ __forceinline__ void operator()(const pg8::f32x4 (&acc)[2][2][4][2], const pg8::Unit& u, int wr, int wc, int fr, int fq) const {
        using pg8::f32x4;
        const int row0 = u.pm * 256 + wr * 64 + fr, col0 = u.pn * 256 + wc * 32 + 4 * fq;
#pragma unroll
        for (int ai = 0; ai < 2; ++ai)
#pragma unroll
            for (int m = 0; m < 4; ++m) { const size_t row = row0 + ai * 128 + m * 16;
#pragma unroll
                for (int bj = 0; bj < 2; ++bj)
#pragma unroll
                    for (int n = 0; n < 2; ++n) { const int col = col0 + bj * 128 + n * 16; const uint2 gw2 = *(const uint2*)(GATES + row * 6144 + gcol + col);
                        f32x4 g; g[0] = __uint_as_float(gw2.x << 16); g[1] = __uint_as_float(gw2.x & 0xffff0000u); g[2] = __uint_as_float(gw2.y << 16); g[3] = __uint_as_float(gw2.y & 0xffff0000u);
                        f32x4 v = g * acc[ai][bj][m][n]; float* yp = YP + row * DM + col;
                        if (MODE >= 1) v = v + *(const f32x4*)yp;
                        if (MODE <= 1) *(f32x4*)yp = v;
                        else { uint2 w; w.x = pg8::cvt_pk_bf16(v[0], v[1]); w.y = pg8::cvt_pk_bf16(v[2], v[3]); *(uint2*)(YB + row * DM + col) = w; } } }
    }
};
struct EpiBranchAll {
    static constexpr bool PERM = false, AFTER_DRAIN = false, CARRY = false;
    float* YP; bf16_t* YB; const bf16_t* GATES;
    __device__ __forceinline__ void operator()(const pg8::f32x4 (&acc)[2][2][4][2], const pg8::Unit& u, int wr, int wc, int fr, int fq) const {
        const pg8::Unit v{u.pm, u.pn & 7}; const int br = u.pn >> 3;
        if (br == 0) { EpiBranch<0> e{YP, YB, GATES, 0}; e(acc, v, wr, wc, fr, fq); }
        else if (br == 1) { EpiBranch<1> e{YP, YB, GATES, 2048}; e(acc, v, wr, wc, fr, fq); }
        else { EpiBranch<2> e{YP, YB, GATES, 4096}; e(acc, v, wr, wc, fr, fq); }
    }
};
struct EpiBranchCarry {
    static constexpr bool PERM = false, AFTER_DRAIN = false, CARRY = true;
    bf16_t* YB; const bf16_t* GATES;
    static __device__ __forceinline__ pg8::f32x4 gate4(const uint2 w) { pg8::f32x4 g; g[0] = __uint_as_float(w.x << 16); g[1] = __uint_as_float(w.x & 0xffff0000u); g[2] = __uint_as_float(w.y << 16); g[3] = __uint_as_float(w.y & 0xffff0000u); return g; }
    __device__ __forceinline__ void operator()(pg8::f32x4 (&acc)[2][2][4][2], const pg8::Unit& u, int wr, int wc, int fr, int fq) const {
        using pg8::f32x4;
        const int br = u.pn >> 3, row0 = u.pm * 256 + wr * 64 + fr, col0 = (u.pn & 7) * 256 + wc * 32 + 4 * fq; const bf16_t* ga = GATES + br * 2048;
        if (br < 2) {
#pragma unroll
            for (int ai = 0; ai < 2; ++ai) { uint2 gq[4][2][2], hq[4][2][2];
#pragma unroll
                for (int m = 0; m < 4; ++m) { const size_t row = row0 + ai * 128 + m * 16;
#pragma unroll
                    for (int bj = 0; bj < 2; ++bj)
#pragma unroll
                        for (int n = 0; n < 2; ++n) { const int col = col0 + bj * 128 + n * 16; gq[m][bj][n] = *(const uint2*)(ga + row * 6144 + col); hq[m][bj][n] = *(const uint2*)(ga + row * 6144 + 2048 + col); } }
                asm volatile("" ::: "memory");
#pragma unroll
                for (int m = 0; m < 4; ++m)
#pragma unroll
                    for (int bj = 0; bj < 2; ++bj)
#pragma unroll
                        for (int n = 0; n < 2; ++n) { const f32x4 g = gate4(gq[m][bj][n]), h = gate4(hq[m][bj][n]);
                            f32x4 r; r[0] = h[0] * __builtin_amdgcn_rcpf(g[0]); r[1] = h[1] * __builtin_amdgcn_rcpf(g[1]); r[2] = h[2] * __builtin_amdgcn_rcpf(g[2]); r[3] = h[3] * __builtin_amdgcn_rcpf(g[3]);
                            acc[ai][bj][m][n] = acc[ai][bj][m][n] * r; } }
        } else {
#pragma unroll
            for (int ai = 0; ai < 2; ++ai) { uint2 gq[4][2][2];
#pragma unroll
                for (int m = 0; m < 4; ++m) { const size_t row = row0 + ai * 128 + m * 16;
#pragma unroll
                    for (int bj = 0; bj < 2; ++bj)
#pragma unroll
                        for (int n = 0; n < 2; ++n) gq[m][bj][n] = *(const uint2*)(ga + row * 6144 + col0 + bj * 128 + n * 16); }
                asm volatile("" ::: "memory");
#pragma unroll
                for (int m = 0; m < 4; ++m) { const size_t row = row0 + ai * 128 + m * 16;
#pragma unroll
                    for (int bj = 0; bj < 2; ++bj)
#pragma unroll
                        for (int n = 0; n < 2; ++n) { const int col = col0 + bj * 128 + n * 16; const f32x4 e4 = gate4(gq[m][bj][n]), a4 = acc[ai][bj][m][n]; const f32x4 v = {a4[0] * __builtin_amdgcn_rcpf(e4[0]), a4[1] * __builtin_amdgcn_rcpf(e4[1]), a4[2] * __builtin_amdgcn_rcpf(e4[2]), a4[3] * __builtin_amdgcn_rcpf(e4[3])};
                            uint2 w; w.x = pg8::cvt_pk_bf16(v[0], v[1]); w.y = pg8::cvt_pk_bf16(v[2], v[3]); *(uint2*)(YB + row * DM + col) = w; } } }
        }
    }
};
struct EpiResidM {
    static constexpr bool PERM = false, AFTER_DRAIN = false, CARRY = false;
    bf16_t* X; const float* gt; const void* Xb; bool xb_f32;
    __device__ __forceinline__ void operator()(const pg8::f32x4 (&acc)[2][2][4][2], const pg8::Unit& u, int wr, int wc, int fr, int fq) const {
        using pg8::f32x4;
        const int row0 = u.pm * 256 + wr * 64 + fr, col0 = u.pn * 256 + wc * 32 + 4 * fq; const float* gtb = gt + (size_t)((u.pm * 256) / SEQ) * NMOD;
        f32x4 g4[2][2];
#pragma unroll
        for (int bj = 0; bj < 2; ++bj)
#pragma unroll
            for (int n = 0; n < 2; ++n) g4[bj][n] = *(const f32x4*)(gtb + col0 + bj * 128 + n * 16);
#pragma unroll
        for (int ai = 0; ai < 2; ++ai) { float4 xq[4][2][2];
#pragma unroll
            for (int m = 0; m < 4; ++m) { const size_t row = row0 + ai * 128 + m * 16;
#pragma unroll
                for (int bj = 0; bj < 2; ++bj)
#pragma unroll
                    for (int n = 0; n < 2; ++n) xq[m][bj][n] = ldx4(Xb, xb_f32, row * DM + col0 + bj * 128 + n * 16); }
            asm volatile("" ::: "memory");
#pragma unroll
            for (int m = 0; m < 4; ++m) { const size_t row = row0 + ai * 128 + m * 16;
#pragma unroll
                for (int bj = 0; bj < 2; ++bj)
#pragma unroll
                    for (int n = 0; n < 2; ++n) { const float4 xb = xq[m][bj][n]; const f32x4 g = g4[bj][n], a = acc[ai][bj][m][n];
                        uint2 w; w.x = pg8::cvt_pk_bf16(xb.x + g[0] * a[0], xb.y + g[1] * a[1]); w.y = pg8::cvt_pk_bf16(xb.z + g[2] * a[2], xb.w + g[3] * a[3]);
                        *(uint2*)(X + row * DM + col0 + bj * 128 + n * 16) = w; } } }
    }
};
struct EpiStoreF32 {
    static constexpr bool PERM = false, AFTER_DRAIN = false, CARRY = false;
    float* C; int ldc;
    __device__ __forceinline__ void operator()(const pg8::f32x4 (&acc)[2][2][4][2], const pg8::Unit& u, int wr, int wc, int fr, int fq) const {
        const int row0 = u.pm * 256 + wr * 64 + fr, col0 = u.pn * 256 + wc * 32 + 4 * fq;
#pragma unroll
        for (int ai = 0; ai < 2; ++ai)
#pragma unroll
            for (int m = 0; m < 4; ++m) { const size_t row = row0 + ai * 128 + m * 16;
#pragma unroll
                for (int bj = 0; bj < 2; ++bj)
#pragma unroll
                    for (int n = 0; n < 2; ++n) *(pg8::f32x4*)(C + row * ldc + col0 + bj * 128 + n * 16) = acc[ai][bj][m][n]; }
    }
};

__device__ __forceinline__ int win_src_col(int n) {
    if (n >= 6144) return n + 6;
    if (n >= C_DQ && n < C_DV) { const int p = n & 63, base = n & ~63, j = p >> 3, m = p & 3, hi = (p >> 2) & 1; return base + (hi ? 32 : 0) + 4 * j + m; }
    return n;
}
__device__ __forceinline__ void transpose_item_win8(const float* W, signed char* WT, const unsigned* cmax, float* scr, int kb, int nb, int lane) {
    const int k0 = 64 * kb, n0 = 32 * nb; const int sc = win_src_col(n0 + (lane & 31)); const float q = 127.f / fmaxf(__uint_as_float(cmax[n0 + (lane & 31)]), 1e-30f);
#pragma unroll
    for (int i = 0; i < 32; ++i) { const int kk = 2 * i + (lane >> 5); scr[kk * 33 + (lane & 31)] = W[(size_t)(k0 + kk) * INW + sc] * q; }
    const int c = lane & 7;
#pragma unroll
    for (int j = 0; j < 4; ++j) { const int n = (lane >> 3) + 8 * j; const float* sp = scr + (8 * c) * 33 + n;
        uint2 o; o.x = pk_i8x4(sp[0 * 33], sp[1 * 33], sp[2 * 33], sp[3 * 33]); o.y = pk_i8x4(sp[4 * 33], sp[5 * 33], sp[6 * 33], sp[7 * 33]);
        *(uint2*)(WT + (size_t)(n0 + n) * DM + k0 + 8 * c) = o; }
}
struct EpiPeerHid {
    static constexpr bool PERM = true, AFTER_DRAIN = false;
    const unsigned char* Sm; const float* SH; const float* SU; float* HID;
    __device__ __forceinline__ void operator()(const pg8::i32x4 (&acc)[2][2][4][2], const pg8::Unit& u, int wr, int wc, int fr, int fq) const {
        using pg8::f32x4;
        const int row0 = u.pm * 256 + wr * 64 + fr, col0 = u.pn * 256 + wc * 32 + 8 * fq;
        f32x4 su[2][2];
#pragma unroll
        for (int bj = 0; bj < 2; ++bj) { su[bj][0] = *(const f32x4*)(SU + col0 + bj * 128); su[bj][1] = *(const f32x4*)(SU + col0 + bj * 128 + 4); }
        uint2 w[2][4][2]; float shr[2][4];
#pragma unroll
        for (int ai = 0; ai < 2; ++ai)
#pragma unroll
            for (int m = 0; m < 4; ++m) { const size_t row = row0 + ai * 128 + m * 16; shr[ai][m] = SH[row];
#pragma unroll
                for (int bj = 0; bj < 2; ++bj) w[ai][m][bj] = *(const uint2*)(Sm + (((size_t)u.pm * 64 + u.pn) * 256 + (row & 255)) * 256 + (col0 & 255) + bj * 128); }
#pragma unroll
        for (int ai = 0; ai < 2; ++ai)
#pragma unroll
            for (int m = 0; m < 4; ++m) { const size_t row = row0 + ai * 128 + m * 16;
#pragma unroll
                for (int bj = 0; bj < 2; ++bj) { const uint2 ww = w[ai][m][bj];
                    if ((ww.x | ww.y) != 0u) {
                        const pg8::i32x4 v0 = acc[ai][bj][m][0], v1 = acc[ai][bj][m][1];
                        const int hv[8] = {v0[0], v0[1], v0[2], v0[3], v1[0], v1[1], v1[2], v1[3]};
                        const float sc[8] = {su[bj][0][0], su[bj][0][1], su[bj][0][2], su[bj][0][3], su[bj][1][0], su[bj][1][1], su[bj][1][2], su[bj][1][3]};
#pragma unroll
                        for (int e = 0; e < 8; ++e) { const unsigned sb = ((e < 4 ? ww.x : ww.y) >> (8 * (e & 3))) & 0xffu;
                            if (sb != 0u) HID[row * PE_E + (sb - 1u)] = (float)hv[e] * shr[ai][m] * sc[e]; } } } }
    }
};
struct EpiStoreI8 {
    static constexpr bool PERM = false, AFTER_DRAIN = false;
    float* C; int ldc; const float* SH; const float* SC;
    __device__ __forceinline__ void operator()(const pg8::i32x4 (&acc)[2][2][4][2], const pg8::Unit& u, int wr, int wc, int fr, int fq) const {
        using pg8::f32x4;
        const int row0 = u.pm * 256 + wr * 64 + fr, col0 = u.pn * 256 + wc * 32 + 4 * fq;
        float sh[2][4]; f32x4 sc[2][2];
#pragma unroll
        for (int ai = 0; ai < 2; ++ai)
#pragma unroll
            for (int m = 0; m < 4; ++m) sh[ai][m] = SH[row0 + ai * 128 + m * 16];
#pragma unroll
        for (int bj = 0; bj < 2; ++bj)
#pragma unroll
            for (int n = 0; n < 2; ++n) sc[bj][n] = *(const f32x4*)(SC + col0 + bj * 128 + n * 16);
        asm volatile("" ::: "memory");
#pragma unroll
        for (int ai = 0; ai < 2; ++ai)
#pragma unroll
            for (int m = 0; m < 4; ++m) { const size_t row = row0 + ai * 128 + m * 16;
#pragma unroll
                for (int bj = 0; bj < 2; ++bj)
#pragma unroll
                    for (int n = 0; n < 2; ++n) { const int col = col0 + bj * 128 + n * 16; const pg8::i32x4 a = acc[ai][bj][m][n]; const f32x4 q = sc[bj][n] * sh[ai][m];
                        *(f32x4*)(C + row * ldc + col) = (f32x4){(float)a[0] * q[0], (float)a[1] * q[1], (float)a[2] * q[2], (float)a[3] * q[3]}; } }
    }
};
struct EpiResidI8 {
    static constexpr bool PERM = false, AFTER_DRAIN = false;
    bf16_t* X; const float* gt; const float* SA;
    __device__ __forceinline__ void operator()(const pg8::i32x4 (&acc)[2][2][4][2], const pg8::Unit& u, int wr, int wc, int fr, int fq) const {
        using pg8::f32x4;
        const int row0 = u.pm * 256 + wr * 64 + fr, col0 = u.pn * 256 + wc * 32 + 4 * fq; const float* gtb = gt + (size_t)((u.pm * 256) / SEQ) * NMOD;
        f32x4 g4[2][2];
#pragma unroll
        for (int bj = 0; bj < 2; ++bj)
#pragma unroll
            for (int n = 0; n < 2; ++n) g4[bj][n] = *(const f32x4*)(gtb + col0 + bj * 128 + n * 16);
#pragma unroll
        for (int ai = 0; ai < 2; ++ai) { uint2 xw[4][2][2]; float sa[4];
#pragma unroll
            for (int m = 0; m < 4; ++m) { const size_t row = row0 + ai * 128 + m * 16; sa[m] = SA[row];
#pragma unroll
                for (int bj = 0; bj < 2; ++bj)
#pragma unroll
                    for (int n = 0; n < 2; ++n) xw[m][bj][n] = *(const uint2*)(X + row * DM + col0 + bj * 128 + n * 16); }
            asm volatile("" ::: "memory");
#pragma unroll
            for (int m = 0; m < 4; ++m) { const size_t row = row0 + ai * 128 + m * 16;
#pragma unroll
                for (int bj = 0; bj < 2; ++bj)
#pragma unroll
                    for (int n = 0; n < 2; ++n) { const pg8::i32x4 a = acc[ai][bj][m][n]; const uint2 xq = xw[m][bj][n]; const f32x4 g = g4[bj][n]; const float s_ = sa[m];
                        uint2 w; w.x = pg8::cvt_pk_bf16(__uint_as_float(xq.x << 16) + g[0] * ((float)a[0] * s_), __uint_as_float(xq.x & 0xffff0000u) + g[1] * ((float)a[1] * s_));
                        w.y = pg8::cvt_pk_bf16(__uint_as_float(xq.y << 16) + g[2] * ((float)a[2] * s_), __uint_as_float(xq.y & 0xffff0000u) + g[3] * ((float)a[3] * s_));
                        *(uint2*)(X + row * DM + col0 + bj * 128 + n * 16) = w; } } }
    }
};

template <bool MAPW>
__device__ __forceinline__ void transpose_item(const float* W, int ldw, bf16_t* WT, int K, float* scr, int kb, int nb, int lane) {
    const int k0 = 64 * kb, n0 = 32 * nb; const int sc = MAPW ? win_src_col(n0 + (lane & 31)) : (n0 + (lane & 31));
#pragma unroll
    for (int i = 0; i < 32; ++i) { const int kk = 2 * i + (lane >> 5); scr[kk * 33 + (lane & 31)] = ldnt1(W + (size_t)(k0 + kk) * ldw + sc); }
    const int c = lane & 7;
#pragma unroll
    for (int j = 0; j < 4; ++j) { const int n = (lane >> 3) + 8 * j; const float* sp = scr + (8 * c) * 33 + n;
        pg8::u32x4 o; o.x = pg8::cvt_pk_bf16(sp[0 * 33], sp[1 * 33]); o.y = pg8::cvt_pk_bf16(sp[2 * 33], sp[3 * 33]); o.z = pg8::cvt_pk_bf16(sp[4 * 33], sp[5 * 33]); o.w = pg8::cvt_pk_bf16(sp[6 * 33], sp[7 * 33]);
        *(pg8::u32x4*)(WT + (size_t)(n0 + n) * K + k0 + 8 * c) = o; }
}

namespace att {
typedef short bf16x8 __attribute__((ext_vector_type(8)));
typedef short s16x4 __attribute__((ext_vector_type(4)));
typedef float f32x16 __attribute__((ext_vector_type(16)));
typedef float f32x4 __attribute__((ext_vector_type(4)));
typedef unsigned u32x4 __attribute__((ext_vector_type(4)));
constexpr int SHM_K = 16384, SHM_V = 16384;
constexpr int OFF_V = 0, OFF_K = 2 * SHM_V, OFF_CK = 2 * SHM_V + 2 * SHM_K, OFF_WS = OFF_CK + 512, OFF_Q = OFF_WS + 8 * 64 * 4, LDS_ATT = OFF_Q + 8 * 8 * 1024;
constexpr float LOG2E = 1.4426950408889634f;
#define KSWZ(row, colB) ((row) * 256 + ((colB) ^ (((row) & 7) << 4)))
#define SBAR() __builtin_amdgcn_sched_barrier(0)
__device__ __forceinline__ int v_st(int k, int c) { const int kk = (k & ~0xC) | ((k & 4) << 1) | ((k & 8) >> 1); return ((kk >> 3) * 4 + (c >> 5)) * 512 + ((kk & 7) * 32 + (c & 31)) * 2; }
__device__ __forceinline__ int v_rd_base(int lane) { return ((lane & 3) << 3) | (((lane >> 2) & 3) << 6) | (((lane >> 4) & 1) << 5) | (((lane >> 5) & 1) << 8); }
constexpr int v_rd_off(int d0, int ks, int half) { return d0 * 512 + ks * 4096 + half * 2048; }
__device__ __forceinline__ int crow(int r, int hi) { return (r & 3) + 8 * (r >> 2) + 4 * hi; }
__device__ __forceinline__ unsigned cvtpk(float lo, float hi) { unsigned r; asm volatile("v_cvt_pk_bf16_f32 %0, %1, %2" : "=v"(r) : "v"(lo), "v"(hi)); return r; }
__device__ __forceinline__ float psum2(float v) { auto rr = __builtin_amdgcn_permlane32_swap(__float_as_uint(v), __float_as_uint(v), false, false); return __uint_as_float(rr[0]) + __uint_as_float(rr[1]); }
__device__ __forceinline__ float pmax2(float v) { auto rr = __builtin_amdgcn_permlane32_swap(__float_as_uint(v), __float_as_uint(v), false, false); return fmaxf(__uint_as_float(rr[0]), __uint_as_float(rr[1])); }

template <int KB, int D0, int D1>
__device__ __forceinline__ void qkt(f32x16& p0, f32x16& p1, const char* K_lds, int r32, int hi, const char* qr) {
    p0 = f32x16{}; p1 = f32x16{};
    const char* kb[4];
#pragma unroll
    for (int dd = 0; dd < 4; ++dd) kb[dd] = K_lds + KB * SHM_K + KSWZ(r32, (dd * 16 + hi * 8) * 2);
#pragma unroll
    for (int d0 = D0; d0 < D1; ++d0) { const char* a = kb[d0 & 3] + (d0 >> 2) * 128;
        bf16x8 b0 = *reinterpret_cast<const bf16x8*>(a);
        bf16x8 b1 = *reinterpret_cast<const bf16x8*>(a + 32 * 256);
        const bf16x8 qf = *reinterpret_cast<const bf16x8*>(qr + d0 * 1024);
        p0 = __builtin_amdgcn_mfma_f32_32x32x16_bf16(b0, qf, p0, 0, 0, 0);
        p1 = __builtin_amdgcn_mfma_f32_32x32x16_bf16(b1, qf, p1, 0, 0, 0); }
}
template <int VB>
__device__ __forceinline__ void pv_tile(f32x16* o, int vb0, bf16x8 pa0, bf16x8 pa1, bf16x8 pa2, bf16x8 pa3) {
#define TRRD(dst, off) asm volatile("ds_read_b64_tr_b16 %0, %1 offset:%2" : "=&v"(dst) : "v"(vb0), "i"(off) : "memory")
#define PV_D0(d0) do { s16x4 l0, l1, l2, l3, h0, h1, h2, h3; constexpr int b_ = VB * SHM_V + v_rd_off(d0, 0, 0); \
        TRRD(l0, b_); TRRD(h0, b_ + 2048); TRRD(l1, b_ + 4096); TRRD(h1, b_ + 6144); TRRD(l2, b_ + 8192); TRRD(h2, b_ + 10240); TRRD(l3, b_ + 12288); TRRD(h3, b_ + 14336); \
        asm volatile("s_waitcnt lgkmcnt(0)" ::: "memory"); SBAR(); \
        o[d0] = __builtin_amdgcn_mfma_f32_32x32x16_bf16(pa0, (bf16x8){l0[0], l0[1], l0[2], l0[3], h0[0], h0[1], h0[2], h0[3]}, o[d0], 0, 0, 0); \
        o[d0] = __builtin_amdgcn_mfma_f32_32x32x16_bf16(pa1, (bf16x8){l1[0], l1[1], l1[2], l1[3], h1[0], h1[1], h1[2], h1[3]}, o[d0], 0, 0, 0); \
        o[d0] = __builtin_amdgcn_mfma_f32_32x32x16_bf16(pa2, (bf16x8){l2[0], l2[1], l2[2], l2[3], h2[0], h2[1], h2[2], h2[3]}, o[d0], 0, 0, 0); \
        o[d0] = __builtin_amdgcn_mfma_f32_32x32x16_bf16(pa3, (bf16x8){l3[0], l3[1], l3[2], l3[3], h3[0], h3[1], h3[2], h3[3]}, o[d0], 0, 0, 0); } while (0)
    PV_D0(0); PV_D0(1); PV_D0(2); PV_D0(3);
#undef PV_D0
#undef TRRD
}
__device__ __forceinline__ void pack_p(const f32x16& p0, const f32x16& p1, bf16x8& pa0, bf16x8& pa1, bf16x8& pa2, bf16x8& pa3) {
#define PK4(P, B_, OUT) do { unsigned a0 = cvtpk(P[B_+0], P[B_+1]), a1 = cvtpk(P[B_+2], P[B_+3]); \
        unsigned b0 = cvtpk(P[B_+4], P[B_+5]), b1 = cvtpk(P[B_+6], P[B_+7]); \
        auto r0 = __builtin_amdgcn_permlane32_swap(a0, b0, false, false); auto r1 = __builtin_amdgcn_permlane32_swap(a1, b1, false, false); \
        u32x4 w = {r0[0], r1[0], r0[1], r1[1]}; OUT = *reinterpret_cast<bf16x8*>(&w); } while (0)
    PK4(p0, 0, pa0); PK4(p0, 8, pa1); PK4(p1, 0, pa2); PK4(p1, 8, pa3);
#undef PK4
}
__device__ __forceinline__ void mask_tile(f32x16& p0, f32x16& p1, int dq) {
    const float NEG = -__builtin_inff();
#pragma unroll
    for (int r = 0; r < 16; ++r) { const int c = (r & 3) + 8 * (r >> 2); if (dq - c < 0) p0[r] = NEG; if (dq - c - 32 < 0) p1[r] = NEG; }
}
constexpr float THR2 = 11.5f;
__device__ __forceinline__ float softmax_step(f32x16& p0, f32x16& p1, float& m_reg, float& l_reg) {
    float pmax = p0[0];
#pragma unroll
    for (int r = 1; r < 16; ++r) pmax = fmaxf(pmax, p0[r]);
#pragma unroll
    for (int r = 0; r < 16; ++r) pmax = fmaxf(pmax, p1[r]);
    pmax = pmax2(pmax);
    float alpha = 1.f;
    if (!__all(pmax - m_reg <= THR2)) { const float mn = fmaxf(m_reg, pmax); alpha = __builtin_amdgcn_exp2f(m_reg - mn); m_reg = mn; }
    float ps = 0.f;
#pragma unroll
    for (int r = 0; r < 16; ++r) { p0[r] = __builtin_amdgcn_exp2f(p0[r] - m_reg); ps += p0[r]; }
#pragma unroll
    for (int r = 0; r < 16; ++r) { p1[r] = __builtin_amdgcn_exp2f(p1[r] - m_reg); ps += p1[r]; }
    l_reg = l_reg * alpha + psum2(ps);
    return alpha;
}
__device__ __forceinline__ void rescale_o(f32x16* o, float alpha, float* al_l, int r32, int hi) {
    if (__any(alpha < 1.f)) { if (hi == 0) al_l[r32] = alpha; asm volatile("s_waitcnt lgkmcnt(0)" ::: "memory");
#pragma unroll
        for (int r = 0; r < 16; ++r) { const float a = al_l[crow(r, hi)];
#pragma unroll
            for (int d = 0; d < 4; ++d) o[d][r] *= a; } }
}

template <int MODE, int KB>
__device__ __forceinline__ void tile_compute(const int t, const int q0, const int r32, const int hi, const char* K_lds, const int vb0, const float* ck_l, float* al_l, const char* qr,
                                             f32x16* o, f32x16* o2, float& m1, float& l1, float& m2, float& l2, float& carry, const float cq2) {
    constexpr float C2 = (MODE >= 2 ? 0.125f : 0.08838834764831845f) * LOG2E;
    const int dq = q0 + r32 - t * 64 - 4 * hi;
    bf16x8 pa0, pa1, pa2, pa3; f32x16 p0, p1;
    if constexpr (MODE == 0) {
        qkt<KB, 0, 8>(p0, p1, K_lds, r32, hi, qr);
        const float* ck = ck_l + KB * 64 + 4 * hi;
#pragma unroll
        for (int g = 0; g < 4; ++g) { const f32x4 c0 = *(const f32x4*)(ck + 8 * g), c1 = *(const f32x4*)(ck + 32 + 8 * g);
#pragma unroll
            for (int e = 0; e < 4; ++e) { p0[4 * g + e] = fmaf(p0[4 * g + e], C2, cq2 - c0[e]); p1[4 * g + e] = fmaf(p1[4 * g + e], C2, cq2 - c1[e]); } }
        if (t * 64 + 63 > q0) mask_tile(p0, p1, dq);
        const float alpha = softmax_step(p0, p1, m1, l1);
        pack_p(p0, p1, pa0, pa1, pa2, pa3);
        rescale_o(o, alpha, al_l, r32, hi);
        pv_tile<KB>(o, vb0, pa0, pa1, pa2, pa3);
    } else if constexpr (MODE == 1) {
        qkt<KB, 0, 8>(p0, p1, K_lds, r32, hi, qr);
        const bool nm = (t * 64 + 63 >= q0);
        f32x16 k0, k1; float gs[8];
#pragma unroll
        for (int r = 0; r < 16; ++r) { const int c = (r & 3) + 8 * (r >> 2);
            { const float z2 = p0[r] * C2, sp = fmaxf(z2, 0.f) + __builtin_amdgcn_logf(1.f + __builtin_amdgcn_exp2f(-fabsf(z2))); const bool valid = !nm || (dq - c - 1 >= 0);
              p0[r] = valid ? (z2 - sp) : -__builtin_inff(); k0[r] = valid ? -sp : 0.f; }
            { const float z2 = p1[r] * C2, sp = fmaxf(z2, 0.f) + __builtin_amdgcn_logf(1.f + __builtin_amdgcn_exp2f(-fabsf(z2))); const bool valid = !nm || (dq - c - 33 >= 0);
              p1[r] = valid ? (z2 - sp) : -__builtin_inff(); k1[r] = valid ? -sp : 0.f; } }
#pragma unroll
        for (int g = 0; g < 4; ++g) { gs[g] = (k0[4 * g] + k0[4 * g + 1]) + (k0[4 * g + 2] + k0[4 * g + 3]); gs[4 + g] = (k1[4 * g] + k1[4 * g + 1]) + (k1[4 * g + 2] + k1[4 * g + 3]); }
        float run = carry;
#pragma unroll
        for (int g = 7; g >= 0; --g) {
            const float tot = psum2(gs[g]); float base = run + (hi == 0 ? (tot - gs[g]) : 0.f);
#pragma unroll
            for (int e = 3; e >= 0; --e) { const int r = 4 * (g & 3) + e;
                if (g >= 4) { const float w = __builtin_amdgcn_exp2f(p1[r] + base); base += k1[r]; p1[r] = w; }
                else { const float w = __builtin_amdgcn_exp2f(p0[r] + base); base += k0[r]; p0[r] = w; } }
            run += tot; }
        carry = run;
        pack_p(p0, p1, pa0, pa1, pa2, pa3);
        pv_tile<KB>(o, vb0, pa0, pa1, pa2, pa3);
    } else {
        qkt<KB, (MODE == 2 ? 0 : 4), (MODE == 2 ? 4 : 8)>(p0, p1, K_lds, r32, hi, qr);
#pragma unroll
        for (int r = 0; r < 16; ++r) { p0[r] *= C2; p1[r] *= C2; }
        const float a1 = softmax_step(p0, p1, m1, l1);
        pack_p(p0, p1, pa0, pa1, pa2, pa3);
        rescale_o(o, a1, al_l, r32, hi);
        pv_tile<KB>(o, vb0, pa0, pa1, pa2, pa3);
    }
}

template <int MODE>
__device__ __forceinline__ void attn_unit(const int tid, char* lds, const bf16_t* ATT, const float* CUM2, bf16_t* OB, float* ODF, int b, int h, int qb, const unsigned* KINF, unsigned char* Gz, const unsigned rank) {
    const int wid = __builtin_amdgcn_readfirstlane(tid >> 6), lane = tid & 63, r32 = lane & 31, hi = lane >> 5;
    const int qc = (MODE == 0 ? C_FQ : MODE == 1 ? C_SQ : C_DQ) + h * 128, kc = (MODE == 0 ? C_FK : MODE == 1 ? C_SK : C_DK) + h * 128, vc = (MODE == 0 ? C_FV : MODE == 1 ? C_SV : C_DV) + h * 128;
    const int oc = (MODE == 0 ? 0 : MODE == 1 ? 768 : 1536) + h * 128;
    const size_t rowb = (size_t)b * SEQ;
    const int q0 = qb * 256 + wid * 32;
    const int NT = 4 * qb + 4;
    char* V_lds = lds + OFF_V; char* K_lds = lds + OFF_K; float* ck_l = (float*)(lds + OFF_CK); float* wsl = (float*)(lds + OFF_WS) + wid * 64; float* li_l = wsl; float* al_l = wsl + 32;
    const int vb0 = (int)(uintptr_t)V_lds + v_rd_base(lane);
    int koff, voff;
    { const int row = tid >> 4, cb = (tid & 15) ^ (row & 7); koff = row * 6144 + cb * 8;
      const int sub = tid >> 5, w = tid & 31, kk = (sub >> 2) * 8 + (w >> 2), k = (kk & ~0xC) | ((kk & 4) << 1) | ((kk & 8) >> 1); voff = k * 6144 + (sub & 3) * 32 + (w & 3) * 8; }
    const bf16_t* Kg = ATT + rowb * 6144 + kc; const bf16_t* Vg = ATT + rowb * 6144 + vc;
    const float* cumh = CUM2 + (size_t)(b * 6 + h) * SEQ;
    LAS char* ldsl = (LAS char*)lds;
    char* qr = lds + OFF_Q + wid * 8192 + lane * 16;
    float qa = 0.f;
#pragma unroll
    for (int d0 = 0; d0 < 8; ++d0) { const bf16x8 f = *(const bf16x8*)(ATT + (rowb + q0 + r32) * 6144 + qc + d0 * 16 + hi * 8); *(bf16x8*)(qr + d0 * 1024) = f;
        if (MODE == 0) {
#pragma unroll
            for (int e = 0; e < 8; ++e) qa += fabsf(__uint_as_float(((unsigned)(unsigned short)f[e]) << 16)); } }
    f32x16 o[4] = {}; f32x16 o2[1] = {};
    float m1 = -1e30f, l1 = 0.f, m2 = -1e30f, l2 = 0.f, carry = 0.f, cq2 = 0.f;
    if (MODE == 0) cq2 = cumh[q0 + r32];
    float ub = 0.f; bool deadw = false;
    if (MODE == 0) ub = psum2(qa) * (__uint_as_float(KINF[b * 8 + h]) * 1.01f) * (0.08838834764831845f * LOG2E) + 1.f;
#define TILE(i) ((MODE <= 1) ? (NT - 1 - (i)) : (i))
#define STAGE(t, bf) do { const bf16_t* kp_ = Kg + (size_t)(t) * (64 * 6144) + koff; const bf16_t* vp_ = Vg + (size_t)(t) * (64 * 6144) + voff; \
        __builtin_amdgcn_global_load_lds((const unsigned*)kp_, (LAS unsigned*)(ldsl + OFF_K + (bf) * SHM_K + wid * 1024), 16, 0, 0); \
        __builtin_amdgcn_global_load_lds((const unsigned*)(kp_ + 32 * 6144), (LAS unsigned*)(ldsl + OFF_K + (bf) * SHM_K + 8192 + wid * 1024), 16, 0, 0); \
        __builtin_amdgcn_global_load_lds((const unsigned*)vp_, (LAS unsigned*)(ldsl + OFF_V + (bf) * SHM_V + wid * 1024), 16, 0, 0); \
        __builtin_amdgcn_global_load_lds((const unsigned*)(vp_ + 32 * 6144), (LAS unsigned*)(ldsl + OFF_V + (bf) * SHM_V + 8192 + wid * 1024), 16, 0, 0); \
        if (MODE == 0 && wid == 0) __builtin_amdgcn_global_load_lds((const unsigned*)(cumh + (t) * 64 + lane), (LAS unsigned*)(ldsl + OFF_CK + (bf) * 256), 4, 0, 0); } while (0)
#define ACTIVE(t) ((MODE == 0) ? ((t) * 64 <= q0 + 31) : (MODE == 1) ? ((t) * 64 < q0 + 31) : ((t) * 64 <= q0))
    volatile int* dn_l = (volatile int*)(lds + (MODE == 1 ? OFF_CK : OFF_WS));
    bool stop = false;
    unsigned zz_ = 0u; asm volatile("" : "+v"(zz_)); const u32x4 zv_ = {zz_, zz_, zz_, zz_}; int zk_ = 0;
#define ZST(k) do { const unsigned o_ = (unsigned)(k) * 512u + (unsigned)tid; const size_t g_ = (size_t)rank * 13108u + o_; if (o_ < 13108u && g_ < (size_t)(NB * SEQ) * 1024u) ((u32x4*)Gz)[g_] = zv_; } while (0)
#define BODY(i, KB) do { const int t_ = TILE(i); \
        if (zk_ < 26) { ZST(zk_); ZST(zk_ + 1); zk_ += 2; } \
        if ((i) + 1 < NT) STAGE(TILE((i) + 1), (KB) ^ 1); \
        const bool dead_ = (MODE == 1) ? __all(carry < -130.f) : deadw; \
        if (ACTIVE(t_) && !dead_) { tile_compute<MODE, KB>(t_, q0, r32, hi, K_lds, vb0, ck_l, al_l, qr, o, o2, m1, l1, m2, l2, carry, cq2); \
            if (MODE == 0) deadw = __all(ub + cq2 - ck_l[(KB) * 64] - m1 < -130.f); } \
        if (MODE <= 1 && lane == 0) dn_l[(KB) * 8 + wid] = ((MODE == 0 ? deadw : dead_) || t_ == 0) ? 1 : 0;     \
        asm volatile("s_waitcnt vmcnt(0) lgkmcnt(0)" ::: "memory"); __syncthreads(); \
        if (MODE <= 1) { int a_ = 1; _Pragma("unroll") for (int w_ = 0; w_ < 8; ++w_) a_ &= dn_l[(KB) * 8 + w_]; stop = (a_ != 0); } } while (0)
    STAGE(TILE(0), 0); asm volatile("s_waitcnt vmcnt(0)" ::: "memory"); __syncthreads();
    for (int i = 0; i < NT; i += 2) { BODY(i, 0); if (MODE <= 1 && stop) break; BODY(i + 1, 1); if (MODE <= 1 && stop) break; }
    if (MODE <= 1) __syncthreads();
    for (; zk_ < 26; ++zk_) ZST(zk_);
    if (MODE != 1) { if (hi == 0) li_l[r32] = 1.f / l1; }
    asm volatile("s_waitcnt lgkmcnt(0)" ::: "memory");
    if (MODE != 1) {
#pragma unroll
        for (int r = 0; r < 16; ++r) { const float f1 = li_l[crow(r, hi)];
#pragma unroll
            for (int d = 0; d < 4; ++d) o[d][r] *= f1; }
    }
    if (MODE >= 2) {
        float* Ow = ODF + ((size_t)(MODE - 2) * (NB * SEQ) + rowb + q0) * 512 + h * 128;
#pragma unroll
        for (int r = 0; r < 16; ++r) { const int orow = crow(r, hi);
#pragma unroll
            for (int d = 0; d < 4; ++d) Ow[(size_t)orow * 512 + d * 32 + r32] = o[d][r]; }
    } else {
        bf16_t* Ow = OB + (rowb + q0) * DM + oc;
#pragma unroll
        for (int r = 0; r < 16; ++r) { const int orow = crow(r, hi);
#pragma unroll
            for (int d = 0; d < 4; ++d) { const float v = o[d][r]; const float vn = __shfl_xor(v, 1);
                if ((r32 & 1) == 0) *(unsigned*)(Ow + (size_t)orow * DM + d * 32 + r32) = cvtpk(v, vn); } }
    }
    __syncthreads();
#undef TILE
#undef STAGE
#undef ACTIVE
#undef BODY
#undef ZST
}
#undef KSWZ
#undef SBAR
}

namespace topk {
using att::f32x16; using att::bf16x8;
constexpr int CA[64] = {0, 0, 0, 0, 0, 0, 0, 0, 0, 0, 0, 0, 0, 0, 0, 0, 1, 1, 1, 1, 1, 1, 1, 1, 2, -1, -1, -1, -1, -1, -1, -1, 2, 2, 2, 2, 3, 3, 3, 3, 4, 4, 4, 5, 5, 6, 6, 7, 7, 8, 9, 10, 11, 12, 13, 14, 15, -1, -1, -1, -1, -1, -1, -1};
constexpr int CB[64] = {0, 1, 2, 3, 4, 5, 6, 7, 8, 9, 10, 11, 12, 13, 14, 15, 0, 1, 2, 3, 4, 5, 6, 7, 0, -1, -1, -1, -1, -1, -1, -1, 1, 2, 3, 4, 0, 1, 2, 3, 0, 1, 2, 0, 1, 0, 1, 0, 1, 0, 0, 0, 0, 0, 0, 0, 0, -1, -1, -1, -1, -1, -1, -1};
__device__ __forceinline__ unsigned mono(float f) { const unsigned u = __float_as_uint(f); return u ^ ((unsigned)((int)u >> 31) | 0x80000000u); }
__device__ __forceinline__ float unmono(unsigned k) { return __uint_as_float((k & 0x80000000u) ? (k ^ 0x80000000u) : ~k); }
__device__ __forceinline__ unsigned umax_(unsigned a, unsigned b) { return a > b ? a : b; }
__device__ __forceinline__ unsigned umin_(unsigned a, unsigned b) { return a < b ? a : b; }
__device__ __forceinline__ unsigned partner_u(unsigned v, int hi) { auto rr = __builtin_amdgcn_permlane32_swap(v, v, false, false); return hi ? rr[0] : rr[1]; }

template <int N> __device__ __forceinline__ void sort_blocks16(unsigned (&x)[N]) {
#pragma unroll
    for (int k = 2; k <= 16; k <<= 1)
#pragma unroll
        for (int j = k >> 1; j > 0; j >>= 1)
#pragma unroll
            for (int i = 0; i < N; ++i) { const int l = i ^ j; if (l > i) { const bool desc = ((i & k) == 0); const unsigned a = x[i], b = x[l], mx = umax_(a, b), mn = umin_(a, b); x[i] = desc ? mx : mn; x[l] = desc ? mn : mx; } }
}
template <bool DESC> __device__ __forceinline__ void merge16(unsigned (&x)[16]) {
#pragma unroll
    for (int j = 8; j > 0; j >>= 1)
#pragma unroll
        for (int i = 0; i < 16; ++i) { const int l = i ^ j; if (l > i) { const unsigned a = x[i], b = x[l], mx = umax_(a, b), mn = umin_(a, b); x[i] = DESC ? mx : mn; x[l] = DESC ? mn : mx; } }
}
__device__ __forceinline__ void top16_of_pair(unsigned (&x)[64], unsigned (&w)[16], int hi) {
    sort_blocks16<64>(x);
    unsigned y[16], z[16];
#pragma unroll
    for (int i = 0; i < 16; ++i) { y[i] = umax_(x[i], x[16 + i]); z[i] = umax_(x[32 + i], x[48 + i]); }
    merge16<true>(y); merge16<false>(z);
#pragma unroll
    for (int i = 0; i < 16; ++i) w[i] = umax_(y[i], z[i]);
    merge16<true>(w);
    unsigned pr[16];
#pragma unroll
    for (int i = 0; i < 16; ++i) pr[i] = partner_u(w[i], hi);
#pragma unroll
    for (int i = 0; i < 16; ++i) w[i] = umax_(w[i], pr[15 - i]);
    merge16<true>(w);
}
__device__ __forceinline__ void ce2(float& va, unsigned& pa, float& vb, unsigned& pb, bool desc) {
    const bool sw = desc ? (vb > va) : (va > vb); const float tv = sw ? vb : va, uv = sw ? va : vb; const unsigned tp = sw ? pb : pa, up = sw ? pa : pb; va = tv; pa = tp; vb = uv; pb = up;
}
__device__ __forceinline__ void merge16v(float (&v)[16], unsigned (&p)[16]) {
#pragma unroll
    for (int j = 8; j > 0; j >>= 1)
#pragma unroll
        for (int i = 0; i < 16; ++i) { const int l = i ^ j; if (l > i) ce2(v[i], p[i], v[l], p[l], true); }
}

__device__ __forceinline__ void scores_half(f32x16& pA, f32x16& pB, f32x16& pC, f32x16& pD, const char* imgs, int r32, int hi, const float* qrow) {
    pA = f32x16{}; pB = f32x16{}; pC = f32x16{}; pD = f32x16{};
    int kb[4];
#pragma unroll
    for (int dd = 0; dd < 4; ++dd) kb[dd] = r32 * 256 + (((dd * 16 + hi * 8) * 2) ^ ((r32 & 7) << 4));
    att::f32x4 qa[4], qb[4];
#pragma unroll
    for (int d0 = 0; d0 < 4; ++d0) { qa[d0] = *(const att::f32x4*)(qrow + d0 * 16 + hi * 8); qb[d0] = *(const att::f32x4*)(qrow + d0 * 16 + hi * 8 + 4); }
#pragma unroll
    for (int d0 = 0; d0 < 8; ++d0) { const int a = kb[d0 & 3] + (d0 >> 2) * 128;
        const att::f32x4 fa = d0 < 4 ? qa[d0 & 3] : *(const att::f32x4*)(qrow + d0 * 16 + hi * 8), fb = d0 < 4 ? qb[d0 & 3] : *(const att::f32x4*)(qrow + d0 * 16 + hi * 8 + 4);
        const float f[8] = {fa[0], fa[1], fa[2], fa[3], fb[0], fb[1], fb[2], fb[3]}; unsigned hw[4], lw[4];
#pragma unroll
        for (int e = 0; e < 4; ++e) { const unsigned h2 = att::cvtpk(f[2 * e], f[2 * e + 1]); hw[e] = h2;
            lw[e] = att::cvtpk(f[2 * e] - __uint_as_float(h2 << 16), f[2 * e + 1] - __uint_as_float(h2 & 0xffff0000u)); }
        att::u32x4 hv = {hw[0], hw[1], hw[2], hw[3]}, lv = {lw[0], lw[1], lw[2], lw[3]}; const bf16x8 qh = *reinterpret_cast<bf16x8*>(&hv), ql = *reinterpret_cast<bf16x8*>(&lv);
#pragma unroll
        for (int tl = 0; tl < 2; ++tl) { const char* img_hi = imgs + tl * 32768; const char* img_lo = img_hi + 16384;
            const bf16x8 h0 = *reinterpret_cast<const bf16x8*>(img_hi + a), h1 = *reinterpret_cast<const bf16x8*>(img_hi + a + 32 * 256);
            const bf16x8 l0 = *reinterpret_cast<const bf16x8*>(img_lo + a), l1 = *reinterpret_cast<const bf16x8*>(img_lo + a + 32 * 256);
            f32x16& q0 = tl ? pC : pA; f32x16& q1 = tl ? pD : pB;
            q0 = __builtin_amdgcn_mfma_f32_32x32x16_bf16(h0, qh, q0, 0, 0, 0); q1 = __builtin_amdgcn_mfma_f32_32x32x16_bf16(h1, qh, q1, 0, 0, 0);
            q0 = __builtin_amdgcn_mfma_f32_32x32x16_bf16(l0, qh, q0, 0, 0, 0); q1 = __builtin_amdgcn_mfma_f32_32x32x16_bf16(l1, qh, q1, 0, 0, 0);
            q0 = __builtin_amdgcn_mfma_f32_32x32x16_bf16(h0, ql, q0, 0, 0, 0); q1 = __builtin_amdgcn_mfma_f32_32x32x16_bf16(h1, ql, q1, 0, 0, 0); } }
}
__device__ __forceinline__ void half_top16(const float* qrow, const char* imgs  , int r32, int hi, unsigned (&w)[16]) {
    unsigned x[64]; const unsigned ib = 127u - 4u * (unsigned)hi;
    { f32x16 pA, pB, pC, pD; scores_half(pA, pB, pC, pD, imgs, r32, hi, qrow);
#pragma unroll
      for (int r = 0; r < 16; ++r) { const unsigned c = (unsigned)((r & 3) + 8 * (r >> 2));
          x[r] = (mono(pA[r]) & ~127u) | (ib - c); x[16 + r] = (mono(pB[r]) & ~127u) | (ib - c - 32u);
          x[32 + r] = (mono(pC[r]) & ~127u) | (ib - c - 64u); x[48 + r] = (mono(pD[r]) & ~127u) | (ib - c - 96u); } }
    top16_of_pair(x, w, hi);
}
__device__ __forceinline__ void combine_top16(const unsigned (&w1)[16], const unsigned (&w2)[16], int hi, float (&bv)[16], unsigned (&bp)[16]) {
    float s1[16], s2[16]; unsigned i1[16], i2[16];
#pragma unroll
    for (int i = 0; i < 16; ++i) { s1[i] = unmono(w1[i] & ~127u); s2[i] = unmono(w2[i] & ~127u); i1[i] = 127u - (w1[i] & 127u); i2[i] = 127u - (w2[i] & 127u); }
    float v[32]; unsigned p[32];
#pragma unroll
    for (int k = 0; k < 32; ++k) {
        float v0 = -__builtin_inff(), v1 = -__builtin_inff(); unsigned q0 = 0u, q1 = 0u;
        if (CA[k] >= 0) { v0 = s1[CA[k] < 0 ? 0 : CA[k]] + s2[CB[k] < 0 ? 0 : CB[k]]; q0 = (i1[CA[k] < 0 ? 0 : CA[k]] << 7) | i2[CB[k] < 0 ? 0 : CB[k]]; }
        if (CA[32 + k] >= 0) { v1 = s1[CA[32 + k] < 0 ? 0 : CA[32 + k]] + s2[CB[32 + k] < 0 ? 0 : CB[32 + k]]; q1 = (i1[CA[32 + k] < 0 ? 0 : CA[32 + k]] << 7) | i2[CB[32 + k] < 0 ? 0 : CB[32 + k]]; }
        v[k] = hi ? v1 : v0; p[k] = hi ? q1 : q0; }
#pragma unroll
    for (int kk = 2; kk <= 16; kk <<= 1)
#pragma unroll
        for (int j = kk >> 1; j > 0; j >>= 1)
#pragma unroll
            for (int i = 0; i < 32; ++i) { const int l = i ^ j; if (l > i) ce2(v[i], p[i], v[l], p[l], (i & kk) == 0); }
#pragma unroll
    for (int i = 0; i < 16; ++i) { const bool t = v[16 + i] > v[i]; bv[i] = t ? v[16 + i] : v[i]; bp[i] = t ? p[16 + i] : p[i]; }
    merge16v(bv, bp);
    float pv[16]; unsigned pp[16];
#pragma unroll
    for (int i = 0; i < 16; ++i) { pv[i] = __uint_as_float(partner_u(__float_as_uint(bv[i]), hi)); pp[i] = partner_u(bp[i], hi); }
#pragma unroll
    for (int i = 0; i < 16; ++i) { const bool t = pv[15 - i] > bv[i]; bv[i] = t ? pv[15 - i] : bv[i]; bp[i] = t ? pp[15 - i] : bp[i]; }
    merge16v(bv, bp);
}
}

static __device__ const unsigned short ATT_UNITS[640] = {8207, 8223, 8239, 8255, 10255, 10271, 10287, 10303, 12303, 12319, 12335, 12351, 14351, 14367, 14383, 14399, 8206, 8222, 8238, 8254, 10254, 10270, 10286, 10302, 12302, 12318, 12334, 12350, 14350, 14366, 14382, 14398, 8205, 8221, 8237, 8253, 10253, 10269, 10285, 10301, 12301, 12317, 12333, 12349, 14349, 14365, 14381, 14397, 8204, 8220, 8236, 8252, 10252, 10268, 10284, 10300, 12300, 12316, 12332, 12348, 14348, 14364, 14380, 14396, 8203, 8219, 8235, 8251, 10251, 10267, 10283, 10299, 12299, 12315, 12331, 12347, 14347, 14363, 14379, 14395, 8202, 8218, 8234, 8250, 10250, 10266, 10282, 10298, 12298, 12314, 12330, 12346, 14346, 14362, 14378, 14394, 8201, 8217, 8233, 8249, 10249, 10265, 10281, 10297, 12297, 12313, 12329, 12345, 14345, 14361, 14377, 14393, 8200, 8216, 8232, 8248, 10248, 10264, 10280, 10296, 12296, 12312, 12328, 12344, 14344, 14360, 14376, 14392, 8199, 8215, 8231, 8247, 10247, 10263, 10279, 10295, 12295, 12311, 12327, 12343, 14343, 14359, 14375, 14391, 8198, 8214, 8230, 8246, 10246, 10262, 10278, 10294, 12294, 12310, 12326, 12342, 14342, 14358, 14374, 14390, 4, 20, 36, 52, 68, 84, 2052, 2068, 2084, 2100, 2116, 2132, 5, 21, 37, 53, 69, 85, 2053, 2069, 2085, 2101, 2117, 2133, 6, 22, 38, 54, 70, 86, 2054, 2070, 2086, 2102, 2118, 2134, 7, 23, 39, 55, 71, 87, 2055, 2071, 2087, 2103, 2119, 2135, 8, 24, 40, 56, 72, 88, 2056, 2072, 2088, 2104, 2120, 2136, 9, 25, 41, 57, 73, 89, 2057, 2073, 2089, 2105, 2121, 2137, 10, 26, 42, 58, 74, 90, 2058, 2074, 2090, 2106, 2122, 2138, 11, 27, 43, 59, 75, 91, 2059, 2075, 2091, 2107, 2123, 2139, 12, 28, 44, 60, 76, 92, 2060, 2076, 2092, 2108, 2124, 2140, 13, 29, 45, 61, 77, 93, 2061, 2077, 2093, 2109, 2125, 2141, 14, 30, 46, 62, 78, 94, 2062, 2078, 2094, 2110, 2126, 2142, 15, 31, 47, 63, 79, 95, 2063, 2079, 2095, 2111, 2127, 2143, 8197, 8213, 8229, 8245, 10245, 10261, 10277, 10293, 12293, 12309, 12325, 12341, 14341, 14357, 14373, 14389, 3, 19, 35, 51, 67, 83, 2051, 2067, 2083, 2099, 2115, 2131, 8196, 8212, 8228, 8244, 10244, 10260, 10276, 10292, 12292, 12308, 12324, 12340, 14340, 14356, 14372, 14388, 8195, 8211, 8227, 8243, 10243, 10259, 10275, 10291, 12291, 12307, 12323, 12339, 14339, 14355, 14371, 14387, 2, 18, 34, 50, 66, 82, 2050, 2066, 2082, 2098, 2114, 2130, 8194, 8210, 8226, 8242, 10242, 10258, 10274, 10290, 12290, 12306, 12322, 12338, 14338, 14354, 14370, 14386, 4097, 4113, 4129, 4145, 4161, 4177, 6145, 6161, 6177, 6193, 6209, 6225, 4098, 4114, 4130, 4146, 4162, 4178, 6146, 6162, 6178, 6194, 6210, 6226, 4099, 4115, 4131, 4147, 4163, 4179, 6147, 6163, 6179, 6195, 6211, 6227, 4100, 4116, 4132, 4148, 4164, 4180, 6148, 6164, 6180, 6196, 6212, 6228, 4101, 4117, 4133, 4149, 4165, 4181, 6149, 6165, 6181, 6197, 6213, 6229, 4102, 4118, 4134, 4150, 4166, 4182, 6150, 6166, 6182, 6198, 6214, 6230, 4103, 4119, 4135, 4151, 4167, 4183, 6151, 6167, 6183, 6199, 6215, 6231, 4104, 4120, 4136, 4152, 4168, 4184, 6152, 6168, 6184, 6200, 6216, 6232, 4105, 4121, 4137, 4153, 4169, 4185, 6153, 6169, 6185, 6201, 6217, 6233, 4106, 4122, 4138, 4154, 4170, 4186, 6154, 6170, 6186, 6202, 6218, 6234, 4107, 4123, 4139, 4155, 4171, 4187, 6155, 6171, 6187, 6203, 6219, 6235, 4108, 4124, 4140, 4156, 4172, 4188, 6156, 6172, 6188, 6204, 6220, 6236, 4109, 4125, 4141, 4157, 4173, 4189, 6157, 6173, 6189, 6205, 6221, 6237, 4110, 4126, 4142, 4158, 4174, 4190, 6158, 6174, 6190, 6206, 6222, 6238, 4111, 4127, 4143, 4159, 4175, 4191, 6159, 6175, 6191, 6207, 6223, 6239, 1, 17, 33, 49, 65, 81, 2049, 2065, 2081, 2097, 2113, 2129, 8193, 8209, 8225, 8241, 10241, 10257, 10273, 10289, 12289, 12305, 12321, 12337, 14337, 14353, 14369, 14385, 4096, 4112, 4128, 4144, 4160, 4176, 6144, 6160, 6176, 6192, 6208, 6224, 0, 16, 32, 48, 64, 80, 2048, 2064, 2080, 2096, 2112, 2128, 8192, 8208, 8224, 8240, 10240, 10256, 10272, 10288, 12288, 12304, 12320, 12336, 14336, 14352, 14368, 14384};
constexpr int N_ATT_ITEMS0 = 1920;
static __device__ const unsigned short ATT_ITEMS0[N_ATT_ITEMS0] = {8207, 8223, 8239, 8255, 10255, 10271, 10287, 10303, 12303, 12319, 12335, 12351, 14351, 14367, 14383, 14399, 8206, 8222, 8238, 8254, 10254, 10270, 10286, 10302, 12302, 12318, 12334, 12350, 14350, 14366, 14382, 14398, 8205, 8221, 8237, 8253, 10253, 10269, 10285, 10301, 12301, 12317, 12333, 12349, 14349, 14365, 14381, 14397, 8204, 8220, 8236, 8252, 10252, 10268, 10284, 10300, 12300, 12316, 12332, 12348, 14348, 14364, 14380, 14396, 8203, 8219, 8235, 8251, 10251, 10267, 10283, 10299, 12299, 12315, 12331, 12347, 14347, 14363, 14379, 14395, 8202, 8218, 8234, 8250, 10250, 10266, 10282, 10298, 12298, 12314, 12330, 12346, 14346, 14362, 14378, 14394, 8201, 8217, 8233, 8249, 10249, 10265, 10281, 10297, 12297, 12313, 12329, 12345, 14345, 14361, 14377, 14393, 8200, 8216, 8232, 8248, 10248, 10264, 10280, 10296, 12296, 12312, 12328, 12344, 14344, 14360, 14376, 14392, 8199, 8215, 8231, 8247, 10247, 10263, 10279, 10295, 12295, 12311, 12327, 12343, 14343, 14359, 14375, 14391, 8198, 8214, 8230, 8246, 10246, 10262, 10278, 10294, 12294, 12310, 12326, 12342, 14342, 14358, 14374, 14390, 4, 20, 36, 52, 68, 84, 2052, 2068, 2084, 2100, 2116, 2132, 5, 21, 37, 53, 69, 85, 2053, 2069, 2085, 2101, 2117, 2133, 6, 22, 38, 54, 70, 86, 2054, 2070, 2086, 2102, 2118, 2134, 7, 23, 39, 55, 71, 87, 2055, 2071, 2087, 2103, 2119, 2135, 8, 24, 40, 56, 72, 88, 2056, 2072, 2088, 2104, 2120, 2136, 9, 25, 41, 57, 73, 89, 2057, 2073, 2089, 2105, 2121, 2137, 10, 26, 42, 58, 74, 90, 2058, 2074, 2090, 2106, 2122, 2138, 11, 27, 43, 59, 75, 91, 2059, 2075, 2091, 2107, 2123, 2139, 45056, 45057, 45058, 45059, 45060, 45061, 45062, 45063, 45064, 45065, 45066, 45067, 45068, 45069, 45070, 45071, 45072, 45073, 45074, 45075, 45076, 45077, 45078, 45079, 45080, 45081, 45082, 45083, 45084, 45085, 45086, 45087, 45088, 45089, 45090, 45091, 45092, 45093, 45094, 45095, 45096, 45097, 45098, 45099, 45100, 45101, 45102, 45103, 45104, 45105, 45106, 45107, 45108, 45109, 45110, 45111, 45112, 45113, 45114, 45115, 45116, 45117, 45118, 45119, 45120, 45121, 45122, 45123, 45124, 45125, 45126, 45127, 45128, 45129, 45130, 45131, 45132, 45133, 45134, 45135, 45136, 45137, 45138, 45139, 45140, 45141, 45142, 45143, 45144, 45145, 45146, 45147, 45148, 45149, 45150, 45151, 45152, 45153, 45154, 45155, 45156, 45157, 45158, 45159, 45160, 45161, 45162, 45163, 45164, 45165, 45166, 45167, 45168, 45169, 45170, 45171, 45172, 45173, 45174, 45175, 45176, 45177, 45178, 45179, 45180, 45181, 45182, 45183, 12, 28, 44, 60, 76, 92, 2060, 2076, 2092, 2108, 2124, 2140, 13, 29, 45, 61, 77, 93, 2061, 2077, 2093, 2109, 2125, 2141, 14, 30, 46, 62, 78, 94, 2062, 2078, 2094, 2110, 2126, 2142, 15, 31, 47, 63, 79, 95, 2063, 2079, 2095, 2111, 2127, 2143, 8197, 8213, 8229, 8245, 10245, 10261, 10277, 10293, 12293, 12309, 12325, 12341, 14341, 14357, 14373, 14389, 3, 19, 35, 51, 67, 83, 2051, 2067, 2083, 2099, 2115, 2131, 8196, 8212, 8228, 8244, 10244, 10260, 10276, 10292, 12292, 12308, 12324, 12340, 14340, 14356, 14372, 14388, 8195, 8211, 8227, 8243, 10243, 10259, 10275, 10291, 12291, 12307, 12323, 12339, 14339, 14355, 14371, 14387, 2, 18, 34, 50, 66, 82, 2050, 2066, 2082, 2098, 2114, 2130, 8194, 8210, 8226, 8242, 10242, 10258, 10274, 10290, 12290, 12306, 12322, 12338, 14338, 14354, 14370, 14386, 4097, 4113, 4129, 4145, 4161, 4177, 6145, 6161, 6177, 6193, 6209, 6225, 4098, 4114, 4130, 4146, 4162, 4178, 6146, 6162, 6178, 6194, 6210, 6226, 4099, 4115, 4131, 4147, 4163, 4179, 6147, 6163, 6179, 6195, 6211, 6227, 4100, 4116, 4132, 4148, 4164, 4180, 6148, 6164, 6180, 6196, 6212, 6228, 4101, 4117, 4133, 4149, 4165, 4181, 6149, 6165, 6181, 6197, 6213, 6229, 4102, 4118, 4134, 4150, 4166, 4182, 6150, 6166, 6182, 6198, 6214, 6230, 4103, 4119, 4135, 4151, 4167, 4183, 6151, 6167, 6183, 6199, 6215, 6231, 4104, 4120, 4136, 4152, 4168, 4184, 6152, 6168, 6184, 6200, 6216, 6232, 4105, 4121, 4137, 4153, 4169, 4185, 6153, 6169, 6185, 6201, 6217, 6233, 4106, 4122, 4138, 4154, 4170, 4186, 6154, 6170, 6186, 6202, 6218, 6234, 4107, 4123, 4139, 4155, 4171, 4187, 6155, 6171, 6187, 6203, 6219, 6235, 4108, 4124, 4140, 4156, 4172, 4188, 6156, 6172, 6188, 6204, 6220, 6236, 4109, 4125, 4141, 4157, 4173, 4189, 6157, 6173, 6189, 6205, 6221, 6237, 4110, 4126, 4142, 4158, 4174, 4190, 6158, 6174, 6190, 6206, 6222, 6238, 4111, 4127, 4143, 4159, 4175, 4191, 6159, 6175, 6191, 6207, 6223, 6239, 49152, 49153, 49154, 49155, 49156, 49157, 49158, 49159, 49160, 49161, 49162, 49163, 49164, 49165, 49166, 49167, 49168, 49169, 49170, 49171, 49172, 49173, 49174, 49175, 49176, 49177, 49178, 49179, 49180, 49181, 49182, 49183, 49184, 49185, 49186, 49187, 49188, 49189, 49190, 49191, 49192, 49193, 49194, 49195, 49196, 49197, 49198, 49199, 49200, 49201, 49202, 49203, 49204, 49205, 49206, 49207, 49208, 49209, 49210, 49211, 49212, 49213, 49214, 49215, 49216, 49217, 49218, 49219, 49220, 49221, 49222, 49223, 49224, 49225, 49226, 49227, 49228, 49229, 49230, 49231, 49232, 49233, 49234, 49235, 49236, 49237, 49238, 49239, 49240, 49241, 49242, 49243, 49244, 49245, 49246, 49247, 49248, 49249, 49250, 49251, 49252, 49253, 49254, 49255, 49256, 49257, 49258, 49259, 49260, 49261, 49262, 49263, 49264, 49265, 49266, 49267, 49268, 49269, 49270, 49271, 49272, 49273, 49274, 49275, 49276, 49277, 49278, 49279, 49280, 49281, 49282, 49283, 49284, 49285, 49286, 49287, 49288, 49289, 49290, 49291, 49292, 49293, 49294, 49295, 49296, 49297, 49298, 49299, 49300, 49301, 49302, 49303, 49304, 49305, 49306, 49307, 49308, 49309, 49310, 49311, 49312, 49313, 49314, 49315, 49316, 49317, 49318, 49319, 49320, 49321, 49322, 49323, 49324, 49325, 49326, 49327, 49328, 49329, 49330, 49331, 49332, 49333, 49334, 49335, 49336, 49337, 49338, 49339, 49340, 49341, 49342, 49343, 49344, 49345, 49346, 49347, 49348, 49349, 49350, 49351, 49352, 49353, 49354, 49355, 49356, 49357, 49358, 49359, 49360, 49361, 49362, 49363, 49364, 49365, 49366, 49367, 49368, 49369, 49370, 49371, 49372, 49373, 49374, 49375, 49376, 49377, 49378, 49379, 49380, 49381, 49382, 49383, 49384, 49385, 49386, 49387, 49388, 49389, 49390, 49391, 49392, 49393, 49394, 49395, 49396, 49397, 49398, 49399, 49400, 49401, 49402, 49403, 49404, 49405, 49406, 49407, 49408, 49409, 49410, 49411, 49412, 49413, 49414, 49415, 49416, 49417, 49418, 49419, 49420, 49421, 49422, 49423, 49424, 49425, 49426, 49427, 49428, 49429, 49430, 49431, 49432, 49433, 49434, 49435, 49436, 49437, 49438, 49439, 49440, 49441, 49442, 49443, 49444, 49445, 49446, 49447, 49448, 49449, 49450, 49451, 49452, 49453, 49454, 49455, 49456, 49457, 49458, 49459, 49460, 49461, 49462, 49463, 49464, 49465, 49466, 49467, 49468, 49469, 49470, 49471, 49472, 49473, 49474, 49475, 49476, 49477, 49478, 49479, 49480, 49481, 49482, 49483, 49484, 49485, 49486, 49487, 49488, 49489, 49490, 49491, 49492, 49493, 49494, 49495, 49496, 49497, 49498, 49499, 49500, 49501, 49502, 49503, 49504, 49505, 49506, 49507, 49508, 49509, 49510, 49511, 49512, 49513, 49514, 49515, 49516, 49517, 49518, 49519, 49520, 49521, 49522, 49523, 49524, 49525, 49526, 49527, 49528, 49529, 49530, 49531, 49532, 49533, 49534, 49535, 49536, 49537, 49538, 49539, 49540, 49541, 49542, 49543, 49544, 49545, 49546, 49547, 49548, 49549, 49550, 49551, 49552, 49553, 49554, 49555, 49556, 49557, 49558, 49559, 49560, 49561, 49562, 49563, 49564, 49565, 49566, 49567, 49568, 49569, 49570, 49571, 49572, 49573, 49574, 49575, 49576, 49577, 49578, 49579, 49580, 49581, 49582, 49583, 49584, 49585, 49586, 49587, 49588, 49589, 49590, 49591, 49592, 49593, 49594, 49595, 49596, 49597, 49598, 49599, 49600, 49601, 49602, 49603, 49604, 49605, 49606, 49607, 49608, 49609, 49610, 49611, 49612, 49613, 49614, 49615, 49616, 49617, 49618, 49619, 49620, 49621, 49622, 49623, 49624, 49625, 49626, 49627, 49628, 49629, 49630, 49631, 49632, 49633, 49634, 49635, 49636, 49637, 49638, 49639, 49640, 49641, 49642, 49643, 49644, 49645, 49646, 49647, 49648, 49649, 49650, 49651, 49652, 49653, 49654, 49655, 49656, 49657, 49658, 49659, 49660, 49661, 49662, 49663, 1, 17, 33, 49, 65, 81, 2049, 2065, 2081, 2097, 2113, 2129, 8193, 8209, 8225, 8241, 10241, 10257, 10273, 10289, 12289, 12305, 12321, 12337, 14337, 14353, 14369, 14385, 40960, 40961, 40962, 40963, 40964, 40965, 40966, 40967, 40968, 40969, 40970, 40971, 40972, 40973, 40974, 40975, 40976, 40977, 40978, 40979, 40980, 40981, 40982, 40983, 40984, 40985, 40986, 40987, 40988, 40989, 40990, 40991, 40992, 40993, 40994, 40995, 40996, 40997, 40998, 40999, 41000, 41001, 41002, 41003, 41004, 41005, 41006, 41007, 41008, 41009, 41010, 41011, 41012, 41013, 41014, 41015, 41016, 41017, 41018, 41019, 41020, 41021, 41022, 41023, 41024, 41025, 41026, 41027, 41028, 41029, 41030, 41031, 41032, 41033, 41034, 41035, 41036, 41037, 41038, 41039, 41040, 41041, 41042, 41043, 41044, 41045, 41046, 41047, 41048, 41049, 41050, 41051, 41052, 41053, 41054, 41055, 41056, 41057, 41058, 41059, 41060, 41061, 41062, 41063, 41064, 41065, 41066, 41067, 41068, 41069, 41070, 41071, 41072, 41073, 41074, 41075, 41076, 41077, 41078, 41079, 41080, 41081, 41082, 41083, 41084, 41085, 41086, 41087, 4096, 4112, 4128, 4144, 4160, 4176, 6144, 6160, 6176, 6192, 6208, 6224, 0, 16, 32, 48, 64, 80, 2048, 2064, 2080, 2096, 2112, 2128, 8192, 8208, 8224, 8240, 10240, 10256, 10272, 10288, 12288, 12304, 12320, 12336, 14336, 14352, 14368, 14384, 32768, 32769, 32770, 32771, 32772, 32773, 32774, 32775, 32776, 32777, 32778, 32779, 32780, 32781, 32782, 32783, 32784, 32785, 32786, 32787, 32788, 32789, 32790, 32791, 32792, 32793, 32794, 32795, 32796, 32797, 32798, 32799, 32800, 32801, 32802, 32803, 32804, 32805, 32806, 32807, 32808, 32809, 32810, 32811, 32812, 32813, 32814, 32815, 32816, 32817, 32818, 32819, 32820, 32821, 32822, 32823, 32824, 32825, 32826, 32827, 32828, 32829, 32830, 32831, 32832, 32833, 32834, 32835, 32836, 32837, 32838, 32839, 32840, 32841, 32842, 32843, 32844, 32845, 32846, 32847, 32848, 32849, 32850, 32851, 32852, 32853, 32854, 32855, 32856, 32857, 32858, 32859, 32860, 32861, 32862, 32863, 32864, 32865, 32866, 32867, 32868, 32869, 32870, 32871, 32872, 32873, 32874, 32875, 32876, 32877, 32878, 32879, 32880, 32881, 32882, 32883, 32884, 32885, 32886, 32887, 32888, 32889, 32890, 32891, 32892, 32893, 32894, 32895, 32896, 32897, 32898, 32899, 32900, 32901, 32902, 32903, 32904, 32905, 32906, 32907, 32908, 32909, 32910, 32911, 32912, 32913, 32914, 32915, 32916, 32917, 32918, 32919, 32920, 32921, 32922, 32923, 32924, 32925, 32926, 32927, 32928, 32929, 32930, 32931, 32932, 32933, 32934, 32935, 32936, 32937, 32938, 32939, 32940, 32941, 32942, 32943, 32944, 32945, 32946, 32947, 32948, 32949, 32950, 32951, 32952, 32953, 32954, 32955, 32956, 32957, 32958, 32959, 32960, 32961, 32962, 32963, 32964, 32965, 32966, 32967, 32968, 32969, 32970, 32971, 32972, 32973, 32974, 32975, 32976, 32977, 32978, 32979, 32980, 32981, 32982, 32983, 32984, 32985, 32986, 32987, 32988, 32989, 32990, 32991, 32992, 32993, 32994, 32995, 32996, 32997, 32998, 32999, 33000, 33001, 33002, 33003, 33004, 33005, 33006, 33007, 33008, 33009, 33010, 33011, 33012, 33013, 33014, 33015, 33016, 33017, 33018, 33019, 33020, 33021, 33022, 33023, 33024, 33025, 33026, 33027, 33028, 33029, 33030, 33031, 33032, 33033, 33034, 33035, 33036, 33037, 33038, 33039, 33040, 33041, 33042, 33043, 33044, 33045, 33046, 33047, 33048, 33049, 33050, 33051, 33052, 33053, 33054, 33055, 33056, 33057, 33058, 33059, 33060, 33061, 33062, 33063, 33064, 33065, 33066, 33067, 33068, 33069, 33070, 33071, 33072, 33073, 33074, 33075, 33076, 33077, 33078, 33079, 33080, 33081, 33082, 33083, 33084, 33085, 33086, 33087, 33088, 33089, 33090, 33091, 33092, 33093, 33094, 33095, 33096, 33097, 33098, 33099, 33100, 33101, 33102, 33103, 33104, 33105, 33106, 33107, 33108, 33109, 33110, 33111, 33112, 33113, 33114, 33115, 33116, 33117, 33118, 33119, 33120, 33121, 33122, 33123, 33124, 33125, 33126, 33127, 33128, 33129, 33130, 33131, 33132, 33133, 33134, 33135, 33136, 33137, 33138, 33139, 33140, 33141, 33142, 33143, 33144, 33145, 33146, 33147, 33148, 33149, 33150, 33151, 36864, 36865, 36866, 36867, 36868, 36869, 36870, 36871, 36872, 36873, 36874, 36875, 36876, 36877, 36878, 36879, 36880, 36881, 36882, 36883, 36884, 36885, 36886, 36887, 36888, 36889, 36890, 36891, 36892, 36893, 36894, 36895, 36896, 36897, 36898, 36899, 36900, 36901, 36902, 36903, 36904, 36905, 36906, 36907, 36908, 36909, 36910, 36911, 36912, 36913, 36914, 36915, 36916, 36917, 36918, 36919, 36920, 36921, 36922, 36923, 36924, 36925, 36926, 36927, 36928, 36929, 36930, 36931, 36932, 36933, 36934, 36935, 36936, 36937, 36938, 36939, 36940, 36941, 36942, 36943, 36944, 36945, 36946, 36947, 36948, 36949, 36950, 36951, 36952, 36953, 36954, 36955, 36956, 36957, 36958, 36959, 36960, 36961, 36962, 36963, 36964, 36965, 36966, 36967, 36968, 36969, 36970, 36971, 36972, 36973, 36974, 36975, 36976, 36977, 36978, 36979, 36980, 36981, 36982, 36983, 36984, 36985, 36986, 36987, 36988, 36989, 36990, 36991};


__global__ void __launch_bounds__(NTHR, 2) fwd_kernel(Args args) {
    extern __shared__ __attribute__((aligned(16))) unsigned char lds_raw[];
    float* lds = (float*)lds_raw;
    const int G = gridDim.x, NGW = G * NWAVES, NGT = G * NTHR;
    const int wave_u_ = __builtin_amdgcn_readfirstlane(threadIdx.x >> 6);
#define PHASE_VARS unsigned z0_ = 0u; asm volatile("" : "+v"(z0_));   \
    int tid = wave_u_ * 64 + (int)__builtin_amdgcn_mbcnt_hi(~0u, __builtin_amdgcn_mbcnt_lo(~0u, z0_)); int bid = blockIdx.x; asm volatile("" : "+s"(bid)); \
    const int lane = tid & 63, wave = tid >> 6, gw = bid * NWAVES + wave, gtid = bid * NTHR + tid; (void)lane; (void)gw; (void)gtid;
    volatile LAS unsigned* MISC = (volatile LAS unsigned*)((LAS unsigned char*)lds_raw + MISC_OFF);
    { const int tid = threadIdx.x;
    unsigned char* ws = args.ws;
    if (tid < 64) MISC[tid] = 0u;
    __syncthreads();
    (void)xcd_barrier_post((unsigned*)(ws + WS_CTL) + CW_BAR, MISC + 8);

    if (tid == 0) {
        volatile LAS unsigned long long* pt = (volatile LAS unsigned long long*)(MISC + 64);
#define PT_SET(i) pt[i] = (unsigned long long)args.in[i]
        PT_SET(0); PT_SET(1); PT_SET(2); PT_SET(3); PT_SET(4); PT_SET(5); PT_SET(6); PT_SET(7); PT_SET(8); PT_SET(9); PT_SET(10); PT_SET(11);
        PT_SET(12); PT_SET(13); PT_SET(14); PT_SET(15); PT_SET(16); PT_SET(17); PT_SET(18); PT_SET(19); PT_SET(20); PT_SET(21); PT_SET(22);
#undef PT_SET
        pt[23] = (unsigned long long)args.out; pt[24] = (unsigned long long)args.ws;
    }
    __syncthreads(); }
#define GRID_BAR() do { XcdBarrier b_; b_.bar = (unsigned*)((unsigned char*)ldp(MISC + 64, 24) + WS_CTL) + CW_BAR; b_.x = xb_xcc_id(); b_.st = MISC + 8; unsigned zb_ = 0u; asm volatile("" : "+v"(zb_)); xcd_barrier(b_, wave_u_ == 0 && __builtin_amdgcn_mbcnt_hi(~0u, __builtin_amdgcn_mbcnt_lo(~0u, zb_)) == 0u); } while (0)
#define IN(i) ldp(MISC + 64, i)
#define WSF(off) ((float*)((unsigned char*)ldp(MISC + 64, 24) + (off)))

    auto cv_win = [&](const int item, const int tid) __attribute__((always_inline)) {
        const int lane = tid & 63; const float* w_in = IN(7); signed char* WT8 = (signed char*)WSF(WS_WINT); float* SW = WSF(WS_SW); LAS unsigned* cm = (LAS unsigned*)((LAS unsigned char*)lds_raw + 140 * 1024);
        const int c4 = tid & 7, rg = tid >> 3; const int l = item / 384, n0 = (item % 384) * 32 + 4 * c4; const int sc0 = win_src_col(n0);
        __syncthreads();
        if (tid < 32) cm[tid] = 0u;
        __syncthreads();
        const float* src = w_in + ((size_t)l * DM + rg * 32) * INW + sc0; float v[32][4]; float mx[4] = {0.f, 0.f, 0.f, 0.f};
#pragma unroll
        for (int j = 0; j < 32; ++j) { const float2 a = ldnt2(src + (size_t)j * INW), b2 = ldnt2(src + (size_t)j * INW + 2); v[j][0] = a.x; v[j][1] = a.y; v[j][2] = b2.x; v[j][3] = b2.y; }
#pragma unroll
        for (int j = 0; j < 32; ++j) {
#pragma unroll
            for (int i = 0; i < 4; ++i) mx[i] = fmaxf(mx[i], fabsf(v[j][i])); }
#pragma unroll
        for (int i = 0; i < 4; ++i) { float m = mx[i]; m = fmaxf(m, SWZ_XOR(m, 8)); m = fmaxf(m, SWZ_XOR(m, 16));
            auto rr = __builtin_amdgcn_permlane32_swap(__float_as_uint(m), __float_as_uint(m), false, false); m = fmaxf(__uint_as_float(rr[0]), __uint_as_float(rr[1]));
            if (lane < 8) __hip_atomic_fetch_max(cm + 4 * c4 + i, __float_as_uint(m), __ATOMIC_RELAXED, __HIP_MEMORY_SCOPE_WORKGROUP); }
        __syncthreads();
#pragma unroll
        for (int i = 0; i < 4; ++i) { const float cmx = fmaxf(__uint_as_float(cm[4 * c4 + i]), 1e-30f), q = 127.f / cmx; unsigned w[8];
#pragma unroll
            for (int m = 0; m < 8; ++m) w[m] = pk_i8x4(v[4 * m][i] * q, v[4 * m + 1][i] * q, v[4 * m + 2][i] * q, v[4 * m + 3][i] * q);
            signed char* dst = WT8 + ((size_t)l * 12288 + n0 + i) * DM + rg * 32;
            *(uint4*)dst = make_uint4(w[0], w[1], w[2], w[3]); *(uint4*)(dst + 16) = make_uint4(w[4], w[5], w[6], w[7]);
            if (rg == 0) SW[(size_t)l * 12288 + n0 + i] = cmx * (1.f / 127.f); }
    };
    auto cv_wq = [&](const int item, const int tid) __attribute__((always_inline)) {
        const int lane = tid & 63; const float* wq = IN(18); signed char* WQ8 = (signed char*)WSF(WS_WQT); float* SWQ = WSF(WS_SWQ); LAS unsigned* cm = (LAS unsigned*)((LAS unsigned char*)lds_raw + 140 * 1024);
        const int c4 = tid & 7, rg = tid >> 3; const int l = item >> 6, n0 = (item & 63) * 32 + 4 * c4;
        __syncthreads();
        if (tid < 32) cm[tid] = 0u;
        __syncthreads();
        const float* src = wq + ((size_t)l * DM + rg * 32) * DM + n0; float v[32][4]; float mx[4] = {0.f, 0.f, 0.f, 0.f};
#pragma unroll
        for (int j = 0; j < 32; ++j) { const float4 a = ldnt4(src + (size_t)j * DM); v[j][0] = a.x; v[j][1] = a.y; v[j][2] = a.z; v[j][3] = a.w; }
#pragma unroll
        for (int j = 0; j < 32; ++j) {
#pragma unroll
            for (int i = 0; i < 4; ++i) mx[i] = fmaxf(mx[i], fabsf(v[j][i])); }
#pragma unroll
        for (int i = 0; i < 4; ++i) { float m = mx[i]; m = fmaxf(m, SWZ_XOR(m, 8)); m = fmaxf(m, SWZ_XOR(m, 16));
            auto rr = __builtin_amdgcn_permlane32_swap(__float_as_uint(m), __float_as_uint(m), false, false); m = fmaxf(__uint_as_float(rr[0]), __uint_as_float(rr[1]));
            if (lane < 8) __hip_atomic_fetch_max(cm + 4 * c4 + i, __float_as_uint(m), __ATOMIC_RELAXED, __HIP_MEMORY_SCOPE_WORKGROUP); }
        __syncthreads();
#pragma unroll
        for (int i = 0; i < 4; ++i) { const float cmx = fmaxf(__uint_as_float(cm[4 * c4 + i]), 1e-30f), q = 127.f / cmx; unsigned w[8];
#pragma unroll
            for (int m = 0; m < 8; ++m) w[m] = pk_i8x4(v[4 * m][i] * q, v[4 * m + 1][i] * q, v[4 * m + 2][i] * q, v[4 * m + 3][i] * q);
            signed char* dst = WQ8 + ((size_t)l * DM + n0 + i) * DM + rg * 32;
            *(uint4*)dst = make_uint4(w[0], w[1], w[2], w[3]); *(uint4*)(dst + 16) = make_uint4(w[4], w[5], w[6], w[7]);
            if (rg == 0) SWQ[(size_t)l * DM + n0 + i] = cmx * (1.f / 127.f); }
    };
    auto cv_tr = [&](const int it, const int tid) __attribute__((always_inline)) {
        const int lane = tid & 63, wave = tid >> 6; float* scr = lds + wave * (64 * 33); const int l = it / 4096; int r = it % 4096;
        bf16_t* wbr = (bf16_t*)WSF(WS_WBRT) + (size_t)l * 3 * DM * 768;
        if (r < 768) { transpose_item<false>(IN(14) + (size_t)l * 768 * DM, DM, wbr, 768, scr, r / 64, r % 64, lane); return; } r -= 768;
        if (r < 768) { transpose_item<false>(IN(15) + (size_t)l * 768 * DM, DM, wbr + (size_t)DM * 768, 768, scr, r / 64, r % 64, lane); return; } r -= 768;
        if (r < 512) { transpose_item<false>(IN(16) + (size_t)l * 512 * DM, DM, wbr + (size_t)2 * DM * 768, 768, scr, r / 64, r % 64, lane); return; } r -= 512;
        transpose_item<false>(IN(17) + (size_t)l * DM * DM, DM, (bf16_t*)WSF(WS_WOT) + (size_t)l * DM * DM, DM, scr, r / 64, r % 64, lane);
    };
    auto cv_u = [&](const int r, const int tid) __attribute__((always_inline)) {
        const int lane = tid & 63; const float* pu = IN(20); signed char* U8 = (signed char*)WSF(WS_UB); float* SU = WSF(WS_SU);
        const float* src = pu + (size_t)r * DM; float4 v[8]; float mx = 0.f;
#pragma unroll
        for (int j = 0; j < 8; ++j) { v[j] = ldnt4(src + lane * 4 + 256 * j); mx = fmaxf(mx, fmaxf(fmaxf(fabsf(v[j].x), fabsf(v[j].y)), fmaxf(fabsf(v[j].z), fabsf(v[j].w)))); }
        mx = fmaxf(wave_max(mx), 1e-30f); const float q = 127.f / mx;
#pragma unroll
        for (int j = 0; j < 8; ++j) *(unsigned*)(U8 + (size_t)r * DM + lane * 4 + 256 * j) = pk_i8x4(v[j].x * q, v[j].y * q, v[j].z * q, v[j].w * q);
        if (lane == 0) SU[r] = mx * (1.f / 127.f);
    };
    auto cv_v = [&](const int item, const int tid) __attribute__((always_inline)) {
        const int lane = tid & 63, wave = tid >> 6; const float* pv = IN(21); float* DV = WSF(WS_DV); unsigned char* VT = (unsigned char*)WSF(WS_VT); LAS unsigned char* T = (LAS unsigned char*)lds_raw;
        const int l = item >> 8, eb = item & 255;
        __syncthreads();
#pragma unroll 2
        for (int i = 0; i < 8; ++i) { const int e = wave * 8 + i; const size_t r = (size_t)l * 16384 + eb * 64 + e; const float* src = pv + r * DM; float4 v[8]; float mx = 0.f;
#pragma unroll
            for (int j = 0; j < 8; ++j) { v[j] = ldnt4(src + lane * 4 + 256 * j); mx = fmaxf(mx, fmaxf(fmaxf(fabsf(v[j].x), fabsf(v[j].y)), fmaxf(fabsf(v[j].z), fabsf(v[j].w)))); }
            mx = fmaxf(wave_max(mx), 1e-30f); const float q = 127.f / mx;
#pragma unroll
            for (int j = 0; j < 8; ++j) *(LAS unsigned*)(T + e * 2048 + lane * 4 + 256 * j) = pk_i8x4(v[j].x * q, v[j].y * q, v[j].z * q, v[j].w * q);
            if (lane == 0) DV[r] = mx * (1.f / 127.f); }
        __syncthreads();
#pragma unroll
        for (int qd = 0; qd < 4; ++qd) { unsigned d[16];
#pragma unroll
            for (int e = 0; e < 16; ++e) d[e] = *(const LAS unsigned*)(T + (qd * 16 + e) * 2048 + tid * 4);
#pragma unroll
            for (int k = 0; k < 4; ++k) { unsigned o[4];
#pragma unroll
                for (int g = 0; g < 4; ++g) o[g] = ((d[4 * g] >> (8 * k)) & 0xffu) | (((d[4 * g + 1] >> (8 * k)) & 0xffu) << 8) | (((d[4 * g + 2] >> (8 * k)) & 0xffu) << 16) | (((d[4 * g + 3] >> (8 * k)) & 0xffu) << 24);
                *(uint4*)(VT + ((size_t)l * DM + tid * 4 + k) * 16384 + eb * 64 + qd * 16) = make_uint4(o[0], o[1], o[2], o[3]); } }
        __syncthreads();
    };

    { PHASE_VARS
    {
        const float* c_in = IN(1); const float* ada_w = IN(3); float* MODP = WSF(WS_MODP);
        float* cond = lds;
        for (int i = tid; i < NB * DM; i += NTHR) { const float c = c_in[i]; cond[i] = c / (1.f + expf(-c)); }
        __syncthreads();
        for (int item = gtid; item < 2 * 16 * (NMOD / 4); item += NGT) {
            const int j4 = item % (NMOD / 4), ch = (item / (NMOD / 4)) % 16, l = item / (16 * (NMOD / 4));
            float4 a0 = {0.f, 0.f, 0.f, 0.f}, a1 = {0.f, 0.f, 0.f, 0.f};
            const float* wp = ada_w + ((size_t)l * DM + ch * 128) * NMOD + j4 * 4;
            for (int k = 0; k < 128; ++k) { const float4 w = ldnt4(wp + (size_t)k * NMOD); const float c0 = cond[ch * 128 + k], c1 = cond[DM + ch * 128 + k];
                a0.x += c0 * w.x; a0.y += c0 * w.y; a0.z += c0 * w.z; a0.w += c0 * w.w; a1.x += c1 * w.x; a1.y += c1 * w.y; a1.z += c1 * w.z; a1.w += c1 * w.w; }
            *(float4*)(MODP + (((size_t)l * 16 + ch) * 2 + 0) * NMOD + j4 * 4) = a0;
            *(float4*)(MODP + (((size_t)l * 16 + ch) * 2 + 1) * NMOD + j4 * 4) = a1;
        }
        __syncthreads();
        for (int item = bid; item < 384; item += G) cv_win(item, tid);
        __syncthreads();
        { const int* pos_in = (const int*)IN(2); float* ROPE = WSF(WS_ROPE);
          for (int i = gtid; i < NT * 32; i += NGT) { const int t = i >> 5, k = i & 31; const float invf = exp2f(-(float)(2 * k) * (1.f / 64.f) * 13.287712379549449f);
              const float ang = (float)pos_in[t] * invf; ROPE[(size_t)i * 2] = cosf(ang); ROPE[(size_t)i * 2 + 1] = sinf(ang); } }
    }
    }
    GRID_BAR();
    { PHASE_VARS
    { const float* ada_b = IN(4); const float* MODP = WSF(WS_MODP); float* MOD = WSF(WS_MOD);
    for (int i = gtid; i < 2 * 2 * NMOD; i += NGT) { const int j = i % NMOD, b = (i / NMOD) % 2, l = i / (2 * NMOD); float s = ada_b[(size_t)l * NMOD + j];
        for (int ch = 0; ch < 16; ++ch) s += MODP[(((size_t)l * 16 + ch) * 2 + b) * NMOD + j];
        MOD[i] = s; } }
    }
    GRID_BAR();

#pragma clang loop unroll(full)
    for (int l = 0; l < DEPTH; ++l) {
        const float lam_init = 0.8f - 0.6f * expf(-0.3f * (float)l);
#define MODL (WSF(WS_MOD) + (size_t)l * 2 * NMOD)
        { PHASE_VARS
        { const float* modl = MODL; const float* norm1_g = IN(5); const void* X = (l == 0) ? (const void*)IN(0) : (const void*)WSF(WS_X); const bool xf32 = (l == 0); signed char* HQ = (signed char*)WSF(WS_HB); float* SH1 = WSF(WS_SH1); float* FL = WSF(WS_FL);
        float* wfl = lds;
        { const float* w_in = IN(7) + (size_t)l * DM * INW;
          float wv[24];
#pragma unroll
          for (int it = 0; it < 24; ++it) { const int i = tid + it * NTHR, k = i / 6, jj = i % 6; wv[it] = w_in[(size_t)k * INW + C_FL + jj]; }
#pragma unroll
          for (int it = 0; it < 24; ++it) { const int i = tid + it * NTHR, k = i / 6, jj = i % 6; wfl[jj * DM + k] = wv[it]; } }
        __syncthreads();
        for (int t = gw; t < NT; t += NGW) {
            const int b = t / SEQ; const float* g = norm1_g + (size_t)l * DM; const float* sh = modl + (size_t)b * NMOD; const float* sc = sh + DM;
            float4 v[8]; float ss = 0.f; int ln = lane; asm volatile("" : "+v"(ln));
#pragma unroll
            for (int j = 0; j < 8; ++j) { v[j] = ldx4(X, xf32, (size_t)t * DM + ln * 4 + 256 * j); ss += v[j].x * v[j].x + v[j].y * v[j].y + v[j].z * v[j].z + v[j].w * v[j].w; }
            const float r = rsqrtf(wave_sum(ss) * (1.f / DM) + RMS_EPS);
            float fl[6] = {0.f, 0.f, 0.f, 0.f, 0.f, 0.f}; float hmx = 0.f;
#pragma unroll
            for (int j = 0; j < 8; ++j) { const int d = ln * 4 + 256 * j; const float4 gg = *(const float4*)(g + d), s1 = *(const float4*)(sc + d), s0 = *(const float4*)(sh + d); float4 o;
                o.x = v[j].x * r * gg.x * (1.f + s1.x) + s0.x; o.y = v[j].y * r * gg.y * (1.f + s1.y) + s0.y; o.z = v[j].z * r * gg.z * (1.f + s1.z) + s0.z; o.w = v[j].w * r * gg.w * (1.f + s1.w) + s0.w;
                v[j] = o; hmx = fmaxf(hmx, fmaxf(fmaxf(fabsf(o.x), fabsf(o.y)), fmaxf(fabsf(o.z), fabsf(o.w))));
#pragma unroll
                for (int jj = 0; jj < 6; ++jj) { const float4 w4 = *(const float4*)(wfl + jj * DM + d); fl[jj] += o.x * w4.x + o.y * w4.y + o.z * w4.z + o.w * w4.w; } }
            hmx = fmaxf(wave_max(hmx), 1e-30f); const float hq = 127.f / hmx;
#pragma unroll
            for (int j = 0; j < 8; ++j) *(unsigned*)(HQ + (size_t)t * DM + ln * 4 + 256 * j) = pk_i8x4(v[j].x * hq, v[j].y * hq, v[j].z * hq, v[j].w * hq);
            if (lane == 0) SH1[t] = hmx * (1.f / 127.f);
#pragma unroll
            for (int jj = 0; jj < 6; ++jj) fl[jj] = wave_sum(fl[jj]);
            if (lane == 0) { *(float4*)(FL + (size_t)t * 8) = (float4){fl[0], fl[1], fl[2], fl[3]}; *(float2*)(FL + (size_t)t * 8 + 4) = (float2){fl[4], fl[5]}; }
        }
        __syncthreads(); }
        }
        GRID_BAR();
        { PHASE_VARS
        { const float* b_forget = IN(8); const float* FL = WSF(WS_FL); float* CUM = WSF(WS_CUM);
        if (bid < 12) {
            const int b = bid / 6, h = bid % 6; float* sc = lds;
            float loc[8]; float run = 0.f; const float bf = b_forget[l * 6 + h];
#pragma unroll
            for (int j = 0; j < 8; ++j) { const int s = tid * 8 + j; const float xl = FL[((size_t)b * SEQ + s) * 8 + h] + bf; run += fminf(xl, 0.f) - __logf(1.f + __expf(-fabsf(xl))); loc[j] = run; }
            sc[tid] = run; __syncthreads();
            for (int o = 1; o < NTHR; o <<= 1) { float v = 0.f; if (tid >= o) v = sc[tid - o]; __syncthreads(); sc[tid] += v; __syncthreads(); }
            const float off = (tid > 0) ? sc[tid - 1] : 0.f;
#pragma unroll
            for (int j = 0; j < 8; ++j) CUM[(size_t)bid * SEQ + tid * 8 + j] = (off + loc[j]) * 1.4426950408889634f;
            __syncthreads();
        } }
        { pg8::Gemm8 g{(const signed char*)WSF(WS_HB), (const signed char*)WSF(WS_WINT) + (size_t)l * 12288 * DM, NT, 12288, DM, DM, DM};
          pg8::StaticOrder S; S.init(NT, 12288, G, bid);
          EpiProj E{(bf16_t*)WSF(WS_ATT), (bf16_t*)WSF(WS_GATES), WSF(WS_ROPE), WSF(WS_SH1), WSF(WS_SW) + (size_t)l * 12288, (unsigned*)WSF(WS_CTL) + 12288 + 32 * l};
          pg8::gemm_phase_i8<EpiProj, pg8::StaticOrder, true, true>(tid, (LAS unsigned char*)lds_raw, g, S, E); }
        }
        GRID_BAR();
        { PHASE_VARS
        { const bf16_t* ATTp = (const bf16_t*)WSF(WS_ATT); const float* CUM = WSF(WS_CUM); bf16_t* O = (bf16_t*)WSF(WS_OB); float* ODF = WSF(WS_ODF);
          unsigned* qctr = (unsigned*)WSF(WS_CTL) + 8192 + 64 * l;
          const unsigned* KINFp = (const unsigned*)WSF(WS_CTL) + 12288 + 32 * l; unsigned char* Gzp = (unsigned char*)WSF(WS_G);
        const unsigned short* qtab = (l == 0) ? ATT_ITEMS0 : ATT_UNITS; const unsigned qlen = (l == 0) ? (unsigned)N_ATT_ITEMS0 : 640u;
        for (;;) {
            if (tid == 0) MISC[16] = __hip_atomic_fetch_add(qctr, 1u, __ATOMIC_RELAXED, __HIP_MEMORY_SCOPE_AGENT);
            __syncthreads();
            const unsigned rank = MISC[16];
            __syncthreads();
            if (rank >= qlen) break;
            const unsigned uu = qtab[rank];
            int tid_u = tid; asm volatile("" : "+v"(tid_u));
            if (l == 0 && (uu & 0x8000u)) {
                const int ty = (uu >> 12) & 7, ix = uu & 0xfff, wave_u = tid_u >> 6;
                if (ty == 0) cv_win(384 + ix, tid_u);
                else if (ty == 1) cv_wq(ix, tid_u);
                else if (ty == 2) { for (int k = 0; k < 8; ++k) cv_tr(ix * 64 + k * 8 + wave_u, tid_u); }
                else if (ty == 3) { for (int k = 0; k < 32; ++k) cv_u(ix * 256 + k * 8 + wave_u, tid_u); }
                else cv_v(ix, tid_u);
                __syncthreads();
                continue; }
            const int mode = (uu >> 12) & 3, b = (uu >> 11) & 1, h = (uu >> 4) & 7, qb = uu & 15;
            const unsigned zid = (mode < 2) ? (unsigned)(mode * 192 + (b * 6 + h) * 16 + qb) : (unsigned)(384 + (mode - 2) * 128 + (b * 4 + h) * 16 + qb);
            if (mode == 0) att::attn_unit<0>(tid_u, (char*)lds_raw, ATTp, CUM, O, ODF, b, h, qb, KINFp, Gzp, zid);
            else if (mode == 1) att::attn_unit<1>(tid_u, (char*)lds_raw, ATTp, nullptr, O, ODF, b, h, qb, KINFp, Gzp, zid);
            else if (mode == 2) att::attn_unit<2>(tid_u, (char*)lds_raw, ATTp, nullptr, O, ODF, b, h, qb, KINFp, Gzp, zid);
            else att::attn_unit<3>(tid_u, (char*)lds_raw, ATTp, nullptr, O, ODF, b, h, qb, KINFp, Gzp, zid);
        } }
        }
        GRID_BAR();
        { PHASE_VARS
        { const float* ODF = WSF(WS_ODF); bf16_t* O = (bf16_t*)WSF(WS_OB); const float* lam_q1 = IN(9); const float* lam_k1 = IN(10); const float* lam_q2 = IN(11); const float* lam_k2 = IN(12); const float* subg = IN(13) + l * 128;
          float lamh[4];
#pragma unroll
          for (int h = 0; h < 4; ++h) { float d1 = 0.f, d2 = 0.f; for (int i = 0; i < 64; ++i) { d1 += lam_q1[(l * 4 + h) * 64 + i] * lam_k1[(l * 4 + h) * 64 + i]; d2 += lam_q2[(l * 4 + h) * 64 + i] * lam_k2[(l * 4 + h) * 64 + i]; }
              lamh[h] = expf(d1) - expf(d2) + lam_init; }
        for (int t = gw; t < NT; t += NGW) {
            const int hq = lane >> 4; const float lam = hq == 0 ? lamh[0] : hq == 1 ? lamh[1] : hq == 2 ? lamh[2] : lamh[3];
            const float4 a0 = *(const float4*)(ODF + (size_t)t * 512 + lane * 8), a1 = *(const float4*)(ODF + (size_t)t * 512 + lane * 8 + 4);
            const float4 b0 = *(const float4*)(ODF + ((size_t)NT + t) * 512 + lane * 8), b1 = *(const float4*)(ODF + ((size_t)NT + t) * 512 + lane * 8 + 4);
            float v[8] = {a0.x - lam * b0.x, a0.y - lam * b0.y, a0.z - lam * b0.z, a0.w - lam * b0.w, a1.x - lam * b1.x, a1.y - lam * b1.y, a1.z - lam * b1.z, a1.w - lam * b1.w}; float ss = 0.f;
#pragma unroll
            for (int i = 0; i < 8; ++i) ss += v[i] * v[i];
            ss += __shfl_xor(ss, 1); ss += __shfl_xor(ss, 2); ss += __shfl_xor(ss, 4); ss += __shfl_xor(ss, 8);
            const float rr = rsqrtf(ss * (1.f / 128.f) + RMS_EPS) * (1.f - lam_init); const int dd = (lane & 15) * 8;
            const float4 g0 = *(const float4*)(subg + dd), g1 = *(const float4*)(subg + dd + 4);
            pg8::u32x4 w; w.x = pg8::cvt_pk_bf16(v[0] * rr * g0.x, v[1] * rr * g0.y); w.y = pg8::cvt_pk_bf16(v[2] * rr * g0.z, v[3] * rr * g0.w); w.z = pg8::cvt_pk_bf16(v[4] * rr * g1.x, v[5] * rr * g1.y); w.w = pg8::cvt_pk_bf16(v[6] * rr * g1.z, v[7] * rr * g1.w);
            *(pg8::u32x4*)(O + (size_t)t * DM + 1536 + lane * 8) = w;
        } }
        }
        GRID_BAR();
        { PHASE_VARS
        { pg8::Gemm g{(const bf16_t*)WSF(WS_OB), (const bf16_t*)WSF(WS_WBRT) + (size_t)l * 3 * DM * 768, NT, DM, 768, DM, 768}; pg8::BranchOrder S; S.init(NT, DM, G, bid);
          EpiBranchCarry E{(bf16_t*)WSF(WS_YB), (const bf16_t*)WSF(WS_GATES)};
          pg8::gemm_phase<EpiBranchCarry, pg8::BranchOrder, true, true>(tid, (LAS unsigned char*)lds_raw, g, S, E); }
        }
        GRID_BAR();
        { PHASE_VARS
        { pg8::Gemm g{(const bf16_t*)WSF(WS_YB), (const bf16_t*)WSF(WS_WOT) + (size_t)l * DM * DM, NT, DM, DM, DM, DM}; pg8::StaticOrder S; S.init(NT, DM, G, bid);
          EpiResidM E{(bf16_t*)WSF(WS_X), MODL + 2 * DM, (l == 0) ? (const void*)IN(0) : (const void*)WSF(WS_X), l == 0};
          pg8::gemm_phase<EpiResidM, pg8::StaticOrder, true, true>(tid, (LAS unsigned char*)lds_raw, g, S, E); }
        }
        GRID_BAR();
        { PHASE_VARS
        { const float* modl = MODL; const float* norm2_g = IN(6); const void* X = WSF(WS_X); signed char* HB8 = (signed char*)WSF(WS_HB8); float* SH = WSF(WS_SH);
        for (int t = gw; t < NT; t += NGW) {
            const int b = t / SEQ; const float* g = norm2_g + (size_t)l * DM; const float* sh = modl + (size_t)b * NMOD + 3 * DM; const float* sc = sh + DM;
            float4 v[8]; float ss = 0.f;
#pragma unroll
            for (int j = 0; j < 8; ++j) { v[j] = ldx4(X, false, (size_t)t * DM + lane * 4 + 256 * j); ss += v[j].x * v[j].x + v[j].y * v[j].y + v[j].z * v[j].z + v[j].w * v[j].w; }
            const float r = rsqrtf(wave_sum(ss) * (1.f / DM) + RMS_EPS);
            float hmx = 0.f;
#pragma unroll
            for (int j = 0; j < 8; ++j) { const int d = lane * 4 + 256 * j; const float4 gg = *(const float4*)(g + d), s1 = *(const float4*)(sc + d), s0 = *(const float4*)(sh + d); float4 o;
                o.x = v[j].x * r * gg.x * (1.f + s1.x) + s0.x; o.y = v[j].y * r * gg.y * (1.f + s1.y) + s0.y; o.z = v[j].z * r * gg.z * (1.f + s1.z) + s0.z; o.w = v[j].w * r * gg.w * (1.f + s1.w) + s0.w;
                v[j] = o; hmx = fmaxf(hmx, fmaxf(fmaxf(fabsf(o.x), fabsf(o.y)), fmaxf(fabsf(o.z), fabsf(o.w)))); }
            hmx = fmaxf(wave_max(hmx), 1e-30f); const float hq = 127.f / hmx;
#pragma unroll
            for (int j = 0; j < 8; ++j) *(unsigned*)(HB8 + (size_t)t * DM + lane * 4 + 256 * j) = pk_i8x4(v[j].x * hq, v[j].y * hq, v[j].z * hq, v[j].w * hq);
            if (lane == 0) SH[t] = hmx * (1.f / 127.f);
        } }
        }
        GRID_BAR();
        { PHASE_VARS
        { pg8::Gemm8 g{(const signed char*)WSF(WS_HB8), (const signed char*)WSF(WS_WQT) + (size_t)l * DM * DM, NT, DM, DM, DM, DM}; pg8::StaticOrder S; S.init(NT, DM, G, bid);
          EpiStoreI8 E{WSF(WS_PQ), DM, WSF(WS_SH), WSF(WS_SWQ) + (size_t)l * DM};
          pg8::gemm_phase_i8<EpiStoreI8, pg8::StaticOrder, true, true>(tid, (LAS unsigned char*)lds_raw, g, S, E); }
        }
        { PHASE_VARS
        asm volatile("s_waitcnt vmcnt(0)" ::: "memory"); __syncthreads();
        {
            pg8::Unit uq; { pg8::StaticOrder S; S.init(NT, DM, G, bid); if (!S.next(0, uq)) { uq.pm = 0; uq.pn = 0; } }
            const float* peer_keys = IN(19); const float* PQ = WSF(WS_PQ); int* EIDX = (int*)WSF(WS_EIDX); float* GATE = WSF(WS_GATE);
            const int hh = uq.pn;
            char* imgs = (char*)lds_raw;
            for (int c = tid; c < 4096; c += NTHR) { const int p = c >> 11, k = (c >> 4) & 127, ch = c & 15;
                const float* src = peer_keys + ((((size_t)l * 8 + hh) * 2 + p) * 128 + k) * 128 + ch * 8; const float4 a = *(const float4*)src, b2 = *(const float4*)(src + 4);
                const float f[8] = {a.x, a.y, a.z, a.w, b2.x, b2.y, b2.z, b2.w}; unsigned hw[4], lw[4];
#pragma unroll
                for (int e = 0; e < 4; ++e) { const unsigned h2 = att::cvtpk(f[2 * e], f[2 * e + 1]); hw[e] = h2; lw[e] = att::cvtpk(f[2 * e] - __uint_as_float(h2 << 16), f[2 * e + 1] - __uint_as_float(h2 & 0xffff0000u)); }
                char* dst = imgs + ((p * 2 + (k >> 6)) * 2) * 16384 + (k & 63) * 256 + ((ch * 16) ^ (((k & 63) & 7) << 4));
                *(att::u32x4*)dst = (att::u32x4){hw[0], hw[1], hw[2], hw[3]}; *(att::u32x4*)(dst + 16384) = (att::u32x4){lw[0], lw[1], lw[2], lw[3]}; }
            __syncthreads();
            const int wid = __builtin_amdgcn_readfirstlane(tid >> 6), r32 = lane & 31, hi = lane >> 5;
            if (bid < (NT / 256) * (DM / 256)) { const int tg = uq.pm * 8 + wid;
                const int t = tg * 32 + r32; const float* q = PQ + (size_t)t * DM + hh * 256;
                unsigned w1[16], w2[16];
                topk::half_top16(q, imgs, r32, hi, w1);
                topk::half_top16(q + 128, imgs + 65536, r32, hi, w2);
                float bv[16]; unsigned bp[16];
                topk::combine_top16(w1, w2, hi, bv, bp);
                const float mx = bv[0]; float es = 0.f; float ge[16];
#pragma unroll
                for (int r = 0; r < 16; ++r) { ge[r] = __expf(bv[r] - mx); es += ge[r]; }
                const float inv = 1.f / es;
                if (hi == 0) { int* ep = EIDX + (size_t)t * PE_E + hh * PE_TOP; float* gp = GATE + (size_t)t * PE_E + hh * PE_TOP;
#pragma unroll
                    for (int r4 = 0; r4 < 4; ++r4) { *(int4*)(ep + 4 * r4) = make_int4((int)bp[4 * r4], (int)bp[4 * r4 + 1], (int)bp[4 * r4 + 2], (int)bp[4 * r4 + 3]);
                        *(float4*)(gp + 4 * r4) = make_float4(ge[4 * r4] * inv, ge[4 * r4 + 1] * inv, ge[4 * r4 + 2] * inv, ge[4 * r4 + 3] * inv); } }
            }
            __syncthreads();
        }
        }
        GRID_BAR();
        { PHASE_VARS
        { int* EIDX = (int*)WSF(WS_EIDX); const float* GATE = WSF(WS_GATE); unsigned char* Sm = (unsigned char*)WSF(WS_G); float* GMg = WSF(WS_GM); float* ACTF = WSF(WS_ACTF); const float* DV = WSF(WS_DV) + (size_t)l * 16384;
        for (int t = gw; t < NT; t += NGW) {
            const int e0 = EIDX[(size_t)t * PE_E + lane], e1 = EIDX[(size_t)t * PE_E + 64 + lane]; const float g0 = GATE[(size_t)t * PE_E + lane], g1 = GATE[(size_t)t * PE_E + 64 + lane];
            unsigned long long m00 = ~0ull, m01 = ~0ull, m10 = ~0ull, m11 = ~0ull;
#pragma unroll
            for (int bb = 0; bb < 14; ++bb) { const bool q0 = (e0 >> bb) & 1, q1 = (e1 >> bb) & 1; const unsigned long long B0 = __ballot(q0), B1 = __ballot(q1), x0 = q0 ? ~0ull : 0ull, x1 = q1 ? ~0ull : 0ull;
                m00 &= ~(B0 ^ x0); m01 &= ~(B1 ^ x0); m10 &= ~(B0 ^ x1); m11 &= ~(B1 ^ x1); }
            const unsigned long long ltm = (1ull << lane) - 1ull;
            const bool f0 = (m00 & ltm) == 0ull, f1 = (m10 == 0ull) && ((m11 & ltm) == 0ull);
            float s0 = 0.f, s1 = 0.f;
            for (unsigned long long r = m00; __any(r != 0ull); ) { const bool has = r != 0ull; const int k = has ? __builtin_ctzll(r) : 0; const float gk = __shfl(g0, k); if (has) { s0 += gk; r &= r - 1ull; } }
            for (unsigned long long r = m01; __any(r != 0ull); ) { const bool has = r != 0ull; const int k = has ? __builtin_ctzll(r) : 0; const float gk = __shfl(g1, k); if (has) { s0 += gk; r &= r - 1ull; } }
            for (unsigned long long r = m10; __any(r != 0ull); ) { const bool has = r != 0ull; const int k = has ? __builtin_ctzll(r) : 0; const float gk = __shfl(g0, k); if (has) { s1 += gk; r &= r - 1ull; } }
            for (unsigned long long r = m11; __any(r != 0ull); ) { const bool has = r != 0ull; const int k = has ? __builtin_ctzll(r) : 0; const float gk = __shfl(g1, k); if (has) { s1 += gk; r &= r - 1ull; } }
            if (f0) { Sm[gaddr(t, e0)] = (unsigned char)(lane + 1); GMg[(size_t)t * PE_E + lane] = s0 * DV[e0]; } else { EIDX[(size_t)t * PE_E + lane] = -1; ACTF[(size_t)t * PE_E + lane] = 0.f; }
            if (f1) { Sm[gaddr(t, e1)] = (unsigned char)(64 + lane + 1); GMg[(size_t)t * PE_E + 64 + lane] = s1 * DV[e1]; } else { EIDX[(size_t)t * PE_E + 64 + lane] = -1; ACTF[(size_t)t * PE_E + 64 + lane] = 0.f; }
        } }
        }
        GRID_BAR();
        { PHASE_VARS
        { pg8::Gemm8 g{(const signed char*)WSF(WS_HB8), (const signed char*)WSF(WS_UB) + (size_t)l * 16384 * DM, NT, 16384, DM, DM, DM}; pg8::StaticOrder S; S.init(NT, 16384, G, bid);
          EpiPeerHid E{(const unsigned char*)WSF(WS_G), WSF(WS_SH), WSF(WS_SU) + (size_t)l * 16384, WSF(WS_ACTF)};
          pg8::gemm_phase_i8<EpiPeerHid, pg8::StaticOrder, true, true>(tid, (LAS unsigned char*)lds_raw, g, S, E); }
        }
        GRID_BAR();
        { PHASE_VARS
        { const int* EIDX = (const int*)WSF(WS_EIDX); const float* ACTF = WSF(WS_ACTF); const float* GMg = WSF(WS_GM); signed char* A8 = (signed char*)WSF(WS_G); float* SA = WSF(WS_SA);
        for (int t = gw; t < NT; t += NGW) {
            const int e0 = EIDX[(size_t)t * PE_E + lane], e1 = EIDX[(size_t)t * PE_E + 64 + lane];
            const float a0 = (e0 >= 0) ? GMg[(size_t)t * PE_E + lane] * gelu_erf(ACTF[(size_t)t * PE_E + lane]) : 0.f, a1 = (e1 >= 0) ? GMg[(size_t)t * PE_E + 64 + lane] * gelu_erf(ACTF[(size_t)t * PE_E + 64 + lane]) : 0.f;
            const float mx = fmaxf(wave_max(fmaxf(fabsf(a0), fabsf(a1))), 1e-30f), q = 127.f / mx;
            if (e0 >= 0) A8[gaddr(t, e0)] = (signed char)(int)rintf(a0 * q);
            if (e1 >= 0) A8[gaddr(t, e1)] = (signed char)(int)rintf(a1 * q);
            if (lane == 0) SA[t] = mx * (1.f / 127.f);
        } }
        }
        GRID_BAR();
        { PHASE_VARS
        { pg8::Gemm8 g{(const signed char*)WSF(WS_G), (const signed char*)WSF(WS_VT) + (size_t)l * DM * 16384, NT, DM, 16384, 256, 16384}; pg8::StaticOrder S; S.init(NT, DM, G, bid);
          EpiResidI8 E{(bf16_t*)WSF(WS_X), MODL + 5 * DM, WSF(WS_SA)};
          pg8::gemm_phase_i8<EpiResidI8, pg8::StaticOrder, true, true, true>(tid, (LAS unsigned char*)lds_raw, g, S, E); }
        }
        GRID_BAR();
    }
    { PHASE_VARS
    { const void* X = WSF(WS_X); const float* final_g = IN(22); float* outp = (float*)IN(23);
    for (int t = gw; t < NT; t += NGW) {
        float4 v[8]; float ss = 0.f;
#pragma unroll
        for (int j = 0; j < 8; ++j) { v[j] = ldx4(X, false, (size_t)t * DM + lane * 4 + 256 * j); ss += v[j].x * v[j].x + v[j].y * v[j].y + v[j].z * v[j].z + v[j].w * v[j].w; }
        const float r = rsqrtf(wave_sum(ss) * (1.f / DM) + RMS_EPS);
#pragma unroll
        for (int j = 0; j < 8; ++j) { const int d = lane * 4 + 256 * j; const float4 gg = *(const float4*)(final_g + d); float4 o;
            o.x = v[j].x * r * gg.x; o.y = v[j].y * r * gg.y; o.z = v[j].z * r * gg.z; o.w = v[j].w * r * gg.w; *(float4*)(outp + (size_t)t * DM + d) = o; }
    } }
    }
}

extern "C" void kernel_launch(void* const* d_in, const int* in_sizes, int n_in, void* d_out, int out_size, void* d_ws, size_t ws_size, hipStream_t stream) {
    static int grid = 0;
    if (grid == 0) {
        if (n_in != 23 || out_size != NT * DM || ws_size < WS_END) { fprintf(stderr, "kernel_launch: unexpected shapes: n_in %d out %d ws %zu (need %zu)\n", n_in, out_size, ws_size, (size_t)WS_END); grid = -1; return; }
        int dev = 0, cus = 0;
        if (hipGetDevice(&dev) != hipSuccess || hipDeviceGetAttribute(&cus, hipDeviceAttributeMultiprocessorCount, dev) != hipSuccess) { grid = -1; return; }
        if (hipFuncSetAttribute((const void*)fwd_kernel, hipFuncAttributeMaxDynamicSharedMemorySize, LDS_BYTES) != hipSuccess) { fprintf(stderr, "kernel_launch: hipFuncSetAttribute failed\n"); grid = -1; return; }
        int per_cu = 0;
        if (hipOccupancyMaxActiveBlocksPerMultiprocessor(&per_cu, (const void*)fwd_kernel, NTHR, LDS_BYTES) != hipSuccess || per_cu < 1) { fprintf(stderr, "kernel_launch: occupancy query says %d\n", per_cu); (void)hipGetLastError(); grid = -1; return; }
        grid = cus;
        if (grid % 8 != 0) grid -= grid % 8;
    }
    if (grid < 0) return;
    (void)hipMemsetAsync((char*)d_ws + WS_CTL, 0, CTL_ZERO_BYTES, stream);
    Args a{};
    for (int i = 0; i < 23; ++i) a.in[i] = (const float*)d_in[i];
    a.out = (float*)d_out; a.ws = (unsigned char*)d_ws;
    hipLaunchKernelGGL(fwd_kernel, dim3(grid), dim3(NTHR), LDS_BYTES, stream, a);
}
```

```cpp
#include <hip/hip_runtime.h>
#include <cstdio>
#include <cstdint>

#define LAS __attribute__((address_space(3)))
#define GAS __attribute__((address_space(1)))

constexpr int NB = 2, SEQ = 4096, DM = 2048, NT = NB * SEQ, DEPTH = 2;
constexpr int INW = 12294;
constexpr int C_FQ = 0, C_FK = 768, C_FV = 1536, C_SQ = 2304, C_SK = 3072, C_SV = 3840, C_DQ = 4608, C_DK = 5120, C_DV = 5632, C_FL = 6144, C_GF = 6150, C_GS = 8198, C_GD = 10246;
constexpr int NMOD = 6 * DM;
constexpr int PE_H = 8, PE_K = 128, PE_TOP = 16, PE_E = PE_H * PE_TOP;
constexpr float RMS_EPS = 1e-6f;

constexpr size_t MiB = 1u << 20;
constexpr size_t WS_CTL = 0, CTL_ZERO_BYTES = 1 * MiB;
constexpr size_t WS_X = 1 * MiB;
constexpr size_t WS_HB = WS_X + (size_t)NT * DM * 4;
constexpr size_t WS_ATT = WS_HB + (size_t)NT * DM * 2;
constexpr size_t WS_GATES = WS_ATT + (size_t)NT * 6144 * 2;
constexpr size_t WS_Y = WS_GATES + (size_t)NT * 6144 * 2;
constexpr size_t WS_G = WS_Y;
constexpr size_t WS_PQ = WS_G + (size_t)NT * 16384;
constexpr size_t WS_WINT = WS_PQ + (size_t)NT * DM * 4;
constexpr size_t WS_WBRT = WS_WINT + (size_t)2 * 12288 * DM * 2;
constexpr size_t WS_WOT = WS_WBRT + (size_t)2 * 3 * DM * 768 * 2;
constexpr size_t WS_WQT = WS_WOT + (size_t)2 * DM * DM * 2;
constexpr size_t WS_OB = WS_WQT + (size_t)2 * DM * DM * 2;
constexpr size_t WS_YB = WS_OB + (size_t)NT * DM * 2;
constexpr size_t WS_UB = WS_YB + (size_t)NT * DM * 2;
constexpr size_t WS_VT = WS_UB + (size_t)2 * 16384 * DM * 2;
constexpr size_t WS_ROPE = WS_VT + (size_t)2 * 16384 * DM * 2;
constexpr size_t WS_FL = WS_ROPE + (size_t)NT * 64 * 4;
constexpr size_t WS_CUM = WS_FL + (size_t)NT * 8 * 4;
constexpr size_t WS_MODP = WS_CUM + (size_t)12 * SEQ * 4;
constexpr size_t WS_MOD = WS_MODP + (size_t)2 * 16 * 2 * NMOD * 4;
constexpr size_t WS_EIDX = WS_MOD + (size_t)2 * 2 * NMOD * 4;
constexpr size_t WS_GATE = WS_EIDX + (size_t)NT * PE_E * 4;
constexpr size_t WS_HB8 = WS_GATE + (size_t)NT * PE_E * 4;
constexpr size_t WS_SH = WS_HB8 + (size_t)NT * DM;
constexpr size_t WS_SU = WS_SH + (size_t)NT * 4;
constexpr size_t WS_DV = WS_SU + (size_t)2 * 16384 * 4;
constexpr size_t WS_GM = WS_DV + (size_t)2 * 16384 * 4;
constexpr size_t WS_ACTF = WS_GM + (size_t)NT * PE_E * 4;
constexpr size_t WS_SA = WS_ACTF + (size_t)NT * PE_E * 4;
constexpr size_t WS_SW = WS_SA + (size_t)NT * 4;
constexpr size_t WS_SH1 = WS_SW + (size_t)2 * 12288 * 4;
constexpr size_t WS_SWQ = WS_SH1 + (size_t)NT * 4;
constexpr size_t WS_ODF = WS_SWQ + (size_t)2 * DM * 4;
constexpr size_t WS_END = WS_ODF + (size_t)2 * NT * 512 * 4;
static_assert(WS_END <= (size_t)1024 * MiB, "workspace map exceeds the guaranteed 1 GiB");

constexpr int CW_BAR = 4096;
constexpr int NWAVES = 8, NTHR = NWAVES * 64;
constexpr int LDS_BYTES = 147456;
constexpr int MISC_OFF = 144 * 1024 - 1024;

#define XB_TMO      128
#define XB_XCNT(j)  (256  + 64 * (j))
#define XB_XSUB(j)  (1280 + 64 * (j))
#define XB_XGEN(j)  (2304 + 64 * (j))
#define XB_TOP      3328
#define XB_TOPGEN   3392
#define XCD_BAR_WORDS 3456
#define XB_SPIN_CAP (1u << 18)

__device__ __forceinline__ unsigned xb_ld(unsigned* p)              { return __hip_atomic_load(p, __ATOMIC_RELAXED, __HIP_MEMORY_SCOPE_AGENT); }
__device__ __forceinline__ unsigned xb_add(unsigned* p, unsigned v) { return __hip_atomic_fetch_add(p, v, __ATOMIC_RELAXED, __HIP_MEMORY_SCOPE_AGENT); }
__device__ __forceinline__ unsigned xb_xcc_id() { return (unsigned)__builtin_amdgcn_s_getreg((3 << 11) | 20) & 0xFu; }
#define XB_SPIN(cond, bar) do { unsigned _sp = 0; while (cond) { __builtin_amdgcn_s_sleep(1); \
    if ((++_sp & 255u) == 0u) { if (xb_ld(&(bar)[XB_TMO])) break; if (_sp > XB_SPIN_CAP) { atomicAdd(&(bar)[XB_TMO], 1u); break; } } } } while (0)

struct XcdBarrier { unsigned* bar; unsigned x; volatile LAS unsigned* st; };

__device__ __forceinline__ XcdBarrier xcd_barrier_post(unsigned* bar, volatile LAS unsigned* st) {
    XcdBarrier b; b.bar = bar; b.x = xb_xcc_id(); b.st = st;
    if (threadIdx.x == 0) (void)xb_add(&bar[XB_XCNT(b.x)], 1u);
    return b;
}
__device__ __forceinline__ void xcd_barrier_complete(unsigned* bar, unsigned x, unsigned& nloc, unsigned& nx) {
    const unsigned G = gridDim.x * gridDim.y * gridDim.z;
    unsigned sum, cnt, mine, sp = 0u;
    for (;;) {
        sum = 0u; cnt = 0u; mine = 0u;
#pragma unroll
        for (unsigned j = 0; j < 16; ++j) { const unsigned c = xb_ld(&bar[XB_XCNT(j)]); sum += c; cnt += (c > 0u) ? 1u : 0u; mine = (j == x) ? c : mine; }
        if (sum == G) break;
        __builtin_amdgcn_s_sleep(1);
        if ((++sp & 255u) == 0u) { if (xb_ld(&bar[XB_TMO])) break; if (sp > XB_SPIN_CAP) { atomicAdd(&bar[XB_TMO], 1u); break; } }
    }
    nloc = mine > 0u ? mine : 1u; nx = cnt > 0u ? cnt : 1u;
}
__device__ __forceinline__ void xcd_barrier(const XcdBarrier& b, const bool thread0) {
    asm volatile("s_waitcnt vmcnt(0)" ::: "memory");
    __syncthreads();
    if (thread0) {
        unsigned* bar = b.bar;
        __builtin_amdgcn_s_waitcnt(0);
        unsigned nloc = b.st[0], nx = b.st[1];
        if (nloc == 0u) { xcd_barrier_complete(bar, b.x, nloc, nx); b.st[0] = nloc; b.st[1] = nx; }
        const unsigned old = xb_add(&bar[XB_XSUB(b.x)], 1u);
        const unsigned gen = old / nloc;
        if (old + 1u == (gen + 1u) * nloc) {
            __builtin_amdgcn_fence(__ATOMIC_RELEASE, "agent");
            asm volatile("s_waitcnt vmcnt(0)" ::: "memory");
            const unsigned og = xb_add(&bar[XB_TOP], 1u);
            const unsigned tg = og / nx;
            if (og + 1u == (tg + 1u) * nx) xb_add(&bar[XB_TOPGEN], 1u);
            else XB_SPIN(xb_ld(&bar[XB_TOPGEN]) == tg, bar);
            __builtin_amdgcn_fence(__ATOMIC_ACQUIRE, "agent");
            xb_add(&bar[XB_XGEN(b.x)], 1u);
            asm volatile("s_waitcnt vmcnt(0)" ::: "memory");
        } else {
            XB_SPIN(xb_ld(&bar[XB_XGEN(b.x)]) == gen, bar);
            __builtin_amdgcn_fence(__ATOMIC_ACQUIRE, "agent");
            asm volatile("s_waitcnt vmcnt(0)" ::: "memory");
        }
    }
    __syncthreads();
}

#define SWZ_XOR(v, m) __int_as_float(__builtin_amdgcn_ds_swizzle(__float_as_int(v), ((m) << 10) | 0x1f))
__device__ __forceinline__ float wave_sum(float v) {
    v += SWZ_XOR(v, 1); v += SWZ_XOR(v, 2); v += SWZ_XOR(v, 4); v += SWZ_XOR(v, 8); v += SWZ_XOR(v, 16);
    auto rr = __builtin_amdgcn_permlane32_swap(__float_as_uint(v), __float_as_uint(v), false, false); return __uint_as_float(rr[0]) + __uint_as_float(rr[1]);
}
__device__ __forceinline__ float logsig(float x) { return fminf(x, 0.f) - log1pf(expf(-fabsf(x))); }
__device__ __forceinline__ float gelu_erf(float x) { return 0.5f * x * (1.f + erff(x * 0.70710678118654752f)); }

__device__ __forceinline__ const float* ldp(volatile LAS unsigned* tab0, int i) {
    unsigned a = (unsigned)(unsigned long long)tab0; asm volatile("" : "+v"(a));
    volatile LAS unsigned* tab = (volatile LAS unsigned*)(unsigned long long)a;
    unsigned lo = tab[2 * i], hi = tab[2 * i + 1];
    lo = __builtin_amdgcn_readfirstlane(lo); hi = __builtin_amdgcn_readfirstlane(hi);
    return (const float*)(const GAS float*)(((unsigned long long)hi << 32) | lo);
}
typedef float vf4_ __attribute__((ext_vector_type(4)));
typedef float vf2_ __attribute__((ext_vector_type(2)));
__device__ __forceinline__ float4 ldnt4(const float* p) { const vf4_ v = __builtin_nontemporal_load((const vf4_*)p); return make_float4(v[0], v[1], v[2], v[3]); }
__device__ __forceinline__ float2 ldnt2(const float* p) { const vf2_ v = __builtin_nontemporal_load((const vf2_*)p); return make_float2(v[0], v[1]); }
__device__ __forceinline__ float ldnt1(const float* p) { return __builtin_nontemporal_load(p); }
__device__ __forceinline__ float4 ldx4(const void* X, const bool f32, const size_t idx) {
    if (f32) return *(const float4*)((const float*)X + idx);
    const uint2 w = *(const uint2*)((const unsigned short*)X + idx);
    return make_float4(__uint_as_float(w.x << 16), __uint_as_float(w.x & 0xffff0000u), __uint_as_float(w.y << 16), __uint_as_float(w.y & 0xffff0000u));
}
__device__ __forceinline__ size_t gaddr(const int t, const int e) { return ((((size_t)(t >> 8) * 64 + (size_t)(e >> 8)) * 256 + (size_t)(t & 255)) * 256) + (size_t)(e & 255); }
struct Args {
    const float* in[23];
    float* out; unsigned char* ws;
};

namespace pg8 {
#define PG8_LAS __attribute__((address_space(3)))
typedef unsigned short bf16_t;
typedef short bf16x8 __attribute__((ext_vector_type(8)));
typedef float f32x4 __attribute__((ext_vector_type(4)));
typedef unsigned u32x4 __attribute__((ext_vector_type(4)));
constexpr int BM = 256, BK = 64, HALF = 128, HTB = HALF * BK * 2  , STAGE_BYTES = 8 * HTB, NXCD = 8, WGM = 8;

__host__ __device__ __forceinline__ int lds_byte(int r, int c) { const int st = (r >> 4) * 2 + (c >> 5), rr = r & 15, cc = c & 31, ob = rr * 64 + cc * 2; return st * 1024 + (ob ^ (((ob >> 9) & 1) << 5)); }
__host__ __device__ __forceinline__ void stage_rc(int b, int& R, int& C) { const int st = b / 1024, sb = b % 1024, swz = sb ^ (((sb >> 9) & 1) << 5); R = (st >> 1) * 16 + swz / 64; C = (st & 1) * 32 + (swz % 64) / 2; }
__host__ __device__ __forceinline__ int perm32(int rho) { const int n = rho >> 4, i = rho & 15; return 8 * (i >> 2) + 4 * n + (i & 3); }

struct Unit { int pm, pn; };
struct Gemm { const bf16_t* A; const bf16_t* Bt; int M, N, K, lda, ldb; };

struct StaticOrder {
    int nM, nN, nwg, G, c;
    __host__ __device__ __forceinline__ void init(int M, int N, int G_, int c_) { nM = M / BM; nN = N / BM; nwg = nM * nN; G = G_; c = c_; }
    __host__ __device__ __forceinline__ bool next(int i, Unit& u) const {
        const long L = (long)i * G + c; if (L >= nwg) return false;
        int wgid = (int)L; { const int q = nwg / NXCD, r = nwg % NXCD, xcd = wgid % NXCD, off = wgid / NXCD; wgid = (xcd < r ? xcd * (q + 1) : r * (q + 1) + (xcd - r) * q) + off; }
        const int nig = WGM * nN, gid = wgid / nig, fm = gid * WGM, gsz = (nM - fm) < WGM ? (nM - fm) : WGM;
        u.pm = fm + ((wgid % nig) % gsz); u.pn = (wgid % nig) / gsz; return true;
    }
    __device__ __forceinline__ void a_ready(const Unit&) const {}
    __device__ __forceinline__ void done(const Unit&) const {}
    __device__ __forceinline__ size_t a_byte(const Unit& u, size_t tstep) const { return (size_t)u.pm * tstep; }
    __device__ __forceinline__ size_t b_byte(const Unit& u, size_t tstep) const { return (size_t)u.pn * tstep; }
    __device__ __forceinline__ int ktiles(const Unit&, int nt) const { return nt; }
};
struct BranchOrder {
    StaticOrder base;
    __device__ void init(int M, int N, int G_, int c_) { base.init(M, N, G_, c_); }
    __device__ bool next(int i, Unit& u) const { if (i >= 3) return false; if (!base.next(0, u)) return false; u.pn += 8 * i; return true; }
    __device__ __forceinline__ void a_ready(const Unit&) const {}
    __device__ __forceinline__ void done(const Unit&) const {}
    __device__ __forceinline__ size_t a_byte(const Unit& u, size_t tstep) const { return (size_t)u.pm * tstep + (size_t)((u.pn >> 3) * 768) * 2; }
    __device__ __forceinline__ size_t b_byte(const Unit& u, size_t) const { return ((size_t)(u.pn >> 3) * 2048 + (size_t)(u.pn & 7) * 256) * 768 * 2; }
    __device__ __forceinline__ int ktiles(const Unit& u, int) const { return (u.pn >> 3) < 2 ? 12 : 8; }
};

__device__ __forceinline__ unsigned cvt_pk_bf16(float lo, float hi) { unsigned r; asm volatile("v_cvt_pk_bf16_f32 %0, %1, %2" : "=v"(r) : "v"(lo), "v"(hi)); return r; }
typedef float f32x2 __attribute__((ext_vector_type(2)));
__device__ __forceinline__ f32x2 gelu_pk(f32x2 v) {
    const f32x2 av = __builtin_elementwise_abs(v), d = av * 0.2316418882f + 1.0f;
    f32x2 t; t.x = __builtin_amdgcn_rcpf(d.x); t.y = __builtin_amdgcn_rcpf(d.y);
    f32x2 q = t * 0.5307027145f + (-0.7265760135f); q = q * t + 0.7107068705f; q = q * t + (-0.142248368f); q = q * t + 0.127414796f; q = q * t;
    const f32x2 s = (v * v) * (-0.72134752044f);
    f32x2 e; e.x = __builtin_amdgcn_exp2f(s.x); e.y = __builtin_amdgcn_exp2f(s.y);
    const f32x2 m = v * (q * e), r = v - m;
    f32x2 o; o.x = v.x < 0.f ? m.x : r.x; o.y = v.y < 0.f ? m.y : r.y; return o;
}

template <class Epi, class Sched, bool ALIGN_EPI = false, bool SP2 = false>
__device__ __forceinline__ void gemm_phase(const int tid, PG8_LAS unsigned char* lds, const Gemm g, const Sched& S, const Epi& E) {
    const int wid = __builtin_amdgcn_readfirstlane(tid >> 6), lane = tid & 63, wr = wid >> 2, wc = wid & 3, fr = lane & 15, fq = lane >> 4;
    const int K = g.K, ntK = K / BK;
    unsigned voffA[2], voffB[2];
#pragma unroll
    for (int i = 0; i < 2; ++i) { int R, C; stage_rc(tid * 16 + i * 8192, R, C); const int Rb = Epi::PERM ? ((R & ~31) + perm32(R & 31)) : R;
        voffA[i] = (unsigned)(R * g.lda + C) * 2u; voffB[i] = (unsigned)(Rb * g.ldb + C) * 2u; }
    const size_t kstep = (size_t)(BK * 2);
    const size_t hstepA = (size_t)HALF * g.lda * 2, hstepB = (size_t)HALF * g.ldb * 2;
    const size_t tstepA = 2 * hstepA, tstepB = 2 * hstepB;
    const unsigned ldsw = (unsigned)wid * 1024u;
    const int aoff = lds_byte(wr * 64 + fr, fq * 8), boff = lds_byte(wc * 32 + fr, fq * 8);
#define PG8_SA(b, h) (((b) * 2 + (h)) * HTB)
#define PG8_SB(b, h) ((4 + (b) * 2 + (h)) * HTB)
#define PG8_STAGE(bufoff, gbase, voff) do { _Pragma("unroll") for (int _i = 0; _i < 2; ++_i) \
        __builtin_amdgcn_global_load_lds((const unsigned*)((const char*)(gbase) + (voff)[_i]), (PG8_LAS unsigned*)(lds + (bufoff) + ldsw + _i * 8192), 16, 0, 0); } while (0)
#define PG8_LDA(dst, b, h) do { _Pragma("unroll") for (int m = 0; m < 4; ++m) _Pragma("unroll") for (int k = 0; k < 2; ++k) dst[m][k] = *(const PG8_LAS bf16x8*)(lds + PG8_SA(b, h) + aoff + m * 2048 + k * 1024); } while (0)
#define PG8_LDB(dst, b, h) do { _Pragma("unroll") for (int n = 0; n < 2; ++n) _Pragma("unroll") for (int k = 0; k < 2; ++k) dst[n][k] = *(const PG8_LAS bf16x8*)(lds + PG8_SB(b, h) + boff + n * 2048 + k * 1024); } while (0)
#define PG8_MMA(ai, bj, At, Bt) do { __builtin_amdgcn_s_setprio(1); _Pragma("unroll") for (int m = 0; m < 4; ++m) _Pragma("unroll") for (int n = 0; n < 2; ++n) _Pragma("unroll") for (int k = 0; k < 2; ++k) \
        acc[ai][bj][m][n] = __builtin_amdgcn_mfma_f32_16x16x32_bf16(Bt[n][k], At[m][k], acc[ai][bj][m][n], 0, 0, 0); __builtin_amdgcn_s_setprio(0); } while (0)
#define PG8_WAIT_V(n) asm volatile("s_waitcnt vmcnt(" #n ")" ::: "memory")
#define PG8_WAIT_L(n) asm volatile("s_waitcnt lgkmcnt(" #n ")" ::: "memory")
#define PG8_BAR __builtin_amdgcn_s_barrier()
#define PG8_SCHED __builtin_amdgcn_sched_barrier(0)
    Unit cur, nxt; int ui = 0;
    if (!S.next(0, cur)) return;
    f32x4 acc[2][2][4][2];
#pragma unroll
    for (int a = 0; a < 2; ++a)
#pragma unroll
        for (int b = 0; b < 2; ++b)
#pragma unroll
            for (int m = 0; m < 4; ++m)
#pragma unroll
                for (int n = 0; n < 2; ++n) acc[a][b][m][n] = (f32x4){0.f, 0.f, 0.f, 0.f};
    bf16x8 At[4][2], B0[2][2], B1[2][2];
    const char* cA = (const char*)g.A + S.a_byte(cur, tstepA); const char* cB = (const char*)g.Bt + S.b_byte(cur, tstepB);
    S.a_ready(cur);
    if constexpr (SP2) {
        PG8_STAGE(PG8_SB(0, 0), cB, voffB); PG8_STAGE(PG8_SB(0, 1), cB + hstepB, voffB); PG8_STAGE(PG8_SA(0, 0), cA, voffA); PG8_STAGE(PG8_SA(0, 1), cA + hstepA, voffA);
        if (wr == 1) PG8_BAR;
        PG8_WAIT_V(2); PG8_BAR;
        PG8_STAGE(PG8_SB(1, 0), cB + kstep, voffB); PG8_STAGE(PG8_SA(1, 0), cA + kstep, voffA); PG8_STAGE(PG8_SB(1, 1), cB + hstepB + kstep, voffB);
        PG8_WAIT_V(6); PG8_BAR;
    } else {
        PG8_STAGE(PG8_SB(0, 0), cB, voffB); PG8_STAGE(PG8_SA(0, 0), cA, voffA); PG8_STAGE(PG8_SB(0, 1), cB + hstepB, voffB); PG8_STAGE(PG8_SA(0, 1), cA + hstepA, voffA);
        if (wr == 1) PG8_BAR;
        PG8_WAIT_V(4); PG8_BAR;
        PG8_STAGE(PG8_SB(1, 0), cB + kstep, voffB); PG8_STAGE(PG8_SA(1, 0), cA + kstep, voffA); PG8_STAGE(PG8_SB(1, 1), cB + hstepB + kstep, voffB);
        PG8_WAIT_V(6); PG8_BAR;
    }
    for (;;) {
        const bool has_next = S.next(ui + 1, nxt);
        const char* nA = has_next ? (const char*)g.A + S.a_byte(nxt, tstepA) : cA; const char* nB = has_next ? (const char*)g.Bt + S.b_byte(nxt, tstepB) : cB;
        const int nt = S.ktiles(cur, ntK);
        for (int t = 0; t < nt; t += 2) {
            const bool last = (t == nt - 2);
            const char* a1 = cA + (size_t)(t + 1) * kstep;
            const char* a2 = last ? nA : cA + (size_t)(t + 2) * kstep; const char* b2 = last ? nB : cB + (size_t)(t + 2) * kstep;
            const char* a3 = a2 + kstep; const char* b3 = b2 + kstep;
            if (last && has_next) S.a_ready(nxt);
            if constexpr (SP2) {
            PG8_LDB(B0, 0, 0); PG8_LDB(B1, 0, 1); PG8_SCHED; PG8_LDA(At, 0, 0); PG8_STAGE(PG8_SA(1, 1), a1 + hstepA, voffA);
            PG8_WAIT_V(8); PG8_WAIT_L(0); PG8_BAR; PG8_MMA(0, 0, At, B0); PG8_MMA(0, 1, At, B1); PG8_BAR; PG8_SCHED;
            PG8_LDA(At, 0, 1); PG8_STAGE(PG8_SB(0, 0), b2, voffB); PG8_STAGE(PG8_SB(0, 1), b2 + hstepB, voffB); PG8_STAGE(PG8_SA(0, 0), a2, voffA);
            PG8_WAIT_V(8); PG8_WAIT_L(0); PG8_BAR; PG8_MMA(1, 0, At, B0); PG8_MMA(1, 1, At, B1); PG8_BAR; PG8_SCHED;
            PG8_LDB(B0, 1, 0); PG8_LDB(B1, 1, 1); PG8_SCHED; PG8_LDA(At, 1, 0); PG8_STAGE(PG8_SA(0, 1), a2 + hstepA, voffA);
            PG8_WAIT_V(8); PG8_WAIT_L(0); PG8_BAR; PG8_MMA(0, 0, At, B0); PG8_MMA(0, 1, At, B1); PG8_BAR; PG8_SCHED;
            PG8_LDA(At, 1, 1); PG8_STAGE(PG8_SB(1, 0), b3, voffB); PG8_STAGE(PG8_SB(1, 1), b3 + hstepB, voffB); PG8_STAGE(PG8_SA(1, 0), a3, voffA);
            PG8_WAIT_V(8); PG8_WAIT_L(0); PG8_BAR; PG8_MMA(1, 0, At, B0); PG8_MMA(1, 1, At, B1); PG8_BAR; PG8_SCHED;
            } else {
            PG8_LDB(B0, 0, 0); PG8_SCHED; PG8_LDA(At, 0, 0); PG8_STAGE(PG8_SA(1, 1), a1 + hstepA, voffA);
            PG8_WAIT_L(8); PG8_BAR; PG8_WAIT_L(0); PG8_MMA(0, 0, At, B0); PG8_BAR; PG8_SCHED;
            PG8_LDB(B1, 0, 1); PG8_STAGE(PG8_SB(0, 0), b2, voffB);
            PG8_BAR; PG8_WAIT_L(0); PG8_MMA(0, 1, At, B1); PG8_BAR;
            PG8_LDA(At, 0, 1); PG8_STAGE(PG8_SA(0, 0), a2, voffA);
            PG8_BAR; PG8_WAIT_L(0); PG8_MMA(1, 0, At, B0); PG8_BAR; PG8_SCHED;
            PG8_STAGE(PG8_SB(0, 1), b2 + hstepB, voffB);
            PG8_WAIT_V(6); PG8_BAR; PG8_MMA(1, 1, At, B1); PG8_BAR;
            PG8_LDB(B0, 1, 0); PG8_SCHED; PG8_LDA(At, 1, 0); PG8_STAGE(PG8_SA(0, 1), a2 + hstepA, voffA);
            PG8_WAIT_L(8); PG8_BAR; PG8_WAIT_L(0); PG8_MMA(0, 0, At, B0); PG8_BAR; PG8_SCHED;
            PG8_LDB(B1, 1, 1); PG8_STAGE(PG8_SB(1, 0), b3, voffB);
            PG8_BAR; PG8_WAIT_L(0); PG8_MMA(0, 1, At, B1); PG8_BAR;
            PG8_LDA(At, 1, 1); PG8_STAGE(PG8_SA(1, 0), a3, voffA);
            PG8_BAR; PG8_WAIT_L(0); PG8_MMA(1, 0, At, B0); PG8_BAR; PG8_SCHED;
            PG8_STAGE(PG8_SB(1, 1), b3 + hstepB, voffB);
            PG8_WAIT_V(6); PG8_BAR; PG8_MMA(1, 1, At, B1); PG8_BAR;
            }
        }
        if constexpr (ALIGN_EPI) { if (wr == 0) PG8_BAR; }
        if constexpr (!Epi::AFTER_DRAIN) { E(acc, cur, wr, wc, fr, fq); S.done(cur); }
        if (!has_next) break;
        if constexpr (!Epi::CARRY) {
#pragma unroll
        for (int a = 0; a < 2; ++a)
#pragma unroll
            for (int b = 0; b < 2; ++b)
#pragma unroll
                for (int m = 0; m < 4; ++m)
#pragma unroll
                    for (int n = 0; n < 2; ++n) acc[a][b][m][n] = (f32x4){0.f, 0.f, 0.f, 0.f};
        }
        cur = nxt; cA = nA; cB = nB; ++ui;
        if constexpr (ALIGN_EPI) { if (wr == 1) PG8_BAR; }
    }
    PG8_WAIT_V(0);
    if constexpr (!ALIGN_EPI) { if (wr == 0) PG8_BAR; }
    PG8_BAR;
    if constexpr (Epi::AFTER_DRAIN) { E.fused(acc, cur, wr, wc, fr, fq, lds, wid, lane); S.done(cur); }
#undef PG8_SA
#undef PG8_SB
#undef PG8_STAGE
#undef PG8_LDA
#undef PG8_LDB
#undef PG8_MMA
#undef PG8_WAIT_V
#undef PG8_WAIT_L
#undef PG8_BAR
#undef PG8_SCHED
}

typedef int i32x4 __attribute__((ext_vector_type(4)));
struct Gemm8 { const signed char* A; const signed char* Bt; int M, N, K, lda, ldb; };
template <class Epi, class Sched, bool ALIGN_EPI = false, bool SP2 = false, bool A_TILED = false>
__device__ __forceinline__ void gemm_phase_i8(const int tid, PG8_LAS unsigned char* lds, const Gemm8 g, const Sched& S, const Epi& E) {
    const int wid = __builtin_amdgcn_readfirstlane(tid >> 6), lane = tid & 63, wr = wid >> 2, wc = wid & 3, fr = lane & 15, fq = lane >> 4;
    const int K = g.K, nt = K / 128;
    unsigned voffA[2], voffB[2];
#pragma unroll
    for (int i = 0; i < 2; ++i) { int R, C; stage_rc(tid * 16 + i * 8192, R, C); const int Rb = Epi::PERM ? ((R & ~31) + perm32(R & 31)) : R;
        voffA[i] = (unsigned)(R * g.lda + 2 * C); voffB[i] = (unsigned)(Rb * g.ldb + 2 * C); }
    const size_t kstep = (size_t)128;
    const size_t hstepA = (size_t)HALF * g.lda, hstepB = (size_t)HALF * g.ldb;
    const size_t tstepA = A_TILED ? (size_t)(g.K / 256) * 65536 : 2 * hstepA, tstepB = 2 * hstepB;
    const unsigned ldsw = (unsigned)wid * 1024u;
    const int aoff = lds_byte(wr * 64 + fr, fq * 8), boff = lds_byte(wc * 32 + fr, fq * 8);
#define PG8_SA(b, h) (((b) * 2 + (h)) * HTB)
#define PG8_SB(b, h) ((4 + (b) * 2 + (h)) * HTB)
#define PG8_STAGE(bufoff, gbase, voff) do { _Pragma("unroll") for (int _i = 0; _i < 2; ++_i) \
        __builtin_amdgcn_global_load_lds((const unsigned*)((const char*)(gbase) + (voff)[_i]), (PG8_LAS unsigned*)(lds + (bufoff) + ldsw + _i * 8192), 16, 0, 0); } while (0)
#define PG8_LDA(dst, b, h) do { _Pragma("unroll") for (int m = 0; m < 4; ++m) _Pragma("unroll") for (int k = 0; k < 2; ++k) dst[m][k] = *(const PG8_LAS bf16x8*)(lds + PG8_SA(b, h) + aoff + m * 2048 + k * 1024); } while (0)
#define PG8_LDB(dst, b, h) do { _Pragma("unroll") for (int n = 0; n < 2; ++n) _Pragma("unroll") for (int k = 0; k < 2; ++k) dst[n][k] = *(const PG8_LAS bf16x8*)(lds + PG8_SB(b, h) + boff + n * 2048 + k * 1024); } while (0)
#define PG8_MMA(ai, bj, At, Bt) do { __builtin_amdgcn_s_setprio(1); _Pragma("unroll") for (int m = 0; m < 4; ++m) _Pragma("unroll") for (int n = 0; n < 2; ++n) _Pragma("unroll") for (int k = 0; k < 2; ++k) \
        acc[ai][bj][m][n] = __builtin_amdgcn_mfma_i32_16x16x64_i8(__builtin_bit_cast(i32x4, Bt[n][k]), __builtin_bit_cast(i32x4, At[m][k]), acc[ai][bj][m][n], 0, 0, 0); __builtin_amdgcn_s_setprio(0); } while (0)
#define PG8_WAIT_V(n) asm volatile("s_waitcnt vmcnt(" #n ")" ::: "memory")
#define PG8_WAIT_L(n) asm volatile("s_waitcnt lgkmcnt(" #n ")" ::: "memory")
#define PG8_BAR __builtin_amdgcn_s_barrier()
#define PG8_SCHED __builtin_amdgcn_sched_barrier(0)
    Unit cur, nxt; int ui = 0;
    if (!S.next(0, cur)) return;
    i32x4 acc[2][2][4][2];
#pragma unroll
    for (int a = 0; a < 2; ++a)
#pragma unroll
        for (int b = 0; b < 2; ++b)
#pragma unroll
            for (int m = 0; m < 4; ++m)
#pragma unroll
                for (int n = 0; n < 2; ++n) acc[a][b][m][n] = (i32x4){0, 0, 0, 0};
    bf16x8 At[4][2], B0[2][2], B1[2][2];
    const char* cA = (const char*)g.A + (size_t)cur.pm * tstepA; const char* cB = (const char*)g.Bt + (size_t)cur.pn * tstepB;
    S.a_ready(cur);
    if constexpr (SP2) {
        PG8_STAGE(PG8_SB(0, 0), cB, voffB); PG8_STAGE(PG8_SB(0, 1), cB + hstepB, voffB); PG8_STAGE(PG8_SA(0, 0), cA, voffA); PG8_STAGE(PG8_SA(0, 1), cA + hstepA, voffA);
        if (wr == 1) PG8_BAR;
        PG8_WAIT_V(2); PG8_BAR;
        PG8_STAGE(PG8_SB(1, 0), cB + kstep, voffB); PG8_STAGE(PG8_SA(1, 0), cA + kstep, voffA); PG8_STAGE(PG8_SB(1, 1), cB + hstepB + kstep, voffB);
        PG8_WAIT_V(6); PG8_BAR;
    } else {
        PG8_STAGE(PG8_SB(0, 0), cB, voffB); PG8_STAGE(PG8_SA(0, 0), cA, voffA); PG8_STAGE(PG8_SB(0, 1), cB + hstepB, voffB); PG8_STAGE(PG8_SA(0, 1), cA + hstepA, voffA);
        if (wr == 1) PG8_BAR;
        PG8_WAIT_V(4); PG8_BAR;
        PG8_STAGE(PG8_SB(1, 0), cB + kstep, voffB); PG8_STAGE(PG8_SA(1, 0), cA + kstep, voffA); PG8_STAGE(PG8_SB(1, 1), cB + hstepB + kstep, voffB);
        PG8_WAIT_V(6); PG8_BAR;
    }
    for (;;) {
        const bool has_next = S.next(ui + 1, nxt);
        const char* nA = has_next ? (const char*)g.A + (size_t)nxt.pm * tstepA : cA; const char* nB = has_next ? (const char*)g.Bt + (size_t)nxt.pn * tstepB : cB;
        for (int t = 0; t < nt; t += 2) {
            const bool last = (t == nt - 2);
            const char* a1 = A_TILED ? cA + (size_t)(t >> 1) * 65536 + 128 : cA + (size_t)(t + 1) * kstep;
            const char* a2 = last ? nA : (A_TILED ? cA + (size_t)((t >> 1) + 1) * 65536 : cA + (size_t)(t + 2) * kstep); const char* b2 = last ? nB : cB + (size_t)(t + 2) * kstep;
            const char* a3 = a2 + kstep; const char* b3 = b2 + kstep;
            if (last && has_next) S.a_ready(nxt);
            if constexpr (SP2) {
            PG8_LDB(B0, 0, 0); PG8_LDB(B1, 0, 1); PG8_SCHED; PG8_LDA(At, 0, 0); PG8_STAGE(PG8_SA(1, 1), a1 + hstepA, voffA);
            PG8_WAIT_V(8); PG8_WAIT_L(0); PG8_BAR; PG8_MMA(0, 0, At, B0); PG8_MMA(0, 1, At, B1); PG8_BAR; PG8_SCHED;
            PG8_LDA(At, 0, 1); PG8_STAGE(PG8_SB(0, 0), b2, voffB); PG8_STAGE(PG8_SB(0, 1), b2 + hstepB, voffB); PG8_STAGE(PG8_SA(0, 0), a2, voffA);
            PG8_WAIT_V(8); PG8_WAIT_L(0); PG8_BAR; PG8_MMA(1, 0, At, B0); PG8_MMA(1, 1, At, B1); PG8_BAR; PG8_SCHED;
            PG8_LDB(B0, 1, 0); PG8_LDB(B1, 1, 1); PG8_SCHED; PG8_LDA(At, 1, 0); PG8_STAGE(PG8_SA(0, 1), a2 + hstepA, voffA);
            PG8_WAIT_V(8); PG8_WAIT_L(0); PG8_BAR; PG8_MMA(0, 0, At, B0); PG8_MMA(0, 1, At, B1); PG8_BAR; PG8_SCHED;
            PG8_LDA(At, 1, 1); PG8_STAGE(PG8_SB(1, 0), b3, voffB); PG8_STAGE(PG8_SB(1, 1), b3 + hstepB, voffB); PG8_STAGE(PG8_SA(1, 0), a3, voffA);
            PG8_WAIT_V(8); PG8_WAIT_L(0); PG8_BAR; PG8_MMA(1, 0, At, B0); PG8_MMA(1, 1, At, B1); PG8_BAR; PG8_SCHED;
            } else {
            PG8_LDB(B0, 0, 0); PG8_SCHED; PG8_LDA(At, 0, 0); PG8_STAGE(PG8_SA(1, 1), a1 + hstepA, voffA);
            PG8_WAIT_L(8); PG8_BAR; PG8_WAIT_L(0); PG8_MMA(0, 0, At, B0); PG8_BAR; PG8_SCHED;
            PG8_LDB(B1, 0, 1); PG8_STAGE(PG8_SB(0, 0), b2, voffB);
            PG8_BAR; PG8_WAIT_L(0); PG8_MMA(0, 1, At, B1); PG8_BAR;
            PG8_LDA(At, 0, 1); PG8_STAGE(PG8_SA(0, 0), a2, voffA);
            PG8_BAR; PG8_WAIT_L(0); PG8_MMA(1, 0, At, B0); PG8_BAR; PG8_SCHED;
            PG8_STAGE(PG8_SB(0, 1), b2 + hstepB, voffB);
            PG8_WAIT_V(6); PG8_BAR; PG8_MMA(1, 1, At, B1); PG8_BAR;
            PG8_LDB(B0, 1, 0); PG8_SCHED; PG8_LDA(At, 1, 0); PG8_STAGE(PG8_SA(0, 1), a2 + hstepA, voffA);
            PG8_WAIT_L(8); PG8_BAR; PG8_WAIT_L(0); PG8_MMA(0, 0, At, B0); PG8_BAR; PG8_SCHED;
            PG8_LDB(B1, 1, 1); PG8_STAGE(PG8_SB(1, 0), b3, voffB);
            PG8_BAR; PG8_WAIT_L(0); PG8_MMA(0, 1, At, B1); PG8_BAR;
            PG8_LDA(At, 1, 1); PG8_STAGE(PG8_SA(1, 0), a3, voffA);
            PG8_BAR; PG8_WAIT_L(0); PG8_MMA(1, 0, At, B0); PG8_BAR; PG8_SCHED;
            PG8_STAGE(PG8_SB(1, 1), b3 + hstepB, voffB);
            PG8_WAIT_V(6); PG8_BAR; PG8_MMA(1, 1, At, B1); PG8_BAR;
            }
        }
        if constexpr (ALIGN_EPI) { if (wr == 0) PG8_BAR; }
        if constexpr (!Epi::AFTER_DRAIN) { E(acc, cur, wr, wc, fr, fq); S.done(cur); }
        if (!has_next) break;
#pragma unroll
        for (int a = 0; a < 2; ++a)
#pragma unroll
            for (int b = 0; b < 2; ++b)
#pragma unroll
                for (int m = 0; m < 4; ++m)
#pragma unroll
                    for (int n = 0; n < 2; ++n) acc[a][b][m][n] = (i32x4){0, 0, 0, 0};
        cur = nxt; cA = nA; cB = nB; ++ui;
        if constexpr (ALIGN_EPI) { if (wr == 1) PG8_BAR; }
    }
    PG8_WAIT_V(0);
    if constexpr (!ALIGN_EPI) { if (wr == 0) PG8_BAR; }
    PG8_BAR;
    if constexpr (Epi::AFTER_DRAIN) { E.fused(acc, cur, wr, wc, fr, fq, lds, wid, lane); S.done(cur); }
#undef PG8_SA
#undef PG8_SB
#undef PG8_STAGE
#undef PG8_LDA
#undef PG8_LDB
#undef PG8_MMA
#undef PG8_WAIT_V
#undef PG8_WAIT_L
#undef PG8_BAR
#undef PG8_SCHED
}

}

__device__ __forceinline__ unsigned pk_i8x4(float a, float b, float c, float d) {
    const int ia = (int)rintf(a), ib = (int)rintf(b), ic = (int)rintf(c), id = (int)rintf(d);
    return ((unsigned)ia & 0xffu) | (((unsigned)ib & 0xffu) << 8) | (((unsigned)ic & 0xffu) << 16) | (((unsigned)id & 0xffu) << 24); }
__device__ __forceinline__ float wave_max(float v) {
    v = fmaxf(v, SWZ_XOR(v, 1)); v = fmaxf(v, SWZ_XOR(v, 2)); v = fmaxf(v, SWZ_XOR(v, 4)); v = fmaxf(v, SWZ_XOR(v, 8)); v = fmaxf(v, SWZ_XOR(v, 16));
    auto rr = __builtin_amdgcn_permlane32_swap(__float_as_uint(v), __float_as_uint(v), false, false); return fmaxf(__uint_as_float(rr[0]), __uint_as_float(rr[1])); }
typedef unsigned short bf16_t;

struct EpiProj {
    static constexpr bool PERM = true, AFTER_DRAIN = false;
    bf16_t* ATT; bf16_t* GATES; const float* ROPE; const float* SH; const float* SW; unsigned* KINF;
    template <int MODE, bool KT>
    __device__ __forceinline__ void run(const pg8::i32x4 (&acc)[2][2][4][2], const pg8::Unit& u, int wr, int wc, int fr, int fq) const {
        using pg8::f32x4; using pg8::u32x4; using pg8::cvt_pk_bf16;
        const int row0 = u.pm * 256 + wr * 64 + fr, pn = u.pn;
        float mxk[2] = {0.f, 0.f};
        bf16_t* base = (MODE == 2) ? GATES : ATT; const int colt = (MODE == 2) ? (pn - 24) * 256 : pn * 256;
        float shr[2][4]; f32x4 sw[2][2];
#pragma unroll
        for (int ai = 0; ai < 2; ++ai)
#pragma unroll
            for (int m = 0; m < 4; ++m) shr[ai][m] = SH[row0 + ai * 128 + m * 16];
#pragma unroll
        for (int bj = 0; bj < 2; ++bj) { const int ncol = pn * 256 + bj * 128 + wc * 32 + 8 * fq; sw[bj][0] = *(const f32x4*)(SW + ncol); sw[bj][1] = *(const f32x4*)(SW + ncol + 4); }
#pragma unroll
        for (int ai = 0; ai < 2; ++ai)
#pragma unroll
            for (int m = 0; m < 4; ++m) { const int row = row0 + ai * 128 + m * 16;
#pragma unroll
                for (int bj = 0; bj < 2; ++bj) { const int col = colt + bj * 128 + wc * 32 + 8 * fq;
                    const pg8::i32x4 i0 = acc[ai][bj][m][0], i1 = acc[ai][bj][m][1]; const f32x4 w0 = sw[bj][0] * shr[ai][m], w1 = sw[bj][1] * shr[ai][m];
                    f32x4 v0 = {(float)i0[0] * w0[0], (float)i0[1] * w0[1], (float)i0[2] * w0[2], (float)i0[3] * w0[3]}, v1 = {(float)i1[0] * w1[0], (float)i1[1] * w1[1], (float)i1[2] * w1[2], (float)i1[3] * w1[3]};
                    if constexpr (MODE == 1) { const int j = (col & 63) >> 3; const f32x4 cs0 = *(const f32x4*)(ROPE + (size_t)row * 64 + 8 * j), cs1 = *(const f32x4*)(ROPE + (size_t)row * 64 + 8 * j + 4);
                        f32x4 y0, y1;
                        y0[0] = v0[0] * cs0[0] - v1[0] * cs0[1]; y1[0] = v0[0] * cs0[1] + v1[0] * cs0[0];
                        y0[1] = v0[1] * cs0[2] - v1[1] * cs0[3]; y1[1] = v0[1] * cs0[3] + v1[1] * cs0[2];
                        y0[2] = v0[2] * cs1[0] - v1[2] * cs1[1]; y1[2] = v0[2] * cs1[1] + v1[2] * cs1[0];
                        y0[3] = v0[3] * cs1[2] - v1[3] * cs1[3]; y1[3] = v0[3] * cs1[3] + v1[3] * cs1[2];
                        v0 = y0; v1 = y1; }
                    if constexpr (MODE == 2) {
#pragma unroll
                        for (int e = 0; e < 4; ++e) { v0[e] = fminf(1.f + __expf(-v0[e]), 1e12f); v1[e] = fminf(1.f + __expf(-v1[e]), 1e12f); } }
                    if constexpr (KT) mxk[bj] = fmaxf(fmaxf(mxk[bj], fmaxf(fmaxf(fabsf(v0[0]), fabsf(v0[1])), fmaxf(fabsf(v0[2]), fabsf(v0[3])))), fmaxf(fmaxf(fabsf(v1[0]), fabsf(v1[1])), fmaxf(fabsf(v1[2]), fabsf(v1[3]))));
                    u32x4 w; w.x = cvt_pk_bf16(v0[0], v0[1]); w.y = cvt_pk_bf16(v0[2], v0[3]); w.z = cvt_pk_bf16(v1[0], v1[1]); w.w = cvt_pk_bf16(v1[2], v1[3]);
                    *(u32x4*)(base + (size_t)row * 6144 + col) = w; } }
        if constexpr (KT) {
#pragma unroll
            for (int bj = 0; bj < 2; ++bj) { const float mw = wave_max(mxk[bj]); if (fr == 0 && fq == 0) atomicMax(KINF + ((u.pm * 256) / SEQ) * 8 + 2 * (pn - 3) + bj, __float_as_uint(mw)); } }
    }
    __device__ __forceinline__ void operator()(const pg8::i32x4 (&acc)[2][2][4][2], const pg8::Unit& u, int wr, int wc, int fr, int fq) const {
        const int pn = u.pn;
        if (pn >= 24) run<2, false>(acc, u, wr, wc, fr, fq);
        else if (pn >= 18 && pn < 22) run<1, false>(acc, u, wr, wc, fr, fq);
        else if (pn >= 3 && pn < 6) run<0, true>(acc, u, wr, wc, fr, fq);
        else run<0, false>(acc, u, wr, wc, fr, fq);
    }
};

template <int MODE> struct EpiBranch {
    static constexpr bool PERM = false, AFTER_DRAIN = false, CARRY = false;
    float* YP; bf16_t* YB; const bf16_t* GATES; int gcol;
    __device__ __forceinline__ void operator()(const pg8::f32x4 (&acc)[2][2][4][2], const pg8::Unit& u, int wr, int wc, int fr, int fq) const {
        using pg8::f32x4;
        const int row0 = u.pm * 256 + wr * 64 + fr, col0 = u.pn * 256 + wc * 32 + 4 * fq;
#pragma unroll
        for (int ai = 0; ai < 2; ++ai)
#pragma unroll
            for (int m = 0; m < 4; ++m) { const size_t row = row0 + ai * 128 + m * 16;
#pragma unroll
                for (int bj = 0; bj < 2; ++bj)
#pragma unroll
                    for (int n = 0; n < 2; ++n) { const int col = col0 + bj * 128 + n * 16; const uint2 gw2 = *(const uint2*)(GATES + row * 6144 + gcol + col);
                        f32x4 g; g[0] = __uint_as_float(gw2.x << 16); g[1] = __uint_as_float(gw2.x & 0xffff0000u); g[2] = __uint_as_float(gw2.y << 16); g[3] = __uint_as_float(gw2.y & 0xffff0000u);
                        f32x4 v = g * acc[ai][bj][m][n]; float* yp = YP + row * DM + col;
                        if (MODE >= 1) v = v + *(const f32x4*)yp;
                        if (MODE <= 1) *(f32x4*)yp = v;
                        else { uint2 w; w.x = pg8::cvt_pk_bf16(v[0], v[1]); w.y = pg8::cvt_pk_bf16(v[2], v[3]); *(uint2*)(YB + row * DM + col) = w; } } }
    }
};
struct EpiBranchAll {
    static constexpr bool PERM = false, AFTER_DRAIN = false, CARRY = false;
    float* YP; bf16_t* YB; const bf16_t* GATES;
    __device__ __forceinline__ void operator()(const pg8::f32x4 (&acc)[2][2][4][2], const pg8::Unit& u, int wr, int wc, int fr, int fq) const {
        const pg8::Unit v{u.pm, u.pn & 7}; const int br = u.pn >> 3;
        if (br == 0) { EpiBranch<0> e{YP, YB, GATES, 0}; e(acc, v, wr, wc, fr, fq); }
        else if (br == 1) { EpiBranch<1> e{YP, YB, GATES, 2048}; e(acc, v, wr, wc, fr, fq); }
        else { EpiBranch<2> e{YP, YB, GATES, 4096}; e(acc, v, wr, wc, fr, fq); }
    }
};
struct EpiBranchCarry {
    static constexpr bool PERM = false, AFTER_DRAIN = false, CARRY = true;
    bf16_t* YB; const bf16_t* GATES;
    static __device__ __forceinline__ pg8::f32x4 gate4(const uint2 w) { pg8::f32x4 g; g[0] = __uint_as_float(w.x << 16); g[1] = __uint_as_float(w.x & 0xffff0000u); g[2] = __uint_as_float(w.y << 16); g[3] = __uint_as_float(w.y & 0xffff0000u); return g; }
    __device__ __forceinline__ void operator()(pg8::f32x4 (&acc)[2][2][4][2], const pg8::Unit& u, int wr, int wc, int fr, int fq) const {
        using pg8::f32x4;
        const int br = u.pn >> 3, row0 = u.pm * 256 + wr * 64 + fr, col0 = (u.pn & 7) * 256 + wc * 32 + 4 * fq; const bf16_t* ga = GATES + br * 2048;
        if (br < 2) {
#pragma unroll
            for (int ai = 0; ai < 2; ++ai) { uint2 gq[4][2][2], hq[4][2][2];
#pragma unroll
                for (int m = 0; m < 4; ++m) { const size_t row = row0 + ai * 128 + m * 16;
#pragma unroll
                    for (int bj = 0; bj < 2; ++bj)
#pragma unroll
                        for (int n = 0; n < 2; ++n) { const int col = col0 + bj * 128 + n * 16; gq[m][bj][n] = *(const uint2*)(ga + row * 6144 + col); hq[m][bj][n] = *(const uint2*)(ga + row * 6144 + 2048 + col); } }
                asm volatile("" ::: "memory");
#pragma unroll
                for (int m = 0; m < 4; ++m)
#pragma unroll
                    for (int bj = 0; bj < 2; ++bj)
#pragma unroll
                        for (int n = 0; n < 2; ++n) { const f32x4 g = gate4(gq[m][bj][n]), h = gate4(hq[m][bj][n]);
                            f32x4 r; r[0] = h[0] * __builtin_amdgcn_rcpf(g[0]); r[1] = h[1] * __builtin_amdgcn_rcpf(g[1]); r[2] = h[2] * __builtin_amdgcn_rcpf(g[2]); r[3] = h[3] * __builtin_amdgcn_rcpf(g[3]);
                            acc[ai][bj][m][n] = acc[ai][bj][m][n] * r; } }
        } else {
#pragma unroll
            for (int ai = 0; ai < 2; ++ai) { uint2 gq[4][2][2];
#pragma unroll
                for (int m = 0; m < 4; ++m) { const size_t row = row0 + ai * 128 + m * 16;
#pragma unroll
                    for (int bj = 0; bj < 2; ++bj)
#pragma unroll
                        for (int n = 0; n < 2; ++n) gq[m][bj][n] = *(const uint2*)(ga + row * 6144 + col0 + bj * 128 + n * 16); }
                asm volatile("" ::: "memory");
#pragma unroll
                for (int m = 0; m < 4; ++m) { const size_t row = row0 + ai * 128 + m * 16;
#pragma unroll
                    for (int bj = 0; bj < 2; ++bj)
#pragma unroll
                        for (int n = 0; n < 2; ++n) { const int col = col0 + bj * 128 + n * 16; const f32x4 e4 = gate4(gq[m][bj][n]), a4 = acc[ai][bj][m][n]; const f32x4 v = {a4[0] * __builtin_amdgcn_rcpf(e4[0]), a4[1] * __builtin_amdgcn_rcpf(e4[1]), a4[2] * __builtin_amdgcn_rcpf(e4[2]), a4[3] * __builtin_amdgcn_rcpf(e4[3])};
                            uint2 w; w.x = pg8::cvt_pk_bf16(v[0], v[1]); w.y = pg8::cvt_pk_bf16(v[2], v[3]); *(uint2*)(YB + row * DM + col) = w; } } }
        }
    }
};
struct EpiResidM {
    static constexpr bool PERM = false, AFTER_DRAIN = false, CARRY = false;
    bf16_t* X; const float* gt; const void* Xb; bool xb_f32;
    __device__ __forceinline__ void operator()(const pg8::f32x4 (&acc)[2][2][4][2], const pg8::Unit& u, int wr, int wc, int fr, int fq) const {
        using pg8::f32x4;
        const int row0 = u.pm * 256 + wr * 64 + fr, col0 = u.pn * 256 + wc * 32 + 4 * fq; const float* gtb = gt + (size_t)((u.pm * 256) / SEQ) * NMOD;
        f32x4 g4[2][2];
#pragma unroll
        for (int bj = 0; bj < 2; ++bj)
#pragma unroll
            for (int n = 0; n < 2; ++n) g4[bj][n] = *(const f32x4*)(gtb + col0 + bj * 128 + n * 16);
#pragma unroll
        for (int ai = 0; ai < 2; ++ai) { float4 xq[4][2][2];
#pragma unroll
            for (int m = 0; m < 4; ++m) { const size_t row = row0 + ai * 128 + m * 16;
#pragma unroll
                for (int bj = 0; bj < 2; ++bj)
#pragma unroll
                    for (int n = 0; n < 2; ++n) xq[m][bj][n] = ldx4(Xb, xb_f32, row * DM + col0 + bj * 128 + n * 16); }
            asm volatile("" ::: "memory");
#pragma unroll
            for (int m = 0; m < 4; ++m) { const size_t row = row0 + ai * 128 + m * 16;
#pragma unroll
                for (int bj = 0; bj < 2; ++bj)
#pragma unroll
                    for (int n = 0; n < 2; ++n) { const float4 xb = xq[m][bj][n]; const f32x4 g = g4[bj][n], a = acc[ai][bj][m][n];
                        uint2 w; w.x = pg8::cvt_pk_bf16(xb.x + g[0] * a[0], xb.y + g[1] * a[1]); w.y = pg8::cvt_pk_bf16(xb.z + g[2] * a[2], xb.w + g[3] * a[3]);
                        *(uint2*)(X + row * DM + col0 + bj * 128 + n * 16) = w; } } }
    }
};
struct EpiStoreF32 {
    static constexpr bool PERM = false, AFTER_DRAIN = false, CARRY = false;
    float* C; int ldc;
    __device__ __forceinline__ void operator()(const pg8::f32x4 (&acc)[2][2][4][2], const pg8::Unit& u, int wr, int wc, int fr, int fq) const {
        const int row0 = u.pm * 256 + wr * 64 + fr, col0 = u.pn * 256 + wc * 32 + 4 * fq;
#pragma unroll
        for (int ai = 0; ai < 2; ++ai)
#pragma unroll
            for (int m = 0; m < 4; ++m) { const size_t row = row0 + ai * 128 + m * 16;
#pragma unroll
                for (int bj = 0; bj < 2; ++bj)
#pragma unroll
                    for (int n = 0; n < 2; ++n) *(pg8::f32x4*)(C + row * ldc + col0 + bj * 128 + n * 16) = acc[ai][bj][m][n]; }
    }
};

__device__ __forceinline__ int win_src_col(int n) {
    if (n >= 6144) return n + 6;
    if (n >= C_DQ && n < C_DV) { const int p = n & 63, base = n & ~63, j = p >> 3, m = p & 3, hi = (p >> 2) & 1; return base + (hi ? 32 : 0) + 4 * j + m; }
    return n;
}
__device__ __forceinline__ void transpose_item_win8(const float* W, signed char* WT, const unsigned* cmax, float* scr, int kb, int nb, int lane) {
    const int k0 = 64 * kb, n0 = 32 * nb; const int sc = win_src_col(n0 + (lane & 31)); const float q = 127.f / fmaxf(__uint_as_float(cmax[n0 + (lane & 31)]), 1e-30f);
#pragma unroll
    for (int i = 0; i < 32; ++i) { const int kk = 2 * i + (lane >> 5); scr[kk * 33 + (lane & 31)] = W[(size_t)(k0 + kk) * INW + sc] * q; }
    const int c = lane & 7;
#pragma unroll
    for (int j = 0; j < 4; ++j) { const int n = (lane >> 3) + 8 * j; const float* sp = scr + (8 * c) * 33 + n;
        uint2 o; o.x = pk_i8x4(sp[0 * 33], sp[1 * 33], sp[2 * 33], sp[3 * 33]); o.y = pk_i8x4(sp[4 * 33], sp[5 * 33], sp[6 * 33], sp[7 * 33]);
        *(uint2*)(WT + (size_t)(n0 + n) * DM + k0 + 8 * c) = o; }
}
struct EpiPeerHid {
    static constexpr bool PERM = true, AFTER_DRAIN = false;
    const unsigned char* Sm; const float* SH; const float* SU; float* HID;
    __device__ __forceinline__ void operator()(const pg8::i32x4 (&acc)[2][2][4][2], const pg8::Unit& u, int wr, int wc, int fr, int fq) const {
        using pg8::f32x4;
        const int row0 = u.pm * 256 + wr * 64 + fr, col0 = u.pn * 256 + wc * 32 + 8 * fq;
        f32x4 su[2][2];
#pragma unroll
        for (int bj = 0; bj < 2; ++bj) { su[bj][0] = *(const f32x4*)(SU + col0 + bj * 128); su[bj][1] = *(const f32x4*)(SU + col0 + bj * 128 + 4); }
        uint2 w[2][4][2]; float shr[2][4];
#pragma unroll
        for (int ai = 0; ai < 2; ++ai)
#pragma unroll
            for (int m = 0; m < 4; ++m) { const size_t row = row0 + ai * 128 + m * 16; shr[ai][m] = SH[row];
#pragma unroll
                for (int bj = 0; bj < 2; ++bj) w[ai][m][bj] = *(const uint2*)(Sm + (((size_t)u.pm * 64 + u.pn) * 256 + (row & 255)) * 256 + (col0 & 255) + bj * 128); }
#pragma unroll
        for (int ai = 0; ai < 2; ++ai)
#pragma unroll
            for (int m = 0; m < 4; ++m) { const size_t row = row0 + ai * 128 + m * 16;
#pragma unroll
                for (int bj = 0; bj < 2; ++bj) { const uint2 ww = w[ai][m][bj];
                    if ((ww.x | ww.y) != 0u) {
                        const pg8::i32x4 v0 = acc[ai][bj][m][0], v1 = acc[ai][bj][m][1];
                        const int hv[8] = {v0[0], v0[1], v0[2], v0[3], v1[0], v1[1], v1[2], v1[3]};
                        const float sc[8] = {su[bj][0][0], su[bj][0][1], su[bj][0][2], su[bj][0][3], su[bj][1][0], su[bj][1][1], su[bj][1][2], su[bj][1][3]};
#pragma unroll
                        for (int e = 0; e < 8; ++e) { const unsigned sb = ((e < 4 ? ww.x : ww.y) >> (8 * (e & 3))) & 0xffu;
                            if (sb != 0u) HID[row * PE_E + (sb - 1u)] = (float)hv[e] * shr[ai][m] * sc[e]; } } } }
    }
};
struct EpiStoreI8 {
    static constexpr bool PERM = false, AFTER_DRAIN = false;
    float* C; int ldc; const float* SH; const float* SC;
    __device__ __forceinline__ void operator()(const pg8::i32x4 (&acc)[2][2][4][2], const pg8::Unit& u, int wr, int wc, int fr, int fq) const {
        using pg8::f32x4;
        const int row0 = u.pm * 256 + wr * 64 + fr, col0 = u.pn * 256 + wc * 32 + 4 * fq;
        float sh[2][4]; f32x4 sc[2][2];
#pragma unroll
        for (int ai = 0; ai < 2; ++ai)
#pragma unroll
            for (int m = 0; m < 4; ++m) sh[ai][m] = SH[row0 + ai * 128 + m * 16];
#pragma unroll
        for (int bj = 0; bj < 2; ++bj)
#pragma unroll
            for (int n = 0; n < 2; ++n) sc[bj][n] = *(const f32x4*)(SC + col0 + bj * 128 + n * 16);
        asm volatile("" ::: "memory");
#pragma unroll
        for (int ai = 0; ai < 2; ++ai)
#pragma unroll
            for (int m = 0; m < 4; ++m) { const size_t row = row0 + ai * 128 + m * 16;
#pragma unroll
                for (int bj = 0; bj < 2; ++bj)
#pragma unroll
                    for (int n = 0; n < 2; ++n) { const int col = col0 + bj * 128 + n * 16; const pg8::i32x4 a = acc[ai][bj][m][n]; const f32x4 q = sc[bj][n] * sh[ai][m];
                        *(f32x4*)(C + row * ldc + col) = (f32x4){(float)a[0] * q[0], (float)a[1] * q[1], (float)a[2] * q[2], (float)a[3] * q[3]}; } }
    }
};
struct EpiResidI8 {
    static constexpr bool PERM = false, AFTER_DRAIN = false;
    bf16_t* X; const float* gt; const float* SA;
    __device__ __forceinline__ void operator()(const pg8::i32x4 (&acc)[2][2][4][2], const pg8::Unit& u, int wr, int wc, int fr, int fq) const {
        using pg8::f32x4;
        const int row0 = u.pm * 256 + wr * 64 + fr, col0 = u.pn * 256 + wc * 32 + 4 * fq; const float* gtb = gt + (size_t)((u.pm * 256) / SEQ) * NMOD;
        f32x4 g4[2][2];
#pragma unroll
        for (int bj = 0; bj < 2; ++bj)
#pragma unroll
            for (int n = 0; n < 2; ++n) g4[bj][n] = *(const f32x4*)(gtb + col0 + bj * 128 + n * 16);
#pragma unroll
        for (int ai = 0; ai < 2; ++ai) { uint2 xw[4][2][2]; float sa[4];
#pragma unroll
            for (int m = 0; m < 4; ++m) { const size_t row = row0 + ai * 128 + m * 16; sa[m] = SA[row];
#pragma unroll
                for (int bj = 0; bj < 2; ++bj)
#pragma unroll
                    for (int n = 0; n < 2; ++n) xw[m][bj][n] = *(const uint2*)(X + row * DM + col0 + bj * 128 + n * 16); }
            asm volatile("" ::: "memory");
#pragma unroll
            for (int m = 0; m < 4; ++m) { const size_t row = row0 + ai * 128 + m * 16;
#pragma unroll
                for (int bj = 0; bj < 2; ++bj)
#pragma unroll
                    for (int n = 0; n < 2; ++n) { const pg8::i32x4 a = acc[ai][bj][m][n]; const uint2 xq = xw[m][bj][n]; const f32x4 g = g4[bj][n]; const float s_ = sa[m];
                        uint2 w; w.x = pg8::cvt_pk_bf16(__uint_as_float(xq.x << 16) + g[0] * ((float)a[0] * s_), __uint_as_float(xq.x & 0xffff0000u) + g[1] * ((float)a[1] * s_));
                        w.y = pg8::cvt_pk_bf16(__uint_as_float(xq.y << 16) + g[2] * ((float)a[2] * s_), __uint_as_float(xq.y & 0xffff0000u) + g[3] * ((float)a[3] * s_));
                        *(uint2*)(X + row * DM + col0 + bj * 128 + n * 16) = w; } } }
    }
};

template <bool MAPW>
__device__ __forceinline__ void transpose_item(const float* W, int ldw, bf16_t* WT, int K, float* scr, int kb, int nb, int lane) {
    const int k0 = 64 * kb, n0 = 32 * nb; const int sc = MAPW ? win_src_col(n0 + (lane & 31)) : (n0 + (lane & 31));
#pragma unroll
    for (int i = 0; i < 32; ++i) { const int kk = 2 * i + (lane >> 5); scr[kk * 33 + (lane & 31)] = ldnt1(W + (size_t)(k0 + kk) * ldw + sc); }
    const int c = lane & 7;
#pragma unroll
    for (int j = 0; j < 4; ++j) { const int n = (lane >> 3) + 8 * j; const float* sp = scr + (8 * c) * 33 + n;
        pg8::u32x4 o; o.x = pg8::cvt_pk_bf16(sp[0 * 33], sp[1 * 33]); o.y = pg8::cvt_pk_bf16(sp[2 * 33], sp[3 * 33]); o.z = pg8::cvt_pk_bf16(sp[4 * 33], sp[5 * 33]); o.w = pg8::cvt_pk_bf16(sp[6 * 33], sp[7 * 33]);
        *(pg8::u32x4*)(WT + (size_t)(n0 + n) * K + k0 + 8 * c) = o; }
}

namespace att {
typedef short bf16x8 __attribute__((ext_vector_type(8)));
typedef short s16x4 __attribute__((ext_vector_type(4)));
typedef float f32x16 __attribute__((ext_vector_type(16)));
typedef float f32x4 __attribute__((ext_vector_type(4)));
typedef unsigned u32x4 __attribute__((ext_vector_type(4)));
constexpr int SHM_K = 16384, SHM_V = 16384;
constexpr int OFF_V = 0, OFF_K = 2 * SHM_V, OFF_CK = 2 * SHM_V + 2 * SHM_K, OFF_WS = OFF_CK + 512, OFF_Q = OFF_WS + 8 * 64 * 4, LDS_ATT = OFF_Q + 8 * 8 * 1024;
constexpr float LOG2E = 1.4426950408889634f;
#define KSWZ(row, colB) ((row) * 256 + ((colB) ^ (((row) & 7) << 4)))
#define SBAR() __builtin_amdgcn_sched_barrier(0)
__device__ __forceinline__ int v_st(int k, int c) { const int kk = (k & ~0xC) | ((k & 4) << 1) | ((k & 8) >> 1); return ((kk >> 3) * 4 + (c >> 5)) * 512 + ((kk & 7) * 32 + (c & 31)) * 2; }
__device__ __forceinline__ int v_rd_base(int lane) { return ((lane & 3) << 3) | (((lane >> 2) & 3) << 6) | (((lane >> 4) & 1) << 5) | (((lane >> 5) & 1) << 8); }
constexpr int v_rd_off(int d0, int ks, int half) { return d0 * 512 + ks * 4096 + half * 2048; }
__device__ __forceinline__ int crow(int r, int hi) { return (r & 3) + 8 * (r >> 2) + 4 * hi; }
__device__ __forceinline__ unsigned cvtpk(float lo, float hi) { unsigned r; asm volatile("v_cvt_pk_bf16_f32 %0, %1, %2" : "=v"(r) : "v"(lo), "v"(hi)); return r; }
__device__ __forceinline__ float psum2(float v) { auto rr = __builtin_amdgcn_permlane32_swap(__float_as_uint(v), __float_as_uint(v), false, false); return __uint_as_float(rr[0]) + __uint_as_float(rr[1]); }
__device__ __forceinline__ float pmax2(float v) { auto rr = __builtin_amdgcn_permlane32_swap(__float_as_uint(v), __float_as_uint(v), false, false); return fmaxf(__uint_as_float(rr[0]), __uint_as_float(rr[1])); }

template <int KB, int D0, int D1>
__device__ __forceinline__ void qkt(f32x16& p0, f32x16& p1, const char* K_lds, int r32, int hi, const char* qr) {
    p0 = f32x16{}; p1 = f32x16{};
    const char* kb[4];
#pragma unroll
    for (int dd = 0; dd < 4; ++dd) kb[dd] = K_lds + KB * SHM_K + KSWZ(r32, (dd * 16 + hi * 8) * 2);
#pragma unroll
    for (int d0 = D0; d0 < D1; ++d0) { const char* a = kb[d0 & 3] + (d0 >> 2) * 128;
        bf16x8 b0 = *reinterpret_cast<const bf16x8*>(a);
        bf16x8 b1 = *reinterpret_cast<const bf16x8*>(a + 32 * 256);
        const bf16x8 qf = *reinterpret_cast<const bf16x8*>(qr + d0 * 1024);
        p0 = __builtin_amdgcn_mfma_f32_32x32x16_bf16(b0, qf, p0, 0, 0, 0);
        p1 = __builtin_amdgcn_mfma_f32_32x32x16_bf16(b1, qf, p1, 0, 0, 0); }
}
template <int VB>
__device__ __forceinline__ void pv_tile(f32x16* o, int vb0, bf16x8 pa0, bf16x8 pa1, bf16x8 pa2, bf16x8 pa3) {
#define TRRD(dst, off) asm volatile("ds_read_b64_tr_b16 %0, %1 offset:%2" : "=&v"(dst) : "v"(vb0), "i"(off) : "memory")
#define PV_D0(d0) do { s16x4 l0, l1, l2, l3, h0, h1, h2, h3; constexpr int b_ = VB * SHM_V + v_rd_off(d0, 0, 0); \
        TRRD(l0, b_); TRRD(h0, b_ + 2048); TRRD(l1, b_ + 4096); TRRD(h1, b_ + 6144); TRRD(l2, b_ + 8192); TRRD(h2, b_ + 10240); TRRD(l3, b_ + 12288); TRRD(h3, b_ + 14336); \
        asm volatile("s_waitcnt lgkmcnt(0)" ::: "memory"); SBAR(); \
        o[d0] = __builtin_amdgcn_mfma_f32_32x32x16_bf16(pa0, (bf16x8){l0[0], l0[1], l0[2], l0[3], h0[0], h0[1], h0[2], h0[3]}, o[d0], 0, 0, 0); \
        o[d0] = __builtin_amdgcn_mfma_f32_32x32x16_bf16(pa1, (bf16x8){l1[0], l1[1], l1[2], l1[3], h1[0], h1[1], h1[2], h1[3]}, o[d0], 0, 0, 0); \
        o[d0] = __builtin_amdgcn_mfma_f32_32x32x16_bf16(pa2, (bf16x8){l2[0], l2[1], l2[2], l2[3], h2[0], h2[1], h2[2], h2[3]}, o[d0], 0, 0, 0); \
        o[d0] = __builtin_amdgcn_mfma_f32_32x32x16_bf16(pa3, (bf16x8){l3[0], l3[1], l3[2], l3[3], h3[0], h3[1], h3[2], h3[3]}, o[d0], 0, 0, 0); } while (0)
    PV_D0(0); PV_D0(1); PV_D0(2); PV_D0(3);
#undef PV_D0
#undef TRRD
}
__device__ __forceinline__ void pack_p(const f32x16& p0, const f32x16& p1, bf16x8& pa0, bf16x8& pa1, bf16x8& pa2, bf16x8& pa3) {
#define PK4(P, B_, OUT) do { unsigned a0 = cvtpk(P[B_+0], P[B_+1]), a1 = cvtpk(P[B_+2], P[B_+3]); \
        unsigned b0 = cvtpk(P[B_+4], P[B_+5]), b1 = cvtpk(P[B_+6], P[B_+7]); \
        auto r0 = __builtin_amdgcn_permlane32_swap(a0, b0, false, false); auto r1 = __builtin_amdgcn_permlane32_swap(a1, b1, false, false); \
        u32x4 w = {r0[0], r1[0], r0[1], r1[1]}; OUT = *reinterpret_cast<bf16x8*>(&w); } while (0)
    PK4(p0, 0, pa0); PK4(p0, 8, pa1); PK4(p1, 0, pa2); PK4(p1, 8, pa3);
#undef PK4
}
__device__ __forceinline__ void mask_tile(f32x16& p0, f32x16& p1, int dq) {
    const float NEG = -__builtin_inff();
#pragma unroll
    for (int r = 0; r < 16; ++r) { const int c = (r & 3) + 8 * (r >> 2); if (dq - c < 0) p0[r] = NEG; if (dq - c - 32 < 0) p1[r] = NEG; }
}
constexpr float THR2 = 11.5f;
__device__ __forceinline__ float softmax_step(f32x16& p0, f32x16& p1, float& m_reg, float& l_reg) {
    float pmax = p0[0];
#pragma unroll
    for (int r = 1; r < 16; ++r) pmax = fmaxf(pmax, p0[r]);
#pragma unroll
    for (int r = 0; r < 16; ++r) pmax = fmaxf(pmax, p1[r]);
    pmax = pmax2(pmax);
    float alpha = 1.f;
    if (!__all(pmax - m_reg <= THR2)) { const float mn = fmaxf(m_reg, pmax); alpha = __builtin_amdgcn_exp2f(m_reg - mn); m_reg = mn; }
    float ps = 0.f;
#pragma unroll
    for (int r = 0; r < 16; ++r) { p0[r] = __builtin_amdgcn_exp2f(p0[r] - m_reg); ps += p0[r]; }
#pragma unroll
    for (int r = 0; r < 16; ++r) { p1[r] = __builtin_amdgcn_exp2f(p1[r] - m_reg); ps += p1[r]; }
    l_reg = l_reg * alpha + psum2(ps);
    return alpha;
}
__device__ __forceinline__ void rescale_o(f32x16* o, float alpha, float* al_l, int r32, int hi) {
    if (__any(alpha < 1.f)) { if (hi == 0) al_l[r32] = alpha; asm volatile("s_waitcnt lgkmcnt(0)" ::: "memory");
#pragma unroll
        for (int r = 0; r < 16; ++r) { const float a = al_l[crow(r, hi)];
#pragma unroll
            for (int d = 0; d < 4; ++d) o[d][r] *= a; } }
}

template <int MODE, int KB>
__device__ __forceinline__ void tile_compute(const int t, const int q0, const int r32, const int hi, const char* K_lds, const int vb0, const float* ck_l, float* al_l, const char* qr,
                                             f32x16* o, f32x16* o2, float& m1, float& l1, float& m2, float& l2, float& carry, const float cq2) {
    constexpr float C2 = (MODE >= 2 ? 0.125f : 0.08838834764831845f) * LOG2E;
    const int dq = q0 + r32 - t * 64 - 4 * hi;
    bf16x8 pa0, pa1, pa2, pa3; f32x16 p0, p1;
    if constexpr (MODE == 0) {
        qkt<KB, 0, 8>(p0, p1, K_lds, r32, hi, qr);
        const float* ck = ck_l + KB * 64 + 4 * hi;
#pragma unroll
        for (int g = 0; g < 4; ++g) { const f32x4 c0 = *(const f32x4*)(ck + 8 * g), c1 = *(const f32x4*)(ck + 32 + 8 * g);
#pragma unroll
            for (int e = 0; e < 4; ++e) { p0[4 * g + e] = fmaf(p0[4 * g + e], C2, cq2 - c0[e]); p1[4 * g + e] = fmaf(p1[4 * g + e], C2, cq2 - c1[e]); } }
        if (t * 64 + 63 > q0) mask_tile(p0, p1, dq);
        const float alpha = softmax_step(p0, p1, m1, l1);
        pack_p(p0, p1, pa0, pa1, pa2, pa3);
        rescale_o(o, alpha, al_l, r32, hi);
        pv_tile<KB>(o, vb0, pa0, pa1, pa2, pa3);
    } else if constexpr (MODE == 1) {
        qkt<KB, 0, 8>(p0, p1, K_lds, r32, hi, qr);
        const bool nm = (t * 64 + 63 >= q0);
        f32x16 k0, k1; float gs[8];
#pragma unroll
        for (int r = 0; r < 16; ++r) { const int c = (r & 3) + 8 * (r >> 2);
            { const float z2 = p0[r] * C2, sp = fmaxf(z2, 0.f) + __builtin_amdgcn_logf(1.f + __builtin_amdgcn_exp2f(-fabsf(z2))); const bool valid = !nm || (dq - c - 1 >= 0);
              p0[r] = valid ? (z2 - sp) : -__builtin_inff(); k0[r] = valid ? -sp : 0.f; }
            { const float z2 = p1[r] * C2, sp = fmaxf(z2, 0.f) + __builtin_amdgcn_logf(1.f + __builtin_amdgcn_exp2f(-fabsf(z2))); const bool valid = !nm || (dq - c - 33 >= 0);
              p1[r] = valid ? (z2 - sp) : -__builtin_inff(); k1[r] = valid ? -sp : 0.f; } }
#pragma unroll
        for (int g = 0; g < 4; ++g) { gs[g] = (k0[4 * g] + k0[4 * g + 1]) + (k0[4 * g + 2] + k0[4 * g + 3]); gs[4 + g] = (k1[4 * g] + k1[4 * g + 1]) + (k1[4 * g + 2] + k1[4 * g + 3]); }
        float run = carry;
#pragma unroll
        for (int g = 7; g >= 0; --g) {
            const float tot = psum2(gs[g]); float base = run + (hi == 0 ? (tot - gs[g]) : 0.f);
#pragma unroll
            for (int e = 3; e >= 0; --e) { const int r = 4 * (g & 3) + e;
                if (g >= 4) { const float w = __builtin_amdgcn_exp2f(p1[r] + base); base += k1[r]; p1[r] = w; }
                else { const float w = __builtin_amdgcn_exp2f(p0[r] + base); base += k0[r]; p0[r] = w; } }
            run += tot; }
        carry = run;
        pack_p(p0, p1, pa0, pa1, pa2, pa3);
        pv_tile<KB>(o, vb0, pa0, pa1, pa2, pa3);
    } else {
        qkt<KB, (MODE == 2 ? 0 : 4), (MODE == 2 ? 4 : 8)>(p0, p1, K_lds, r32, hi, qr);
#pragma unroll
        for (int r = 0; r < 16; ++r) { p0[r] *= C2; p1[r] *= C2; }
        const float a1 = softmax_step(p0, p1, m1, l1);
        pack_p(p0, p1, pa0, pa1, pa2, pa3);
        rescale_o(o, a1, al_l, r32, hi);
        pv_tile<KB>(o, vb0, pa0, pa1, pa2, pa3);
    }
}

template <int MODE>
__device__ __forceinline__ void attn_unit(const int tid, char* lds, const bf16_t* ATT, const float* CUM2, bf16_t* OB, float* ODF, int b, int h, int qb, const unsigned* KINF, unsigned char* Gz, const unsigned rank) {
    const int wid = __builtin_amdgcn_readfirstlane(tid >> 6), lane = tid & 63, r32 = lane & 31, hi = lane >> 5;
    const int qc = (MODE == 0 ? C_FQ : MODE == 1 ? C_SQ : C_DQ) + h * 128, kc = (MODE == 0 ? C_FK : MODE == 1 ? C_SK : C_DK) + h * 128, vc = (MODE == 0 ? C_FV : MODE == 1 ? C_SV : C_DV) + h * 128;
    const int oc = (MODE == 0 ? 0 : MODE == 1 ? 768 : 1536) + h * 128;
    const size_t rowb = (size_t)b * SEQ;
    const int q0 = qb * 256 + wid * 32;
    const int NT = 4 * qb + 4;
    char* V_lds = lds + OFF_V; char* K_lds = lds + OFF_K; float* ck_l = (float*)(lds + OFF_CK); float* wsl = (float*)(lds + OFF_WS) + wid * 64; float* li_l = wsl; float* al_l = wsl + 32;
    const int vb0 = (int)(uintptr_t)V_lds + v_rd_base(lane);
    int koff, voff;
    { const int row = tid >> 4, cb = (tid & 15) ^ (row & 7); koff = row * 6144 + cb * 8;
      const int sub = tid >> 5, w = tid & 31, kk = (sub >> 2) * 8 + (w >> 2), k = (kk & ~0xC) | ((kk & 4) << 1) | ((kk & 8) >> 1); voff = k * 6144 + (sub & 3) * 32 + (w & 3) * 8; }
    const bf16_t* Kg = ATT + rowb * 6144 + kc; const bf16_t* Vg = ATT + rowb * 6144 + vc;
    const float* cumh = CUM2 + (size_t)(b * 6 + h) * SEQ;
    LAS char* ldsl = (LAS char*)lds;
    char* qr = lds + OFF_Q + wid * 8192 + lane * 16;
    float qa = 0.f;
#pragma unroll
    for (int d0 = 0; d0 < 8; ++d0) { const bf16x8 f = *(const bf16x8*)(ATT + (rowb + q0 + r32) * 6144 + qc + d0 * 16 + hi * 8); *(bf16x8*)(qr + d0 * 1024) = f;
        if (MODE == 0) {
#pragma unroll
            for (int e = 0; e < 8; ++e) qa += fabsf(__uint_as_float(((unsigned)(unsigned short)f[e]) << 16)); } }
    f32x16 o[4] = {}; f32x16 o2[1] = {};
    float m1 = -1e30f, l1 = 0.f, m2 = -1e30f, l2 = 0.f, carry = 0.f, cq2 = 0.f;
    if (MODE == 0) cq2 = cumh[q0 + r32];
    float ub = 0.f; bool deadw = false;
    if (MODE == 0) ub = psum2(qa) * (__uint_as_float(KINF[b * 8 + h]) * 1.01f) * (0.08838834764831845f * LOG2E) + 1.f;
#define TILE(i) ((MODE <= 1) ? (NT - 1 - (i)) : (i))
#define STAGE(t, bf) do { const bf16_t* kp_ = Kg + (size_t)(t) * (64 * 6144) + koff; const bf16_t* vp_ = Vg + (size_t)(t) * (64 * 6144) + voff; \
        __builtin_amdgcn_global_load_lds((const unsigned*)kp_, (LAS unsigned*)(ldsl + OFF_K + (bf) * SHM_K + wid * 1024), 16, 0, 0); \
        __builtin_amdgcn_global_load_lds((const unsigned*)(kp_ + 32 * 6144), (LAS unsigned*)(ldsl + OFF_K + (bf) * SHM_K + 8192 + wid * 1024), 16, 0, 0); \
        __builtin_amdgcn_global_load_lds((const unsigned*)vp_, (LAS unsigned*)(ldsl + OFF_V + (bf) * SHM_V + wid * 1024), 16, 0, 0); \
        __builtin_amdgcn_global_load_lds((const unsigned*)(vp_ + 32 * 6144), (LAS unsigned*)(ldsl + OFF_V + (bf) * SHM_V + 8192 + wid * 1024), 16, 0, 0); \
        if (MODE == 0 && wid == 0) __builtin_amdgcn_global_load_lds((const unsigned*)(cumh + (t) * 64 + lane), (LAS unsigned*)(ldsl + OFF_CK + (bf) * 256), 4, 0, 0); } while (0)
#define ACTIVE(t) ((MODE == 0) ? ((t) * 64 <= q0 + 31) : (MODE == 1) ? ((t) * 64 < q0 + 31) : ((t) * 64 <= q0))
    volatile int* dn_l = (volatile int*)(lds + (MODE == 1 ? OFF_CK : OFF_WS));
    bool stop = false;
    unsigned zz_ = 0u; asm volatile("" : "+v"(zz_)); const u32x4 zv_ = {zz_, zz_, zz_, zz_}; int zk_ = 0;
#define ZST(k) do { const unsigned o_ = (unsigned)(k) * 512u + (unsigned)tid; const size_t g_ = (size_t)rank * 13108u + o_; if (o_ < 13108u && g_ < (size_t)(NB * SEQ) * 1024u) ((u32x4*)Gz)[g_] = zv_; } while (0)
#define BODY(i, KB) do { const int t_ = TILE(i); \
        if (zk_ < 26) { ZST(zk_); ZST(zk_ + 1); zk_ += 2; } \
        if ((i) + 1 < NT) STAGE(TILE((i) + 1), (KB) ^ 1); \
        const bool dead_ = (MODE == 1) ? __all(carry < -130.f) : deadw; \
        if (ACTIVE(t_) && !dead_) { tile_compute<MODE, KB>(t_, q0, r32, hi, K_lds, vb0, ck_l, al_l, qr, o, o2, m1, l1, m2, l2, carry, cq2); \
            if (MODE == 0) deadw = __all(ub + cq2 - ck_l[(KB) * 64] - m1 < -130.f); } \
        if (MODE <= 1 && lane == 0) dn_l[(KB) * 8 + wid] = ((MODE == 0 ? deadw : dead_) || t_ == 0) ? 1 : 0;     \
        asm volatile("s_waitcnt vmcnt(0) lgkmcnt(0)" ::: "memory"); __syncthreads(); \
        if (MODE <= 1) { int a_ = 1; _Pragma("unroll") for (int w_ = 0; w_ < 8; ++w_) a_ &= dn_l[(KB) * 8 + w_]; stop = (a_ != 0); } } while (0)
    STAGE(TILE(0), 0); asm volatile("s_waitcnt vmcnt(0)" ::: "memory"); __syncthreads();
    for (int i = 0; i < NT; i += 2) { BODY(i, 0); if (MODE <= 1 && stop) break; BODY(i + 1, 1); if (MODE <= 1 && stop) break; }
    if (MODE <= 1) __syncthreads();
    for (; zk_ < 26; ++zk_) ZST(zk_);
    if (MODE != 1) { if (hi == 0) li_l[r32] = 1.f / l1; }
    asm volatile("s_waitcnt lgkmcnt(0)" ::: "memory");
    if (MODE != 1) {
#pragma unroll
        for (int r = 0; r < 16; ++r) { const float f1 = li_l[crow(r, hi)];
#pragma unroll
            for (int d = 0; d < 4; ++d) o[d][r] *= f1; }
    }
    if (MODE >= 2) {
        float* Ow = ODF + ((size_t)(MODE - 2) * (NB * SEQ) + rowb + q0) * 512 + h * 128;
#pragma unroll
        for (int r = 0; r < 16; ++r) { const int orow = crow(r, hi);
#pragma unroll
            for (int d = 0; d < 4; ++d) Ow[(size_t)orow * 512 + d * 32 + r32] = o[d][r]; }
    } else {
        bf16_t* Ow = OB + (rowb + q0) * DM + oc;
#pragma unroll
        for (int r = 0; r < 16; ++r) { const int orow = crow(r, hi);
#pragma unroll
            for (int d = 0; d < 4; ++d) { const float v = o[d][r]; const float vn = __shfl_xor(v, 1);
                if ((r32 & 1) == 0) *(unsigned*)(Ow + (size_t)orow * DM + d * 32 + r32) = cvtpk(v, vn); } }
    }
    __syncthreads();
#undef TILE
#undef STAGE
#undef ACTIVE
#undef BODY
#undef ZST
}
#undef KSWZ
#undef SBAR
}

namespace topk {
using att::f32x16; using att::bf16x8;
constexpr int CA[64] = {0, 0, 0, 0, 0, 0, 0, 0, 0, 0, 0, 0, 0, 0, 0, 0, 1, 1, 1, 1, 1, 1, 1, 1, 2, -1, -1, -1, -1, -1, -1, -1, 2, 2, 2, 2, 3, 3, 3, 3, 4, 4, 4, 5, 5, 6, 6, 7, 7, 8, 9, 10, 11, 12, 13, 14, 15, -1, -1, -1, -1, -1, -1, -1};
constexpr int CB[64] = {0, 1, 2, 3, 4, 5, 6, 7, 8, 9, 10, 11, 12, 13, 14, 15, 0, 1, 2, 3, 4, 5, 6, 7, 0, -1, -1, -1, -1, -1, -1, -1, 1, 2, 3, 4, 0, 1, 2, 3, 0, 1, 2, 0, 1, 0, 1, 0, 1, 0, 0, 0, 0, 0, 0, 0, 0, -1, -1, -1, -1, -1, -1, -1};
__device__ __forceinline__ unsigned mono(float f) { const unsigned u = __float_as_uint(f); return u ^ ((unsigned)((int)u >> 31) | 0x80000000u); }
__device__ __forceinline__ float unmono(unsigned k) { return __uint_as_float((k & 0x80000000u) ? (k ^ 0x80000000u) : ~k); }
__device__ __forceinline__ unsigned umax_(unsigned a, unsigned b) { return a > b ? a : b; }
__device__ __forceinline__ unsigned umin_(unsigned a, unsigned b) { return a < b ? a : b; }
__device__ __forceinline__ unsigned partner_u(unsigned v, int hi) { auto rr = __builtin_amdgcn_permlane32_swap(v, v, false, false); return hi ? rr[0] : rr[1]; }

template <int N> __device__ __forceinline__ void sort_blocks16(unsigned (&x)[N]) {
#pragma unroll
    for (int k = 2; k <= 16; k <<= 1)
#pragma unroll
        for (int j = k >> 1; j > 0; j >>= 1)
#pragma unroll
            for (int i = 0; i < N; ++i) { const int l = i ^ j; if (l > i) { const bool desc = ((i & k) == 0); const unsigned a = x[i], b = x[l], mx = umax_(a, b), mn = umin_(a, b); x[i] = desc ? mx : mn; x[l] = desc ? mn : mx; } }
}
template <bool DESC> __device__ __forceinline__ void merge16(unsigned (&x)[16]) {
#pragma unroll
    for (int j = 8; j > 0; j >>= 1)
#pragma unroll
        for (int i = 0; i < 16; ++i) { const int l = i ^ j; if (l > i) { const unsigned a = x[i], b = x[l], mx = umax_(a, b), mn = umin_(a, b); x[i] = DESC ? mx : mn; x[l] = DESC ? mn : mx; } }
}
__device__ __forceinline__ void top16_of_pair(unsigned (&x)[64], unsigned (&w)[16], int hi) {
    sort_blocks16<64>(x);
    unsigned y[16], z[16];
#pragma unroll
    for (int i = 0; i < 16; ++i) { y[i] = umax_(x[i], x[16 + i]); z[i] = umax_(x[32 + i], x[48 + i]); }
    merge16<true>(y); merge16<false>(z);
#pragma unroll
    for (int i = 0; i < 16; ++i) w[i] = umax_(y[i], z[i]);
    merge16<true>(w);
    unsigned pr[16];
#pragma unroll
    for (int i = 0; i < 16; ++i) pr[i] = partner_u(w[i], hi);
#pragma unroll
    for (int i = 0; i < 16; ++i) w[i] = umax_(w[i], pr[15 - i]);
    merge16<true>(w);
}
__device__ __forceinline__ void ce2(float& va, unsigned& pa, float& vb, unsigned& pb, bool desc) {
    const bool sw = desc ? (vb > va) : (va > vb); const float tv = sw ? vb : va, uv = sw ? va : vb; const unsigned tp = sw ? pb : pa, up = sw ? pa : pb; va = tv; pa = tp; vb = uv; pb = up;
}
__device__ __forceinline__ void merge16v(float (&v)[16], unsigned (&p)[16]) {
#pragma unroll
    for (int j = 8; j > 0; j >>= 1)
#pragma unroll
        for (int i = 0; i < 16; ++i) { const int l = i ^ j; if (l > i) ce2(v[i], p[i], v[l], p[l], true); }
}

__device__ __forceinline__ void scores_half(f32x16& pA, f32x16& pB, f32x16& pC, f32x16& pD, const char* imgs, int r32, int hi, const float* qrow) {
    pA = f32x16{}; pB = f32x16{}; pC = f32x16{}; pD = f32x16{};
    int kb[4];
#pragma unroll
    for (int dd = 0; dd < 4; ++dd) kb[dd] = r32 * 256 + (((dd * 16 + hi * 8) * 2) ^ ((r32 & 7) << 4));
    att::f32x4 qa[4], qb[4];
#pragma unroll
    for (int d0 = 0; d0 < 4; ++d0) { qa[d0] = *(const att::f32x4*)(qrow + d0 * 16 + hi * 8); qb[d0] = *(const att::f32x4*)(qrow + d0 * 16 + hi * 8 + 4); }
#pragma unroll
    for (int d0 = 0; d0 < 8; ++d0) { const int a = kb[d0 & 3] + (d0 >> 2) * 128;
        const att::f32x4 fa = d0 < 4 ? qa[d0 & 3] : *(const att::f32x4*)(qrow + d0 * 16 + hi * 8), fb = d0 < 4 ? qb[d0 & 3] : *(const att::f32x4*)(qrow + d0 * 16 + hi * 8 + 4);
        const float f[8] = {fa[0], fa[1], fa[2], fa[3], fb[0], fb[1], fb[2], fb[3]}; unsigned hw[4], lw[4];
#pragma unroll
        for (int e = 0; e < 4; ++e) { const unsigned h2 = att::cvtpk(f[2 * e], f[2 * e + 1]); hw[e] = h2;
            lw[e] = att::cvtpk(f[2 * e] - __uint_as_float(h2 << 16), f[2 * e + 1] - __uint_as_float(h2 & 0xffff0000u)); }
        att::u32x4 hv = {hw[0], hw[1], hw[2], hw[3]}, lv = {lw[0], lw[1], lw[2], lw[3]}; const bf16x8 qh = *reinterpret_cast<bf16x8*>(&hv), ql = *reinterpret_cast<bf16x8*>(&lv);
#pragma unroll
        for (int tl = 0; tl < 2; ++tl) { const char* img_hi = imgs + tl * 32768; const char* img_lo = img_hi + 16384;
            const bf16x8 h0 = *reinterpret_cast<const bf16x8*>(img_hi + a), h1 = *reinterpret_cast<const bf16x8*>(img_hi + a + 32 * 256);
            const bf16x8 l0 = *reinterpret_cast<const bf16x8*>(img_lo + a), l1 = *reinterpret_cast<const bf16x8*>(img_lo + a + 32 * 256);
            f32x16& q0 = tl ? pC : pA; f32x16& q1 = tl ? pD : pB;
            q0 = __builtin_amdgcn_mfma_f32_32x32x16_bf16(h0, qh, q0, 0, 0, 0); q1 = __builtin_amdgcn_mfma_f32_32x32x16_bf16(h1, qh, q1, 0, 0, 0);
            q0 = __builtin_amdgcn_mfma_f32_32x32x16_bf16(l0, qh, q0, 0, 0, 0); q1 = __builtin_amdgcn_mfma_f32_32x32x16_bf16(l1, qh, q1, 0, 0, 0);
            q0 = __builtin_amdgcn_mfma_f32_32x32x16_bf16(h0, ql, q0, 0, 0, 0); q1 = __builtin_amdgcn_mfma_f32_32x32x16_bf16(h1, ql, q1, 0, 0, 0); } }
}
__device__ __forceinline__ void half_top16(const float* qrow, const char* imgs  , int r32, int hi, unsigned (&w)[16]) {
    unsigned x[64]; const unsigned ib = 127u - 4u * (unsigned)hi;
    { f32x16 pA, pB, pC, pD; scores_half(pA, pB, pC, pD, imgs, r32, hi, qrow);
#pragma unroll
      for (int r = 0; r < 16; ++r) { const unsigned c = (unsigned)((r & 3) + 8 * (r >> 2));
          x[r] = (mono(pA[r]) & ~127u) | (ib - c); x[16 + r] = (mono(pB[r]) & ~127u) | (ib - c - 32u);
          x[32 + r] = (mono(pC[r]) & ~127u) | (ib - c - 64u); x[48 + r] = (mono(pD[r]) & ~127u) | (ib - c - 96u); } }
    top16_of_pair(x, w, hi);
}
__device__ __forceinline__ void combine_top16(const unsigned (&w1)[16], const unsigned (&w2)[16], int hi, float (&bv)[16], unsigned (&bp)[16]) {
    float s1[16], s2[16]; unsigned i1[16], i2[16];
#pragma unroll
    for (int i = 0; i < 16; ++i) { s1[i] = unmono(w1[i] & ~127u); s2[i] = unmono(w2[i] & ~127u); i1[i] = 127u - (w1[i] & 127u); i2[i] = 127u - (w2[i] & 127u); }
    float v[32]; unsigned p[32];
#pragma unroll
    for (int k = 0; k < 32; ++k) {
        float v0 = -__builtin_inff(), v1 = -__builtin_inff(); unsigned q0 = 0u, q1 = 0u;
        if (CA[k] >= 0) { v0 = s1[CA[k] < 0 ? 0 : CA[k]] + s2[CB[k] < 0 ? 0 : CB[k]]; q0 = (i1[CA[k] < 0 ? 0 : CA[k]] << 7) | i2[CB[k] < 0 ? 0 : CB[k]]; }
        if (CA[32 + k] >= 0) { v1 = s1[CA[32 + k] < 0 ? 0 : CA[32 + k]] + s2[CB[32 + k] < 0 ? 0 : CB[32 + k]]; q1 = (i1[CA[32 + k] < 0 ? 0 : CA[32 + k]] << 7) | i2[CB[32 + k] < 0 ? 0 : CB[32 + k]]; }
        v[k] = hi ? v1 : v0; p[k] = hi ? q1 : q0; }
#pragma unroll
    for (int kk = 2; kk <= 16; kk <<= 1)
#pragma unroll
        for (int j = kk >> 1; j > 0; j >>= 1)
#pragma unroll
            for (int i = 0; i < 32; ++i) { const int l = i ^ j; if (l > i) ce2(v[i], p[i], v[l], p[l], (i & kk) == 0); }
#pragma unroll
    for (int i = 0; i < 16; ++i) { const bool t = v[16 + i] > v[i]; bv[i] = t ? v[16 + i] : v[i]; bp[i] = t ? p[16 + i] : p[i]; }
    merge16v(bv, bp);
    float pv[16]; unsigned pp[16];
#pragma unroll
    for (int i = 0; i < 16; ++i) { pv[i] = __uint_as_float(partner_u(__float_as_uint(bv[i]), hi)); pp[i] = partner_u(bp[i], hi); }
#pragma unroll
    for (int i = 0; i < 16; ++i) { const bool t = pv[15 - i] > bv[i]; bv[i] = t ? pv[15 - i] : bv[i]; bp[i] = t ? pp[15 - i] : bp[i]; }
    merge16v(bv, bp);
}
}

static __device__ const unsigned short ATT_UNITS[640] = {8207, 8223, 8239, 8255, 10255, 10271, 10287, 10303, 12303, 12319, 12335, 12351, 14351, 14367, 14383, 14399, 8206, 8222, 8238, 8254, 10254, 10270, 10286, 10302, 12302, 12318, 12334, 12350, 14350, 14366, 14382, 14398, 8205, 8221, 8237, 8253, 10253, 10269, 10285, 10301, 12301, 12317, 12333, 12349, 14349, 14365, 14381, 14397, 8204, 8220, 8236, 8252, 10252, 10268, 10284, 10300, 12300, 12316, 12332, 12348, 14348, 14364, 14380, 14396, 8203, 8219, 8235, 8251, 10251, 10267, 10283, 10299, 12299, 12315, 12331, 12347, 14347, 14363, 14379, 14395, 8202, 8218, 8234, 8250, 10250, 10266, 10282, 10298, 12298, 12314, 12330, 12346, 14346, 14362, 14378, 14394, 8201, 8217, 8233, 8249, 10249, 10265, 10281, 10297, 12297, 12313, 12329, 12345, 14345, 14361, 14377, 14393, 8200, 8216, 8232, 8248, 10248, 10264, 10280, 10296, 12296, 12312, 12328, 12344, 14344, 14360, 14376, 14392, 8199, 8215, 8231, 8247, 10247, 10263, 10279, 10295, 12295, 12311, 12327, 12343, 14343, 14359, 14375, 14391, 8198, 8214, 8230, 8246, 10246, 10262, 10278, 10294, 12294, 12310, 12326, 12342, 14342, 14358, 14374, 14390, 4, 20, 36, 52, 68, 84, 2052, 2068, 2084, 2100, 2116, 2132, 5, 21, 37, 53, 69, 85, 2053, 2069, 2085, 2101, 2117, 2133, 6, 22, 38, 54, 70, 86, 2054, 2070, 2086, 2102, 2118, 2134, 7, 23, 39, 55, 71, 87, 2055, 2071, 2087, 2103, 2119, 2135, 8, 24, 40, 56, 72, 88, 2056, 2072, 2088, 2104, 2120, 2136, 9, 25, 41, 57, 73, 89, 2057, 2073, 2089, 2105, 2121, 2137, 10, 26, 42, 58, 74, 90, 2058, 2074, 2090, 2106, 2122, 2138, 11, 27, 43, 59, 75, 91, 2059, 2075, 2091, 2107, 2123, 2139, 12, 28, 44, 60, 76, 92, 2060, 2076, 2092, 2108, 2124, 2140, 13, 29, 45, 61, 77, 93, 2061, 2077, 2093, 2109, 2125, 2141, 14, 30, 46, 62, 78, 94, 2062, 2078, 2094, 2110, 2126, 2142, 15, 31, 47, 63, 79, 95, 2063, 2079, 2095, 2111, 2127, 2143, 8197, 8213, 8229, 8245, 10245, 10261, 10277, 10293, 12293, 12309, 12325, 12341, 14341, 14357, 14373, 14389, 3, 19, 35, 51, 67, 83, 2051, 2067, 2083, 2099, 2115, 2131, 8196, 8212, 8228, 8244, 10244, 10260, 10276, 10292, 12292, 12308, 12324, 12340, 14340, 14356, 14372, 14388, 8195, 8211, 8227, 8243, 10243, 10259, 10275, 10291, 12291, 12307, 12323, 12339, 14339, 14355, 14371, 14387, 2, 18, 34, 50, 66, 82, 2050, 2066, 2082, 2098, 2114, 2130, 8194, 8210, 8226, 8242, 10242, 10258, 10274, 10290, 12290, 12306, 12322, 12338, 14338, 14354, 14370, 14386, 4097, 4113, 4129, 4145, 4161, 4177, 6145, 6161, 6177, 6193, 6209, 6225, 4098, 4114, 4130, 4146, 4162, 4178, 6146, 6162, 6178, 6194, 6210, 6226, 4099, 4115, 4131, 4147, 4163, 4179, 6147, 6163, 6179, 6195, 6211, 6227, 4100, 4116, 4132, 4148, 4164, 4180, 6148, 6164, 6180, 6196, 6212, 6228, 4101, 4117, 4133, 4149, 4165, 4181, 6149, 6165, 6181, 6197, 6213, 6229, 4102, 4118, 4134, 4150, 4166, 4182, 6150, 6166, 6182, 6198, 6214, 6230, 4103, 4119, 4135, 4151, 4167, 4183, 6151, 6167, 6183, 6199, 6215, 6231, 4104, 4120, 4136, 4152, 4168, 4184, 6152, 6168, 6184, 6200, 6216, 6232, 4105, 4121, 4137, 4153, 4169, 4185, 6153, 6169, 6185, 6201, 6217, 6233, 4106, 4122, 4138, 4154, 4170, 4186, 6154, 6170, 6186, 6202, 6218, 6234, 4107, 4123, 4139, 4155, 4171, 4187, 6155, 6171, 6187, 6203, 6219, 6235, 4108, 4124, 4140, 4156, 4172, 4188, 6156, 6172, 6188, 6204, 6220, 6236, 4109, 4125, 4141, 4157, 4173, 4189, 6157, 6173, 6189, 6205, 6221, 6237, 4110, 4126, 4142, 4158, 4174, 4190, 6158, 6174, 6190, 6206, 6222, 6238, 4111, 4127, 4143, 4159, 4175, 4191, 6159, 6175, 6191, 6207, 6223, 6239, 1, 17, 33, 49, 65, 81, 2049, 2065, 2081, 2097, 2113, 2129, 8193, 8209, 8225, 8241, 10241, 10257, 10273, 10289, 12289, 12305, 12321, 12337, 14337, 14353, 14369, 14385, 4096, 4112, 4128, 4144, 4160, 4176, 6144, 6160, 6176, 6192, 6208, 6224, 0, 16, 32, 48, 64, 80, 2048, 2064, 2080, 2096, 2112, 2128, 8192, 8208, 8224, 8240, 10240, 10256, 10272, 10288, 12288, 12304, 12320, 12336, 14336, 14352, 14368, 14384};
constexpr int N_ATT_ITEMS0 = 1920;
static __device__ const unsigned short ATT_ITEMS0[N_ATT_ITEMS0] = {8207, 8223, 8239, 8255, 10255, 10271, 10287, 10303, 12303, 12319, 12335, 12351, 14351, 14367, 14383, 14399, 8206, 8222, 8238, 8254, 10254, 10270, 10286, 10302, 12302, 12318, 12334, 12350, 14350, 14366, 14382, 14398, 8205, 8221, 8237, 8253, 10253, 10269, 10285, 10301, 12301, 12317, 12333, 12349, 14349, 14365, 14381, 14397, 8204, 8220, 8236, 8252, 10252, 10268, 10284, 10300, 12300, 12316, 12332, 12348, 14348, 14364, 14380, 14396, 8203, 8219, 8235, 8251, 10251, 10267, 10283, 10299, 12299, 12315, 12331, 12347, 14347, 14363, 14379, 14395, 8202, 8218, 8234, 8250, 10250, 10266, 10282, 10298, 12298, 12314, 12330, 12346, 14346, 14362, 14378, 14394, 8201, 8217, 8233, 8249, 10249, 10265, 10281, 10297, 12297, 12313, 12329, 12345, 14345, 14361, 14377, 14393, 8200, 8216, 8232, 8248, 10248, 10264, 10280, 10296, 12296, 12312, 12328, 12344, 14344, 14360, 14376, 14392, 8199, 8215, 8231, 8247, 10247, 10263, 10279, 10295, 12295, 12311, 12327, 12343, 14343, 14359, 14375, 14391, 8198, 8214, 8230, 8246, 10246, 10262, 10278, 10294, 12294, 12310, 12326, 12342, 14342, 14358, 14374, 14390, 4, 20, 36, 52, 68, 84, 2052, 2068, 2084, 2100, 2116, 2132, 5, 21, 37, 53, 69, 85, 2053, 2069, 2085, 2101, 2117, 2133, 6, 22, 38, 54, 70, 86, 2054, 2070, 2086, 2102, 2118, 2134, 7, 23, 39, 55, 71, 87, 2055, 2071, 2087, 2103, 2119, 2135, 8, 24, 40, 56, 72, 88, 2056, 2072, 2088, 2104, 2120, 2136, 9, 25, 41, 57, 73, 89, 2057, 2073, 2089, 2105, 2121, 2137, 10, 26, 42, 58, 74, 90, 2058, 2074, 2090, 2106, 2122, 2138, 11, 27, 43, 59, 75, 91, 2059, 2075, 2091, 2107, 2123, 2139, 45056, 45057, 45058, 45059, 45060, 45061, 45062, 45063, 45064, 45065, 45066, 45067, 45068, 45069, 45070, 45071, 45072, 45073, 45074, 45075, 45076, 45077, 45078, 45079, 45080, 45081, 45082, 45083, 45084, 45085, 45086, 45087, 45088, 45089, 45090, 45091, 45092, 45093, 45094, 45095, 45096, 45097, 45098, 45099, 45100, 45101, 45102, 45103, 45104, 45105, 45106, 45107, 45108, 45109, 45110, 45111, 45112, 45113, 45114, 45115, 45116, 45117, 45118, 45119, 45120, 45121, 45122, 45123, 45124, 45125, 45126, 45127, 45128, 45129, 45130, 45131, 45132, 45133, 45134, 45135, 45136, 45137, 45138, 45139, 45140, 45141, 45142, 45143, 45144, 45145, 45146, 45147, 45148, 45149, 45150, 45151, 45152, 45153, 45154, 45155, 45156, 45157, 45158, 45159, 45160, 45161, 45162, 45163, 45164, 45165, 45166, 45167, 45168, 45169, 45170, 45171, 45172, 45173, 45174, 45175, 45176, 45177, 45178, 45179, 45180, 45181, 45182, 45183, 12, 28, 44, 60, 76, 92, 2060, 2076, 2092, 2108, 2124, 2140, 13, 29, 45, 61, 77, 93, 2061, 2077, 2093, 2109, 2125, 2141, 14, 30, 46, 62, 78, 94, 2062, 2078, 2094, 2110, 2126, 2142, 15, 31, 47, 63, 79, 95, 2063, 2079, 2095, 2111, 2127, 2143, 8197, 8213, 8229, 8245, 10245, 10261, 10277, 10293, 12293, 12309, 12325, 12341, 14341, 14357, 14373, 14389, 3, 19, 35, 51, 67, 83, 2051, 2067, 2083, 2099, 2115, 2131, 8196, 8212, 8228, 8244, 10244, 10260, 10276, 10292, 12292, 12308, 12324, 12340, 14340, 14356, 14372, 14388, 8195, 8211, 8227, 8243, 10243, 10259, 10275, 10291, 12291, 12307, 12323, 12339, 14339, 14355, 14371, 14387, 2, 18, 34, 50, 66, 82, 2050, 2066, 2082, 2098, 2114, 2130, 8194, 8210, 8226, 8242, 10242, 10258, 10274, 10290, 12290, 12306, 12322, 12338, 14338, 14354, 14370, 14386, 4097, 4113, 4129, 4145, 4161, 4177, 6145, 6161, 6177, 6193, 6209, 6225, 4098, 4114, 4130, 4146, 4162, 4178, 6146, 6162, 6178, 6194, 6210, 6226, 4099, 4115, 4131, 4147, 4163, 4179, 6147, 6163, 6179, 6195, 6211, 6227, 4100, 4116, 4132, 4148, 4164, 4180, 6148, 6164, 6180, 6196, 6212, 6228, 4101, 4117, 4133, 4149, 4165, 4181, 6149, 6165, 6181, 6197, 6213, 6229, 4102, 4118, 4134, 4150, 4166, 4182, 6150, 6166, 6182, 6198, 6214, 6230, 4103, 4119, 4135, 4151, 4167, 4183, 6151, 6167, 6183, 6199, 6215, 6231, 4104, 4120, 4136, 4152, 4168, 4184, 6152, 6168, 6184, 6200, 6216, 6232, 4105, 4121, 4137, 4153, 4169, 4185, 6153, 6169, 6185, 6201, 6217, 6233, 4106, 4122, 4138, 4154, 4170, 4186, 6154, 6170, 6186, 6202, 6218, 6234, 4107, 4123, 4139, 4155, 4171, 4187, 6155, 6171, 6187, 6203, 6219, 6235, 4108, 4124, 4140, 4156, 4172, 4188, 6156, 6172, 6188, 6204, 6220, 6236, 4109, 4125, 4141, 4157, 4173, 4189, 6157, 6173, 6189, 6205, 6221, 6237, 4110, 4126, 4142, 4158, 4174, 4190, 6158, 6174, 6190, 6206, 6222, 6238, 4111, 4127, 4143, 4159, 4175, 4191, 6159, 6175, 6191, 6207, 6223, 6239, 49152, 49153, 49154, 49155, 49156, 49157, 49158, 49159, 49160, 49161, 49162, 49163, 49164, 49165, 49166, 49167, 49168, 49169, 49170, 49171, 49172, 49173, 49174, 49175, 49176, 49177, 49178, 49179, 49180, 49181, 49182, 49183, 49184, 49185, 49186, 49187, 49188, 49189, 49190, 49191, 49192, 49193, 49194, 49195, 49196, 49197, 49198, 49199, 49200, 49201, 49202, 49203, 49204, 49205, 49206, 49207, 49208, 49209, 49210, 49211, 49212, 49213, 49214, 49215, 49216, 49217, 49218, 49219, 49220, 49221, 49222, 49223, 49224, 49225, 49226, 49227, 49228, 49229, 49230, 49231, 49232, 49233, 49234, 49235, 49236, 49237, 49238, 49239, 49240, 49241, 49242, 49243, 49244, 49245, 49246, 49247, 49248, 49249, 49250, 49251, 49252, 49253, 49254, 49255, 49256, 49257, 49258, 49259, 49260, 49261, 49262, 49263, 49264, 49265, 49266, 49267, 49268, 49269, 49270, 49271, 49272, 49273, 49274, 49275, 49276, 49277, 49278, 49279, 49280, 49281, 49282, 49283, 49284, 49285, 49286, 49287, 49288, 49289, 49290, 49291, 49292, 49293, 49294, 49295, 49296, 49297, 49298, 49299, 49300, 49301, 49302, 49303, 49304, 49305, 49306, 49307, 49308, 49309, 49310, 49311, 49312, 49313, 49314, 49315, 49316, 49317, 49318, 49319, 49320, 49321, 49322, 49323, 49324, 49325, 49326, 49327, 49328, 49329, 49330, 49331, 49332, 49333, 49334, 49335, 49336, 49337, 49338, 49339, 49340, 49341, 49342, 49343, 49344, 49345, 49346, 49347, 49348, 49349, 49350, 49351, 49352, 49353, 49354, 49355, 49356, 49357, 49358, 49359, 49360, 49361, 49362, 49363, 49364, 49365, 49366, 49367, 49368, 49369, 49370, 49371, 49372, 49373, 49374, 49375, 49376, 49377, 49378, 49379, 49380, 49381, 49382, 49383, 49384, 49385, 49386, 49387, 49388, 49389, 49390, 49391, 49392, 49393, 49394, 49395, 49396, 49397, 49398, 49399, 49400, 49401, 49402, 49403, 49404, 49405, 49406, 49407, 49408, 49409, 49410, 49411, 49412, 49413, 49414, 49415, 49416, 49417, 49418, 49419, 49420, 49421, 49422, 49423, 49424, 49425, 49426, 49427, 49428, 49429, 49430, 49431, 49432, 49433, 49434, 49435, 49436, 49437, 49438, 49439, 49440, 49441, 49442, 49443, 49444, 49445, 49446, 49447, 49448, 49449, 49450, 49451, 49452, 49453, 49454, 49455, 49456, 49457, 49458, 49459, 49460, 49461, 49462, 49463, 49464, 49465, 49466, 49467, 49468, 49469, 49470, 49471, 49472, 49473, 49474, 49475, 49476, 49477, 49478, 49479, 49480, 49481, 49482, 49483, 49484, 49485, 49486, 49487, 49488, 49489, 49490, 49491, 49492, 49493, 49494, 49495, 49496, 49497, 49498, 49499, 49500, 49501, 49502, 49503, 49504, 49505, 49506, 49507, 49508, 49509, 49510, 49511, 49512, 49513, 49514, 49515, 49516, 49517, 49518, 49519, 49520, 49521, 49522, 49523, 49524, 49525, 49526, 49527, 49528, 49529, 49530, 49531, 49532, 49533, 49534, 49535, 49536, 49537, 49538, 49539, 49540, 49541, 49542, 49543, 49544, 49545, 49546, 49547, 49548, 49549, 49550, 49551, 49552, 49553, 49554, 49555, 49556, 49557, 49558, 49559, 49560, 49561, 49562, 49563, 49564, 49565, 49566, 49567, 49568, 49569, 49570, 49571, 49572, 49573, 49574, 49575, 49576, 49577, 49578, 49579, 49580, 49581, 49582, 49583, 49584, 49585, 49586, 49587, 49588, 49589, 49590, 49591, 49592, 49593, 49594, 49595, 49596, 49597, 49598, 49599, 49600, 49601, 49602, 49603, 49604, 49605, 49606, 49607, 49608, 49609, 49610, 49611, 49612, 49613, 49614, 49615, 49616, 49617, 49618, 49619, 49620, 49621, 49622, 49623, 49624, 49625, 49626, 49627, 49628, 49629, 49630, 49631, 49632, 49633, 49634, 49635, 49636, 49637, 49638, 49639, 49640, 49641, 49642, 49643, 49644, 49645, 49646, 49647, 49648, 49649, 49650, 49651, 49652, 49653, 49654, 49655, 49656, 49657, 49658, 49659, 49660, 49661, 49662, 49663, 1, 17, 33, 49, 65, 81, 2049, 2065, 2081, 2097, 2113, 2129, 8193, 8209, 8225, 8241, 10241, 10257, 10273, 10289, 12289, 12305, 12321, 12337, 14337, 14353, 14369, 14385, 40960, 40961, 40962, 40963, 40964, 40965, 40966, 40967, 40968, 40969, 40970, 40971, 40972, 40973, 40974, 40975, 40976, 40977, 40978, 40979, 40980, 40981, 40982, 40983, 40984, 40985, 40986, 40987, 40988, 40989, 40990, 40991, 40992, 40993, 40994, 40995, 40996, 40997, 40998, 40999, 41000, 41001, 41002, 41003, 41004, 41005, 41006, 41007, 41008, 41009, 41010, 41011, 41012, 41013, 41014, 41015, 41016, 41017, 41018, 41019, 41020, 41021, 41022, 41023, 41024, 41025, 41026, 41027, 41028, 41029, 41030, 41031, 41032, 41033, 41034, 41035, 41036, 41037, 41038, 41039, 41040, 41041, 41042, 41043, 41044, 41045, 41046, 41047, 41048, 41049, 41050, 41051, 41052, 41053, 41054, 41055, 41056, 41057, 41058, 41059, 41060, 41061, 41062, 41063, 41064, 41065, 41066, 41067, 41068, 41069, 41070, 41071, 41072, 41073, 41074, 41075, 41076, 41077, 41078, 41079, 41080, 41081, 41082, 41083, 41084, 41085, 41086, 41087, 4096, 4112, 4128, 4144, 4160, 4176, 6144, 6160, 6176, 6192, 6208, 6224, 0, 16, 32, 48, 64, 80, 2048, 2064, 2080, 2096, 2112, 2128, 8192, 8208, 8224, 8240, 10240, 10256, 10272, 10288, 12288, 12304, 12320, 12336, 14336, 14352, 14368, 14384, 32768, 32769, 32770, 32771, 32772, 32773, 32774, 32775, 32776, 32777, 32778, 32779, 32780, 32781, 32782, 32783, 32784, 32785, 32786, 32787, 32788, 32789, 32790, 32791, 32792, 32793, 32794, 32795, 32796, 32797, 32798, 32799, 32800, 32801, 32802, 32803, 32804, 32805, 32806, 32807, 32808, 32809, 32810, 32811, 32812, 32813, 32814, 32815, 32816, 32817, 32818, 32819, 32820, 32821, 32822, 32823, 32824, 32825, 32826, 32827, 32828, 32829, 32830, 32831, 32832, 32833, 32834, 32835, 32836, 32837, 32838, 32839, 32840, 32841, 32842, 32843, 32844, 32845, 32846, 32847, 32848, 32849, 32850, 32851, 32852, 32853, 32854, 32855, 32856, 32857, 32858, 32859, 32860, 32861, 32862, 32863, 32864, 32865, 32866, 32867, 32868, 32869, 32870, 32871, 32872, 32873, 32874, 32875, 32876, 32877, 32878, 32879, 32880, 32881, 32882, 32883, 32884, 32885, 32886, 32887, 32888, 32889, 32890, 32891, 32892, 32893, 32894, 32895, 32896, 32897, 32898, 32899, 32900, 32901, 32902, 32903, 32904, 32905, 32906, 32907, 32908, 32909, 32910, 32911, 32912, 32913, 32914, 32915, 32916, 32917, 32918, 32919, 32920, 32921, 32922, 32923, 32924, 32925, 32926, 32927, 32928, 32929, 32930, 32931, 32932, 32933, 32934, 32935, 32936, 32937, 32938, 32939, 32940, 32941, 32942, 32943, 32944, 32945, 32946, 32947, 32948, 32949, 32950, 32951, 32952, 32953, 32954, 32955, 32956, 32957, 32958, 32959, 32960, 32961, 32962, 32963, 32964, 32965, 32966, 32967, 32968, 32969, 32970, 32971, 32972, 32973, 32974, 32975, 32976, 32977, 32978, 32979, 32980, 32981, 32982, 32983, 32984, 32985, 32986, 32987, 32988, 32989, 32990, 32991, 32992, 32993, 32994, 32995, 32996, 32997, 32998, 32999, 33000, 33001, 33002, 33003, 33004, 33005, 33006, 33007, 33008, 33009, 33010, 33011, 33012, 33013, 33014, 33015, 33016, 33017, 33018, 33019, 33020, 33021, 33022, 33023, 33024, 33025, 33026, 33027, 33028, 33029, 33030, 33031, 33032, 33033, 33034, 33035, 33036, 33037, 33038, 33039, 33040, 33041, 33042, 33043, 33044, 33045, 33046, 33047, 33048, 33049, 33050, 33051, 33052, 33053, 33054, 33055, 33056, 33057, 33058, 33059, 33060, 33061, 33062, 33063, 33064, 33065, 33066, 33067, 33068, 33069, 33070, 33071, 33072, 33073, 33074, 33075, 33076, 33077, 33078, 33079, 33080, 33081, 33082, 33083, 33084, 33085, 33086, 33087, 33088, 33089, 33090, 33091, 33092, 33093, 33094, 33095, 33096, 33097, 33098, 33099, 33100, 33101, 33102, 33103, 33104, 33105, 33106, 33107, 33108, 33109, 33110, 33111, 33112, 33113, 33114, 33115, 33116, 33117, 33118, 33119, 33120, 33121, 33122, 33123, 33124, 33125, 33126, 33127, 33128, 33129, 33130, 33131, 33132, 33133, 33134, 33135, 33136, 33137, 33138, 33139, 33140, 33141, 33142, 33143, 33144, 33145, 33146, 33147, 33148, 33149, 33150, 33151, 36864, 36865, 36866, 36867, 36868, 36869, 36870, 36871, 36872, 36873, 36874, 36875, 36876, 36877, 36878, 36879, 36880, 36881, 36882, 36883, 36884, 36885, 36886, 36887, 36888, 36889, 36890, 36891, 36892, 36893, 36894, 36895, 36896, 36897, 36898, 36899, 36900, 36901, 36902, 36903, 36904, 36905, 36906, 36907, 36908, 36909, 36910, 36911, 36912, 36913, 36914, 36915, 36916, 36917, 36918, 36919, 36920, 36921, 36922, 36923, 36924, 36925, 36926, 36927, 36928, 36929, 36930, 36931, 36932, 36933, 36934, 36935, 36936, 36937, 36938, 36939, 36940, 36941, 36942, 36943, 36944, 36945, 36946, 36947, 36948, 36949, 36950, 36951, 36952, 36953, 36954, 36955, 36956, 36957, 36958, 36959, 36960, 36961, 36962, 36963, 36964, 36965, 36966, 36967, 36968, 36969, 36970, 36971, 36972, 36973, 36974, 36975, 36976, 36977, 36978, 36979, 36980, 36981, 36982, 36983, 36984, 36985, 36986, 36987, 36988, 36989, 36990, 36991};


__global__ void __launch_bounds__(NTHR, 2) fwd_kernel(Args args) {
    extern __shared__ __attribute__((aligned(16))) unsigned char lds_raw[];
    float* lds = (float*)lds_raw;
    const int G = gridDim.x, NGW = G * NWAVES, NGT = G * NTHR;
    const int wave_u_ = __builtin_amdgcn_readfirstlane(threadIdx.x >> 6);
#define PHASE_VARS unsigned z0_ = 0u; asm volatile("" : "+v"(z0_));   \
    int tid = wave_u_ * 64 + (int)__builtin_amdgcn_mbcnt_hi(~0u, __builtin_amdgcn_mbcnt_lo(~0u, z0_)); int bid = blockIdx.x; asm volatile("" : "+s"(bid)); \
    const int lane = tid & 63, wave = tid >> 6, gw = bid * NWAVES + wave, gtid = bid * NTHR + tid; (void)lane; (void)gw; (void)gtid;
    volatile LAS unsigned* MISC = (volatile LAS unsigned*)((LAS unsigned char*)lds_raw + MISC_OFF);
    { const int tid = threadIdx.x;
    unsigned char* ws = args.ws;
    if (tid < 64) MISC[tid] = 0u;
    __syncthreads();
    (void)xcd_barrier_post((unsigned*)(ws + WS_CTL) + CW_BAR, MISC + 8);

    if (tid == 0) {
        volatile LAS unsigned long long* pt = (volatile LAS unsigned long long*)(MISC + 64);
#define PT_SET(i) pt[i] = (unsigned long long)args.in[i]
        PT_SET(0); PT_SET(1); PT_SET(2); PT_SET(3); PT_SET(4); PT_SET(5); PT_SET(6); PT_SET(7); PT_SET(8); PT_SET(9); PT_SET(10); PT_SET(11);
        PT_SET(12); PT_SET(13); PT_SET(14); PT_SET(15); PT_SET(16); PT_SET(17); PT_SET(18); PT_SET(19); PT_SET(20); PT_SET(21); PT_SET(22);
#undef PT_SET
        pt[23] = (unsigned long long)args.out; pt[24] = (unsigned long long)args.ws;
    }
    __syncthreads(); }
#define GRID_BAR() do { XcdBarrier b_; b_.bar = (unsigned*)((unsigned char*)ldp(MISC + 64, 24) + WS_CTL) + CW_BAR; b_.x = xb_xcc_id(); b_.st = MISC + 8; unsigned zb_ = 0u; asm volatile("" : "+v"(zb_)); xcd_barrier(b_, wave_u_ == 0 && __builtin_amdgcn_mbcnt_hi(~0u, __builtin_amdgcn_mbcnt_lo(~0u, zb_)) == 0u); } while (0)
#define IN(i) ldp(MISC + 64, i)
#define WSF(off) ((float*)((unsigned char*)ldp(MISC + 64, 24) + (off)))

    auto cv_win = [&](const int item, const int tid) __attribute__((always_inline)) {
        const int lane = tid & 63; const float* w_in = IN(7); signed char* WT8 = (signed char*)WSF(WS_WINT); float* SW = WSF(WS_SW); LAS unsigned* cm = (LAS unsigned*)((LAS unsigned char*)lds_raw + 140 * 1024);
        const int c4 = tid & 7, rg = tid >> 3; const int l = item / 384, n0 = (item % 384) * 32 + 4 * c4; const int sc0 = win_src_col(n0);
        __syncthreads();
        if (tid < 32) cm[tid] = 0u;
        __syncthreads();
        const float* src = w_in + ((size_t)l * DM + rg * 32) * INW + sc0; float v[32][4]; float mx[4] = {0.f, 0.f, 0.f, 0.f};
#pragma unroll
        for (int j = 0; j < 32; ++j) { const float2 a = ldnt2(src + (size_t)j * INW), b2 = ldnt2(src + (size_t)j * INW + 2); v[j][0] = a.x; v[j][1] = a.y; v[j][2] = b2.x; v[j][3] = b2.y; }
#pragma unroll
        for (int j = 0; j < 32; ++j) {
#pragma unroll
            for (int i = 0; i < 4; ++i) mx[i] = fmaxf(mx[i], fabsf(v[j][i])); }
#pragma unroll
        for (int i = 0; i < 4; ++i) { float m = mx[i]; m = fmaxf(m, SWZ_XOR(m, 8)); m = fmaxf(m, SWZ_XOR(m, 16));
            auto rr = __builtin_amdgcn_permlane32_swap(__float_as_uint(m), __float_as_uint(m), false, false); m = fmaxf(__uint_as_float(rr[0]), __uint_as_float(rr[1]));
            if (lane < 8) __hip_atomic_fetch_max(cm + 4 * c4 + i, __float_as_uint(m), __ATOMIC_RELAXED, __HIP_MEMORY_SCOPE_WORKGROUP); }
        __syncthreads();
#pragma unroll
        for (int i = 0; i < 4; ++i) { const float cmx = fmaxf(__uint_as_float(cm[4 * c4 + i]), 1e-30f), q = 127.f / cmx; unsigned w[8];
#pragma unroll
            for (int m = 0; m < 8; ++m) w[m] = pk_i8x4(v[4 * m][i] * q, v[4 * m + 1][i] * q, v[4 * m + 2][i] * q, v[4 * m + 3][i] * q);
            signed char* dst = WT8 + ((size_t)l * 12288 + n0 + i) * DM + rg * 32;
            *(uint4*)dst = make_uint4(w[0], w[1], w[2], w[3]); *(uint4*)(dst + 16) = make_uint4(w[4], w[5], w[6], w[7]);
            if (rg == 0) SW[(size_t)l * 12288 + n0 + i] = cmx * (1.f / 127.f); }
    };
    auto cv_wq = [&](const int item, const int tid) __attribute__((always_inline)) {
        const int lane = tid & 63; const float* wq = IN(18); signed char* WQ8 = (signed char*)WSF(WS_WQT); float* SWQ = WSF(WS_SWQ); LAS unsigned* cm = (LAS unsigned*)((LAS unsigned char*)lds_raw + 140 * 1024);
        const int c4 = tid & 7, rg = tid >> 3; const int l = item >> 6, n0 = (item & 63) * 32 + 4 * c4;
        __syncthreads();
        if (tid < 32) cm[tid] = 0u;
        __syncthreads();
        const float* src = wq + ((size_t)l * DM + rg * 32) * DM + n0; float v[32][4]; float mx[4] = {0.f, 0.f, 0.f, 0.f};
#pragma unroll
        for (int j = 0; j < 32; ++j) { const float4 a = ldnt4(src + (size_t)j * DM); v[j][0] = a.x; v[j][1] = a.y; v[j][2] = a.z; v[j][3] = a.w; }
#pragma unroll
        for (int j = 0; j < 32; ++j) {
#pragma unroll
            for (int i = 0; i < 4; ++i) mx[i] = fmaxf(mx[i], fabsf(v[j][i])); }
#pragma unroll
        for (int i = 0; i < 4; ++i) { float m = mx[i]; m = fmaxf(m, SWZ_XOR(m, 8)); m = fmaxf(m, SWZ_XOR(m, 16));
            auto rr = __builtin_amdgcn_permlane32_swap(__float_as_uint(m), __float_as_uint(m), false, false); m = fmaxf(__uint_as_float(rr[0]), __uint_as_float(rr[1]));
            if (lane < 8) __hip_atomic_fetch_max(cm + 4 * c4 + i, __float_as_uint(m), __ATOMIC_RELAXED, __HIP_MEMORY_SCOPE_WORKGROUP); }
        __syncthreads();
#pragma unroll
        for (int i = 0; i < 4; ++i) { const float cmx = fmaxf(__uint_as_float(cm[4 * c4 + i]), 1e-30f), q = 127.f / cmx; unsigned w[8];
#pragma unroll
            for (int m = 0; m < 8; ++m) w[m] = pk_i8x4(v[4 * m][i] * q, v[4 * m + 1][i] * q, v[4 * m + 2][i] * q, v[4 * m + 3][i] * q);
            signed char* dst = WQ8 + ((size_t)l * DM + n0 + i) * DM + rg * 32;
            *(uint4*)dst = make_uint4(w[0], w[1], w[2], w[3]); *(uint4*)(dst + 16) = make_uint4(w[4], w[5], w[6], w[7]);
            if (rg == 0) SWQ[(size_t)l * DM + n0 + i] = cmx * (1.f / 127.f); }
    };
    auto cv_tr = [&](const int it, const int tid) __attribute__((always_inline)) {
        const int lane = tid & 63, wave = tid >> 6; float* scr = lds + wave * (64 * 33); const int l = it / 4096; int r = it % 4096;
        bf16_t* wbr = (bf16_t*)WSF(WS_WBRT) + (size_t)l * 3 * DM * 768;
        if (r < 768) { transpose_item<false>(IN(14) + (size_t)l * 768 * DM, DM, wbr, 768, scr, r / 64, r % 64, lane); return; } r -= 768;
        if (r < 768) { transpose_item<false>(IN(15) + (size_t)l * 768 * DM, DM, wbr + (size_t)DM * 768, 768, scr, r / 64, r % 64, lane); return; } r -= 768;
        if (r < 512) { transpose_item<false>(IN(16) + (size_t)l * 512 * DM, DM, wbr + (size_t)2 * DM * 768, 768, scr, r / 64, r % 64, lane); return; } r -= 512;
        transpose_item<false>(IN(17) + (size_t)l * DM * DM, DM, (bf16_t*)WSF(WS_WOT) + (size_t)l * DM * DM, DM, scr, r / 64, r % 64, lane);
    };
    auto cv_u = [&](const int r, const int tid) __attribute__((always_inline)) {
        const int lane = tid & 63; const float* pu = IN(20); signed char* U8 = (signed char*)WSF(WS_UB); float* SU = WSF(WS_SU);
        const float* src = pu + (size_t)r * DM; float4 v[8]; float mx = 0.f;
#pragma unroll
        for (int j = 0; j < 8; ++j) { v[j] = ldnt4(src + lane * 4 + 256 * j); mx = fmaxf(mx, fmaxf(fmaxf(fabsf(v[j].x), fabsf(v[j].y)), fmaxf(fabsf(v[j].z), fabsf(v[j].w)))); }
        mx = fmaxf(wave_max(mx), 1e-30f); const float q = 127.f / mx;
#pragma unroll
        for (int j = 0; j < 8; ++j) *(unsigned*)(U8 + (size_t)r * DM + lane * 4 + 256 * j) = pk_i8x4(v[j].x * q, v[j].y * q, v[j].z * q, v[j].w * q);
        if (lane == 0) SU[r] = mx * (1.f / 127.f);
    };
    auto cv_v = [&](const int item, const int tid) __attribute__((always_inline)) {
        const int lane = tid & 63, wave = tid >> 6; const float* pv = IN(21); float* DV = WSF(WS_DV); unsigned char* VT = (unsigned char*)WSF(WS_VT); LAS unsigned char* T = (LAS unsigned char*)lds_raw;
        const int l = item >> 8, eb = item & 255;
        __syncthreads();
#pragma unroll 2
        for (int i = 0; i < 8; ++i) { const int e = wave * 8 + i; const size_t r = (size_t)l * 16384 + eb * 64 + e; const float* src = pv + r * DM; float4 v[8]; float mx = 0.f;
#pragma unroll
            for (int j = 0; j < 8; ++j) { v[j] = ldnt4(src + lane * 4 + 256 * j); mx = fmaxf(mx, fmaxf(fmaxf(fabsf(v[j].x), fabsf(v[j].y)), fmaxf(fabsf(v[j].z), fabsf(v[j].w)))); }
            mx = fmaxf(wave_max(mx), 1e-30f); const float q = 127.f / mx;
#pragma unroll
            for (int j = 0; j < 8; ++j) *(LAS unsigned*)(T + e * 2048 + lane * 4 + 256 * j) = pk_i8x4(v[j].x * q, v[j].y * q, v[j].z * q, v[j].w * q);
            if (lane == 0) DV[r] = mx * (1.f / 127.f); }
        __syncthreads();
#pragma unroll
        for (int qd = 0; qd < 4; ++qd) { unsigned d[16];
#pragma unroll
            for (int e = 0; e < 16; ++e) d[e] = *(const LAS unsigned*)(T + (qd * 16 + e) * 2048 + tid * 4);
#pragma unroll
            for (int k = 0; k < 4; ++k) { unsigned o[4];
#pragma unroll
                for (int g = 0; g < 4; ++g) o[g] = ((d[4 * g] >> (8 * k)) & 0xffu) | (((d[4 * g + 1] >> (8 * k)) & 0xffu) << 8) | (((d[4 * g + 2] >> (8 * k)) & 0xffu) << 16) | (((d[4 * g + 3] >> (8 * k)) & 0xffu) << 24);
                *(uint4*)(VT + ((size_t)l * DM + tid * 4 + k) * 16384 + eb * 64 + qd * 16) = make_uint4(o[0], o[1], o[2], o[3]); } }
        __syncthreads();
    };

    { PHASE_VARS
    {
        const float* c_in = IN(1); const float* ada_w = IN(3); float* MODP = WSF(WS_MODP);
        float* cond = lds;
        for (int i = tid; i < NB * DM; i += NTHR) { const float c = c_in[i]; cond[i] = c / (1.f + expf(-c)); }
        __syncthreads();
        for (int item = gtid; item < 2 * 16 * (NMOD / 4); item += NGT) {
            const int j4 = item % (NMOD / 4), ch = (item / (NMOD / 4)) % 16, l = item / (16 * (NMOD / 4));
            float4 a0 = {0.f, 0.f, 0.f, 0.f}, a1 = {0.f, 0.f, 0.f, 0.f};
            const float* wp = ada_w + ((size_t)l * DM + ch * 128) * NMOD + j4 * 4;
            for (int k = 0; k < 128; ++k) { const float4 w = ldnt4(wp + (size_t)k * NMOD); const float c0 = cond[ch * 128 + k], c1 = cond[DM + ch * 128 + k];
                a0.x += c0 * w.x; a0.y += c0 * w.y; a0.z += c0 * w.z; a0.w += c0 * w.w; a1.x += c1 * w.x; a1.y += c1 * w.y; a1.z += c1 * w.z; a1.w += c1 * w.w; }
            *(float4*)(MODP + (((size_t)l * 16 + ch) * 2 + 0) * NMOD + j4 * 4) = a0;
            *(float4*)(MODP + (((size_t)l * 16 + ch) * 2 + 1) * NMOD + j4 * 4) = a1;
        }
        __syncthreads();
        for (int item = bid; item < 384; item += G) cv_win(item, tid);
        __syncthreads();
        { const int* pos_in = (const int*)IN(2); float* ROPE = WSF(WS_ROPE);
          for (int i = gtid; i < NT * 32; i += NGT) { const int t = i >> 5, k = i & 31; const float invf = exp2f(-(float)(2 * k) * (1.f / 64.f) * 13.287712379549449f);
              const float ang = (float)pos_in[t] * invf; ROPE[(size_t)i * 2] = cosf(ang); ROPE[(size_t)i * 2 + 1] = sinf(ang); } }
    }
    }
    GRID_BAR();
    { PHASE_VARS
    { const float* ada_b = IN(4); const float* MODP = WSF(WS_MODP); float* MOD = WSF(WS_MOD);
    for (int i = gtid; i < 2 * 2 * NMOD; i += NGT) { const int j = i % NMOD, b = (i / NMOD) % 2, l = i / (2 * NMOD); float s = ada_b[(size_t)l * NMOD + j];
        for (int ch = 0; ch < 16; ++ch) s += MODP[(((size_t)l * 16 + ch) * 2 + b) * NMOD + j];
        MOD[i] = s; } }
    }
    GRID_BAR();

#pragma clang loop unroll(full)
    for (int l = 0; l < DEPTH; ++l) {
        const float lam_init = 0.8f - 0.6f * expf(-0.3f * (float)l);
#define MODL (WSF(WS_MOD) + (size_t)l * 2 * NMOD)
        { PHASE_VARS
        { const float* modl = MODL; const float* norm1_g = IN(5); const void* X = (l == 0) ? (const void*)IN(0) : (const void*)WSF(WS_X); const bool xf32 = (l == 0); signed char* HQ = (signed char*)WSF(WS_HB); float* SH1 = WSF(WS_SH1); float* FL = WSF(WS_FL);
        float* wfl = lds;
        { const float* w_in = IN(7) + (size_t)l * DM * INW;
          float wv[24];
#pragma unroll
          for (int it = 0; it < 24; ++it) { const int i = tid + it * NTHR, k = i / 6, jj = i % 6; wv[it] = w_in[(size_t)k * INW + C_FL + jj]; }
#pragma unroll
          for (int it = 0; it < 24; ++it) { const int i = tid + it * NTHR, k = i / 6, jj = i % 6; wfl[jj * DM + k] = wv[it]; } }
        __syncthreads();
        for (int t = gw; t < NT; t += NGW) {
            const int b = t / SEQ; const float* g = norm1_g + (size_t)l * DM; const float* sh = modl + (size_t)b * NMOD; const float* sc = sh + DM;
            float4 v[8]; float ss = 0.f; int ln = lane; asm volatile("" : "+v"(ln));
#pragma unroll
            for (int j = 0; j < 8; ++j) { v[j] = ldx4(X, xf32, (size_t)t * DM + ln * 4 + 256 * j); ss += v[j].x * v[j].x + v[j].y * v[j].y + v[j].z * v[j].z + v[j].w * v[j].w; }
            const float r = rsqrtf(wave_sum(ss) * (1.f / DM) + RMS_EPS);
            float fl[6] = {0.f, 0.f, 0.f, 0.f, 0.f, 0.f}; float hmx = 0.f;
#pragma unroll
            for (int j = 0; j < 8; ++j) { const int d = ln * 4 + 256 * j; const float4 gg = *(const float4*)(g + d), s1 = *(const float4*)(sc + d), s0 = *(const float4*)(sh + d); float4 o;
                o.x = v[j].x * r * gg.x * (1.f + s1.x) + s0.x; o.y = v[j].y * r * gg.y * (1.f + s1.y) + s0.y; o.z = v[j].z * r * gg.z * (1.f + s1.z) + s0.z; o.w = v[j].w * r * gg.w * (1.f + s1.w) + s0.w;
                v[j] = o; hmx = fmaxf(hmx, fmaxf(fmaxf(fabsf(o.x), fabsf(o.y)), fmaxf(fabsf(o.z), fabsf(o.w))));
#pragma unroll
                for (int jj = 0; jj < 6; ++jj) { const float4 w4 = *(const float4*)(wfl + jj * DM + d); fl[jj] += o.x * w4.x + o.y * w4.y + o.z * w4.z + o.w * w4.w; } }
            hmx = fmaxf(wave_max(hmx), 1e-30f); const float hq = 127.f / hmx;
#pragma unroll
            for (int j = 0; j < 8; ++j) *(unsigned*)(HQ + (size_t)t * DM + ln * 4 + 256 * j) = pk_i8x4(v[j].x * hq, v[j].y * hq, v[j].z * hq, v[j].w * hq);
            if (lane == 0) SH1[t] = hmx * (1.f / 127.f);
#pragma unroll
            for (int jj = 0; jj < 6; ++jj) fl[jj] = wave_sum(fl[jj]);
            if (lane == 0) { *(float4*)(FL + (size_t)t * 8) = (float4){fl[0], fl[1], fl[2], fl[3]}; *(float2*)(FL + (size_t)t * 8 + 4) = (float2){fl[4], fl[5]}; }
        }
        __syncthreads(); }
        }
        GRID_BAR();
        { PHASE_VARS
        { const float* b_forget = IN(8); const float* FL = WSF(WS_FL); float* CUM = WSF(WS_CUM);
        if (bid < 12) {
            const int b = bid / 6, h = bid % 6; float* sc = lds;
            float loc[8]; float run = 0.f; const float bf = b_forget[l * 6 + h];
#pragma unroll
            for (int j = 0; j < 8; ++j) { const int s = tid * 8 + j; const float xl = FL[((size_t)b * SEQ + s) * 8 + h] + bf; run += fminf(xl, 0.f) - __logf(1.f + __expf(-fabsf(xl))); loc[j] = run; }
            sc[tid] = run; __syncthreads();
            for (int o = 1; o < NTHR; o <<= 1) { float v = 0.f; if (tid >= o) v = sc[tid - o]; __syncthreads(); sc[tid] += v; __syncthreads(); }
            const float off = (tid > 0) ? sc[tid - 1] : 0.f;
#pragma unroll
            for (int j = 0; j < 8; ++j) CUM[(size_t)bid * SEQ + tid * 8 + j] = (off + loc[j]) * 1.4426950408889634f;
            __syncthreads();
        } }
        { pg8::Gemm8 g{(const signed char*)WSF(WS_HB), (const signed char*)WSF(WS_WINT) + (size_t)l * 12288 * DM, NT, 12288, DM, DM, DM};
          pg8::StaticOrder S; S.init(NT, 12288, G, bid);
          EpiProj E{(bf16_t*)WSF(WS_ATT), (bf16_t*)WSF(WS_GATES), WSF(WS_ROPE), WSF(WS_SH1), WSF(WS_SW) + (size_t)l * 12288, (unsigned*)WSF(WS_CTL) + 12288 + 32 * l};
          pg8::gemm_phase_i8<EpiProj, pg8::StaticOrder, true, true>(tid, (LAS unsigned char*)lds_raw, g, S, E); }
        }
        GRID_BAR();
        { PHASE_VARS
        { const bf16_t* ATTp = (const bf16_t*)WSF(WS_ATT); const float* CUM = WSF(WS_CUM); bf16_t* O = (bf16_t*)WSF(WS_OB); float* ODF = WSF(WS_ODF);
          unsigned* qctr = (unsigned*)WSF(WS_CTL) + 8192 + 64 * l;
          const unsigned* KINFp = (const unsigned*)WSF(WS_CTL) + 12288 + 32 * l; unsigned char* Gzp = (unsigned char*)WSF(WS_G);
        const unsigned short* qtab = (l == 0) ? ATT_ITEMS0 : ATT_UNITS; const unsigned qlen = (l == 0) ? (unsigned)N_ATT_ITEMS0 : 640u;
        for (;;) {
            if (tid == 0) MISC[16] = __hip_atomic_fetch_add(qctr, 1u, __ATOMIC_RELAXED, __HIP_MEMORY_SCOPE_AGENT);
            __syncthreads();
            const unsigned rank = MISC[16];
            __syncthreads();
            if (rank >= qlen) break;
            const unsigned uu = qtab[rank];
            int tid_u = tid; asm volatile("" : "+v"(tid_u));
            if (l == 0 && (uu & 0x8000u)) {
                const int ty = (uu >> 12) & 7, ix = uu & 0xfff, wave_u = tid_u >> 6;
                if (ty == 0) cv_win(384 + ix, tid_u);
                else if (ty == 1) cv_wq(ix, tid_u);
                else if (ty == 2) { for (int k = 0; k < 8; ++k) cv_tr(ix * 64 + k * 8 + wave_u, tid_u); }
                else if (ty == 3) { for (int k = 0; k < 32; ++k) cv_u(ix * 256 + k * 8 + wave_u, tid_u); }
                else cv_v(ix, tid_u);
                __syncthreads();
                continue; }
            const int mode = (uu >> 12) & 3, b = (uu >> 11) & 1, h = (uu >> 4) & 7, qb = uu & 15;
            const unsigned zid = (mode < 2) ? (unsigned)(mode * 192 + (b * 6 + h) * 16 + qb) : (unsigned)(384 + (mode - 2) * 128 + (b * 4 + h) * 16 + qb);
            if (mode == 0) att::attn_unit<0>(tid_u, (char*)lds_raw, ATTp, CUM, O, ODF, b, h, qb, KINFp, Gzp, zid);
            else if (mode == 1) att::attn_unit<1>(tid_u, (char*)lds_raw, ATTp, nullptr, O, ODF, b, h, qb, KINFp, Gzp, zid);
            else if (mode == 2) att::attn_unit<2>(tid_u, (char*)lds_raw, ATTp, nullptr, O, ODF, b, h, qb, KINFp, Gzp, zid);
            else att::attn_unit<3>(tid_u, (char*)lds_raw, ATTp, nullptr, O, ODF, b, h, qb, KINFp, Gzp, zid);
        } }
        }
        GRID_BAR();
        { PHASE_VARS
        { const float* ODF = WSF(WS_ODF); bf16_t* O = (bf16_t*)WSF(WS_OB); const float* lam_q1 = IN(9); const float* lam_k1 = IN(10); const float* lam_q2 = IN(11); const float* lam_k2 = IN(12); const float* subg = IN(13) + l * 128;
          float lamh[4];
#pragma unroll
          for (int h = 0; h < 4; ++h) {
              const float d1 = wave_sum(lam_q1[(l * 4 + h) * 64 + lane] * lam_k1[(l * 4 + h) * 64 + lane]), d2 = wave_sum(lam_q2[(l * 4 + h) * 64 + lane] * lam_k2[(l * 4 + h) * 64 + lane]);
              lamh[h] = expf(d1) - expf(d2) + lam_init; }
        for (int t = gw; t < NT; t += NGW) {
            const int hq = lane >> 4; const float lam = hq == 0 ? lamh[0] : hq == 1 ? lamh[1] : hq == 2 ? lamh[2] : lamh[3];
            const float4 a0 = *(const float4*)(ODF + (size_t)t * 512 + lane * 8), a1 = *(const float4*)(ODF + (size_t)t * 512 + lane * 8 + 4);
            const float4 b0 = *(const float4*)(ODF + ((size_t)NT + t) * 512 + lane * 8), b1 = *(const float4*)(ODF + ((size_t)NT + t) * 512 + lane * 8 + 4);
            float v[8] = {a0.x - lam * b0.x, a0.y - lam * b0.y, a0.z - lam * b0.z, a0.w - lam * b0.w, a1.x - lam * b1.x, a1.y - lam * b1.y, a1.z - lam * b1.z, a1.w - lam * b1.w}; float ss = 0.f;
#pragma unroll
            for (int i = 0; i < 8; ++i) ss += v[i] * v[i];
            ss += __shfl_xor(ss, 1); ss += __shfl_xor(ss, 2); ss += __shfl_xor(ss, 4); ss += __shfl_xor(ss, 8);
            const float rr = rsqrtf(ss * (1.f / 128.f) + RMS_EPS) * (1.f - lam_init); const int dd = (lane & 15) * 8;
            const float4 g0 = *(const float4*)(subg + dd), g1 = *(const float4*)(subg + dd + 4);
            pg8::u32x4 w; w.x = pg8::cvt_pk_bf16(v[0] * rr * g0.x, v[1] * rr * g0.y); w.y = pg8::cvt_pk_bf16(v[2] * rr * g0.z, v[3] * rr * g0.w); w.z = pg8::cvt_pk_bf16(v[4] * rr * g1.x, v[5] * rr * g1.y); w.w = pg8::cvt_pk_bf16(v[6] * rr * g1.z, v[7] * rr * g1.w);
            *(pg8::u32x4*)(O + (size_t)t * DM + 1536 + lane * 8) = w;
        } }
        }
        GRID_BAR();
        { PHASE_VARS
        { pg8::Gemm g{(const bf16_t*)WSF(WS_OB), (const bf16_t*)WSF(WS_WBRT) + (size_t)l * 3 * DM * 768, NT, DM, 768, DM, 768}; pg8::BranchOrder S; S.init(NT, DM, G, bid);
          EpiBranchCarry E{(bf16_t*)WSF(WS_YB), (const bf16_t*)WSF(WS_GATES)};
          pg8::gemm_phase<EpiBranchCarry, pg8::BranchOrder, true, true>(tid, (LAS unsigned char*)lds_raw, g, S, E); }
        }
        GRID_BAR();
        { PHASE_VARS
        { pg8::Gemm g{(const bf16_t*)WSF(WS_YB), (const bf16_t*)WSF(WS_WOT) + (size_t)l * DM * DM, NT, DM, DM, DM, DM}; pg8::StaticOrder S; S.init(NT, DM, G, bid);
          EpiResidM E{(bf16_t*)WSF(WS_X), MODL + 2 * DM, (l == 0) ? (const void*)IN(0) : (const void*)WSF(WS_X), l == 0};
          pg8::gemm_phase<EpiResidM, pg8::StaticOrder, true, true>(tid, (LAS unsigned char*)lds_raw, g, S, E); }
        }
        GRID_BAR();
        { PHASE_VARS
        { const float* modl = MODL; const float* norm2_g = IN(6); const void* X = WSF(WS_X); signed char* HB8 = (signed char*)WSF(WS_HB8); float* SH = WSF(WS_SH);
        for (int t = gw; t < NT; t += NGW) {
            const int b = t / SEQ; const float* g = norm2_g + (size_t)l * DM; const float* sh = modl + (size_t)b * NMOD + 3 * DM; const float* sc = sh + DM;
            float4 v[8]; float ss = 0.f;
#pragma unroll
            for (int j = 0; j < 8; ++j) { v[j] = ldx4(X, false, (size_t)t * DM + lane * 4 + 256 * j); ss += v[j].x * v[j].x + v[j].y * v[j].y + v[j].z * v[j].z + v[j].w * v[j].w; }
            const float r = rsqrtf(wave_sum(ss) * (1.f / DM) + RMS_EPS);
            float hmx = 0.f;
#pragma unroll
            for (int j = 0; j < 8; ++j) { const int d = lane * 4 + 256 * j; const float4 gg = *(const float4*)(g + d), s1 = *(const float4*)(sc + d), s0 = *(const float4*)(sh + d); float4 o;
                o.x = v[j].x * r * gg.x * (1.f + s1.x) + s0.x; o.y = v[j].y * r * gg.y * (1.f + s1.y) + s0.y; o.z = v[j].z * r * gg.z * (1.f + s1.z) + s0.z; o.w = v[j].w * r * gg.w * (1.f + s1.w) + s0.w;
                v[j] = o; hmx = fmaxf(hmx, fmaxf(fmaxf(fabsf(o.x), fabsf(o.y)), fmaxf(fabsf(o.z), fabsf(o.w)))); }
            hmx = fmaxf(wave_max(hmx), 1e-30f); const float hq = 127.f / hmx;
#pragma unroll
            for (int j = 0; j < 8; ++j) *(unsigned*)(HB8 + (size_t)t * DM + lane * 4 + 256 * j) = pk_i8x4(v[j].x * hq, v[j].y * hq, v[j].z * hq, v[j].w * hq);
            if (lane == 0) SH[t] = hmx * (1.f / 127.f);
        } }
        }
        GRID_BAR();
        { PHASE_VARS
        { pg8::Gemm8 g{(const signed char*)WSF(WS_HB8), (const signed char*)WSF(WS_WQT) + (size_t)l * DM * DM, NT, DM, DM, DM, DM}; pg8::StaticOrder S; S.init(NT, DM, G, bid);
          EpiStoreI8 E{WSF(WS_PQ), DM, WSF(WS_SH), WSF(WS_SWQ) + (size_t)l * DM};
          pg8::gemm_phase_i8<EpiStoreI8, pg8::StaticOrder, true, true>(tid, (LAS unsigned char*)lds_raw, g, S, E); }
        }
        { PHASE_VARS
        asm volatile("s_waitcnt vmcnt(0)" ::: "memory"); __syncthreads();
        {
            pg8::Unit uq; { pg8::StaticOrder S; S.init(NT, DM, G, bid); if (!S.next(0, uq)) { uq.pm = 0; uq.pn = 0; } }
            const float* peer_keys = IN(19); const float* PQ = WSF(WS_PQ); int* EIDX = (int*)WSF(WS_EIDX); float* GATE = WSF(WS_GATE);
            const int hh = uq.pn;
            char* imgs = (char*)lds_raw;
            for (int c = tid; c < 4096; c += NTHR) { const int p = c >> 11, k = (c >> 4) & 127, ch = c & 15;
                const float* src = peer_keys + ((((size_t)l * 8 + hh) * 2 + p) * 128 + k) * 128 + ch * 8; const float4 a = *(const float4*)src, b2 = *(const float4*)(src + 4);
                const float f[8] = {a.x, a.y, a.z, a.w, b2.x, b2.y, b2.z, b2.w}; unsigned hw[4], lw[4];
#pragma unroll
                for (int e = 0; e < 4; ++e) { const unsigned h2 = att::cvtpk(f[2 * e], f[2 * e + 1]); hw[e] = h2; lw[e] = att::cvtpk(f[2 * e] - __uint_as_float(h2 << 16), f[2 * e + 1] - __uint_as_float(h2 & 0xffff0000u)); }
                char* dst = imgs + ((p * 2 + (k >> 6)) * 2) * 16384 + (k & 63) * 256 + ((ch * 16) ^ (((k & 63) & 7) << 4));
                *(att::u32x4*)dst = (att::u32x4){hw[0], hw[1], hw[2], hw[3]}; *(att::u32x4*)(dst + 16384) = (att::u32x4){lw[0], lw[1], lw[2], lw[3]}; }
            __syncthreads();
            const int wid = __builtin_amdgcn_readfirstlane(tid >> 6), r32 = lane & 31, hi = lane >> 5;
            if (bid < (NT / 256) * (DM / 256)) { const int tg = uq.pm * 8 + wid;
                const int t = tg * 32 + r32; const float* q = PQ + (size_t)t * DM + hh * 256;
                unsigned w1[16], w2[16];
                topk::half_top16(q, imgs, r32, hi, w1);
                topk::half_top16(q + 128, imgs + 65536, r32, hi, w2);
                float bv[16]; unsigned bp[16];
                topk::combine_top16(w1, w2, hi, bv, bp);
                const float mx = bv[0]; float es = 0.f; float ge[16];
#pragma unroll
                for (int r = 0; r < 16; ++r) { ge[r] = __expf(bv[r] - mx); es += ge[r]; }
                const float inv = 1.f / es;
                if (hi == 0) { int* ep = EIDX + (size_t)t * PE_E + hh * PE_TOP; float* gp = GATE + (size_t)t * PE_E + hh * PE_TOP;
#pragma unroll
                    for (int r4 = 0; r4 < 4; ++r4) { *(int4*)(ep + 4 * r4) = make_int4((int)bp[4 * r4], (int)bp[4 * r4 + 1], (int)bp[4 * r4 + 2], (int)bp[4 * r4 + 3]);
                        *(float4*)(gp + 4 * r4) = make_float4(ge[4 * r4] * inv, ge[4 * r4 + 1] * inv, ge[4 * r4 + 2] * inv, ge[4 * r4 + 3] * inv); } }
            }
            __syncthreads();
        }
        }
        GRID_BAR();
        { PHASE_VARS
        { int* EIDX = (int*)WSF(WS_EIDX); const float* GATE = WSF(WS_GATE); unsigned char* Sm = (unsigned char*)WSF(WS_G); float* GMg = WSF(WS_GM); float* ACTF = WSF(WS_ACTF); const float* DV = WSF(WS_DV) + (size_t)l * 16384;
        for (int t = gw; t < NT; t += NGW) {
            const int e0 = EIDX[(size_t)t * PE_E + lane], e1 = EIDX[(size_t)t * PE_E + 64 + lane]; const float g0 = GATE[(size_t)t * PE_E + lane], g1 = GATE[(size_t)t * PE_E + 64 + lane];
            unsigned long long m00 = ~0ull, m01 = ~0ull, m10 = ~0ull, m11 = ~0ull;
#pragma unroll
            for (int bb = 0; bb < 14; ++bb) { const bool q0 = (e0 >> bb) & 1, q1 = (e1 >> bb) & 1; const unsigned long long B0 = __ballot(q0), B1 = __ballot(q1), x0 = q0 ? ~0ull : 0ull, x1 = q1 ? ~0ull : 0ull;
                m00 &= ~(B0 ^ x0); m01 &= ~(B1 ^ x0); m10 &= ~(B0 ^ x1); m11 &= ~(B1 ^ x1); }
            const unsigned long long ltm = (1ull << lane) - 1ull;
            const bool f0 = (m00 & ltm) == 0ull, f1 = (m10 == 0ull) && ((m11 & ltm) == 0ull);
            float s0 = 0.f, s1 = 0.f;
            for (unsigned long long r = m00; __any(r != 0ull); ) { const bool has = r != 0ull; const int k = has ? __builtin_ctzll(r) : 0; const float gk = __shfl(g0, k); if (has) { s0 += gk; r &= r - 1ull; } }
            for (unsigned long long r = m01; __any(r != 0ull); ) { const bool has = r != 0ull; const int k = has ? __builtin_ctzll(r) : 0; const float gk = __shfl(g1, k); if (has) { s0 += gk; r &= r - 1ull; } }
            for (unsigned long long r = m10; __any(r != 0ull); ) { const bool has = r != 0ull; const int k = has ? __builtin_ctzll(r) : 0; const float gk = __shfl(g0, k); if (has) { s1 += gk; r &= r - 1ull; } }
            for (unsigned long long r = m11; __any(r != 0ull); ) { const bool has = r != 0ull; const int k = has ? __builtin_ctzll(r) : 0; const float gk = __shfl(g1, k); if (has) { s1 += gk; r &= r - 1ull; } }
            if (f0) { Sm[gaddr(t, e0)] = (unsigned char)(lane + 1); GMg[(size_t)t * PE_E + lane] = s0 * DV[e0]; } else { EIDX[(size_t)t * PE_E + lane] = -1; ACTF[(size_t)t * PE_E + lane] = 0.f; }
            if (f1) { Sm[gaddr(t, e1)] = (unsigned char)(64 + lane + 1); GMg[(size_t)t * PE_E + 64 + lane] = s1 * DV[e1]; } else { EIDX[(size_t)t * PE_E + 64 + lane] = -1; ACTF[(size_t)t * PE_E + 64 + lane] = 0.f; }
        } }
        }
        GRID_BAR();
        { PHASE_VARS
        { pg8::Gemm8 g{(const signed char*)WSF(WS_HB8), (const signed char*)WSF(WS_UB) + (size_t)l * 16384 * DM, NT, 16384, DM, DM, DM}; pg8::StaticOrder S; S.init(NT, 16384, G, bid);
          EpiPeerHid E{(const unsigned char*)WSF(WS_G), WSF(WS_SH), WSF(WS_SU) + (size_t)l * 16384, WSF(WS_ACTF)};
          pg8::gemm_phase_i8<EpiPeerHid, pg8::StaticOrder, true, true>(tid, (LAS unsigned char*)lds_raw, g, S, E); }
        }
        GRID_BAR();
        { PHASE_VARS
        { const int* EIDX = (const int*)WSF(WS_EIDX); const float* ACTF = WSF(WS_ACTF); const float* GMg = WSF(WS_GM); signed char* A8 = (signed char*)WSF(WS_G); float* SA = WSF(WS_SA);
        for (int t = gw; t < NT; t += NGW) {
            const int e0 = EIDX[(size_t)t * PE_E + lane], e1 = EIDX[(size_t)t * PE_E + 64 + lane];
            const float a0 = (e0 >= 0) ? GMg[(size_t)t * PE_E + lane] * gelu_erf(ACTF[(size_t)t * PE_E + lane]) : 0.f, a1 = (e1 >= 0) ? GMg[(size_t)t * PE_E + 64 + lane] * gelu_erf(ACTF[(size_t)t * PE_E + 64 + lane]) : 0.f;
            const float mx = fmaxf(wave_max(fmaxf(fabsf(a0), fabsf(a1))), 1e-30f), q = 127.f / mx;
            if (e0 >= 0) A8[gaddr(t, e0)] = (signed char)(int)rintf(a0 * q);
            if (e1 >= 0) A8[gaddr(t, e1)] = (signed char)(int)rintf(a1 * q);
            if (lane == 0) SA[t] = mx * (1.f / 127.f);
        } }
        }
        GRID_BAR();
        { PHASE_VARS
        { pg8::Gemm8 g{(const signed char*)WSF(WS_G), (const signed char*)WSF(WS_VT) + (size_t)l * DM * 16384, NT, DM, 16384, 256, 16384}; pg8::StaticOrder S; S.init(NT, DM, G, bid);
          EpiResidI8 E{(bf16_t*)WSF(WS_X), MODL + 5 * DM, WSF(WS_SA)};
          pg8::gemm_phase_i8<EpiResidI8, pg8::StaticOrder, true, true, true>(tid, (LAS unsigned char*)lds_raw, g, S, E); }
        }
        GRID_BAR();
    }
    { PHASE_VARS
    { const void* X = WSF(WS_X); const float* final_g = IN(22); float* outp = (float*)IN(23);
    for (int t = gw; t < NT; t += NGW) {
        float4 v[8]; float ss = 0.f;
#pragma unroll
        for (int j = 0; j < 8; ++j) { v[j] = ldx4(X, false, (size_t)t * DM + lane * 4 + 256 * j); ss += v[j].x * v[j].x + v[j].y * v[j].y + v[j].z * v[j].z + v[j].w * v[j].w; }
        const float r = rsqrtf(wave_sum(ss) * (1.f / DM) + RMS_EPS);
#pragma unroll
        for (int j = 0; j < 8; ++j) { const int d = lane * 4 + 256 * j; const float4 gg = *(const float4*)(final_g + d); float4 o;
            o.x = v[j].x * r * gg.x; o.y = v[j].y * r * gg.y; o.z = v[j].z * r * gg.z; o.w = v[j].w * r * gg.w; *(float4*)(outp + (size_t)t * DM + d) = o; }
    } }
    }
}

extern "C" void kernel_launch(void* const* d_in, const int* in_sizes, int n_in, void* d_out, int out_size, void* d_ws, size_t ws_size, hipStream_t stream) {
    static int grid = 0;
    if (grid == 0) {
        if (n_in != 23 || out_size != NT * DM || ws_size < WS_END) { fprintf(stderr, "kernel_launch: unexpected shapes: n_in %d out %d ws %zu (need %zu)\n", n_in, out_size, ws_size, (size_t)WS_END); grid = -1; return; }
        int dev = 0, cus = 0;
        if (hipGetDevice(&dev) != hipSuccess || hipDeviceGetAttribute(&cus, hipDeviceAttributeMultiprocessorCount, dev) != hipSuccess) { grid = -1; return; }
        if (hipFuncSetAttribute((const void*)fwd_kernel, hipFuncAttributeMaxDynamicSharedMemorySize, LDS_BYTES) != hipSuccess) { fprintf(stderr, "kernel_launch: hipFuncSetAttribute failed\n"); grid = -1; return; }
        int per_cu = 0;
        if (hipOccupancyMaxActiveBlocksPerMultiprocessor(&per_cu, (const void*)fwd_kernel, NTHR, LDS_BYTES) != hipSuccess || per_cu < 1) { fprintf(stderr, "kernel_launch: occupancy query says %d\n", per_cu); (void)hipGetLastError(); grid = -1; return; }
        grid = cus;
        if (grid % 8 != 0) grid -= grid % 8;
    }
    if (grid < 0) return;
    (void)hipMemsetAsync((char*)d_ws + WS_CTL, 0, CTL_ZERO_BYTES, stream);
    Args a{};
    for (int i = 0; i < 23; ++i) a.in[i] = (const float*)d_in[i];
    a.out = (float*)d_out; a.ws = (unsigned char*)d_ws;
    hipLaunchKernelGGL(fwd_kernel, dim3(grid), dim3(NTHR), LDS_BYTES, stream, a);
}
```
